# Optimizing an MI355X kernel written in HIP

```python
import jax, jax.numpy as jnp
from jax import lax
import numpy as np

D_MODEL = 1024
BATCH = 16
SEQ = 2048
DEPTH = 1

N_HEADS = 8
N_KV_HEADS = 2
HEAD_DIM = 64
WINDOW = 128
ATTN_BLOCK = 128
GMLP_WIDTH = 512
GMLP_GROUPS = 4
GMLP_CHUNK = 128
N_EXPERTS = 32
TOP_K = 4
D_FF_EXPERT = D_MODEL
SWIGLU_LIMIT = 7.0
SWIGLU_ALPHA = 1.702
MOE_BLOCK = 128
PLE_DIM = 256

RMS_EPS = 1e-6
LN_EPS = 1e-5

Q_WIDTH = N_HEADS * HEAD_DIM
KV_WIDTH = N_KV_HEADS * HEAD_DIM
IN_WIDTH = Q_WIDTH + 2 * KV_WIDTH + 2 * GMLP_WIDTH + 2 * D_MODEL
IN_SPLITS = list(np.cumsum([Q_WIDTH, KV_WIDTH, KV_WIDTH, GMLP_WIDTH, GMLP_WIDTH, D_MODEL]).tolist())

kernel_name = "hybrid_swa_gmlp_moe_block"


def rmsnorm(x, g):
    xf = x.astype(jnp.float32)
    y = xf * lax.rsqrt(jnp.mean(xf * xf, axis=-1, keepdims=True) + RMS_EPS) * g.astype(jnp.float32)
    return y.astype(x.dtype)


def layernorm(x, g, b):
    xf = x.astype(jnp.float32)
    mu = jnp.mean(xf, axis=-1, keepdims=True)
    xc = xf - mu
    var = jnp.mean(xc * xc, axis=-1, keepdims=True)
    y = xc * lax.rsqrt(var + LN_EPS) * g.astype(jnp.float32) + b.astype(jnp.float32)
    return y.astype(x.dtype)


def alibi_slopes(n_heads):
    return jnp.asarray(2.0 ** (-8.0 * (np.arange(n_heads, dtype=np.float32) + 1.0) / n_heads), dtype=jnp.float32)


def sliding_window_attention(q, k, v, sinks):
    B, S = q.shape[0], q.shape[1]
    nb = S // ATTN_BLOCK
    G = N_HEADS // N_KV_HEADS
    qb = q.reshape(B, nb, ATTN_BLOCK, N_KV_HEADS, G, HEAD_DIM)
    kb = k.reshape(B, nb, ATTN_BLOCK, N_KV_HEADS, HEAD_DIM)
    vb = v.reshape(B, nb, ATTN_BLOCK, N_KV_HEADS, HEAD_DIM)
    pad = ((0, 0), (1, 0), (0, 0), (0, 0), (0, 0))
    kk = jnp.concatenate([jnp.pad(kb, pad)[:, :-1], kb], axis=2)
    vv = jnp.concatenate([jnp.pad(vb, pad)[:, :-1], vb], axis=2)
    scores = jnp.einsum('bnqkgd,bnskd->bnkgqs', qb, kk).astype(jnp.float32) * (HEAD_DIM ** -0.5)
    qi = jnp.arange(ATTN_BLOCK)[:, None]
    sj = jnp.arange(2 * ATTN_BLOCK)[None, :]
    dist = (qi + ATTN_BLOCK - sj).astype(jnp.float32)
    in_window = (dist >= 0) & (dist < WINDOW)
    key_pos = (jnp.arange(nb)[:, None] - 1) * ATTN_BLOCK + jnp.arange(2 * ATTN_BLOCK)[None, :]
    mask = in_window[None, :, :] & (key_pos >= 0)[:, None, :]
    slopes = alibi_slopes(N_HEADS).reshape(N_KV_HEADS, G)
    scores = scores - slopes[:, :, None, None] * dist[None, None, :, :]
    scores = jnp.where(mask[None, :, None, None, :, :], scores, -jnp.inf)
    sink_col = jnp.broadcast_to(sinks.astype(jnp.float32).reshape(1, 1, N_KV_HEADS, G, 1, 1),
                                scores.shape[:-1] + (1,))
    probs = jax.nn.softmax(jnp.concatenate([scores, sink_col], axis=-1), axis=-1)[..., :-1]
    out = jnp.einsum('bnkgqs,bnskd->bnqkgd', probs.astype(v.dtype), vv)
    return out.reshape(B, S, Q_WIDTH)


def chunked_spatial_gating(u, v, w_spatial, b_spatial, g_ln, b_ln):
    B, S = u.shape[0], u.shape[1]
    nc = S // GMLP_CHUNK
    cg = GMLP_WIDTH // GMLP_GROUPS
    v = layernorm(v, g_ln, b_ln)
    vc = v.reshape(B, nc, GMLP_CHUNK, GMLP_GROUPS, cg)
    causal = jnp.tril(jnp.ones((GMLP_CHUNK, GMLP_CHUNK), dtype=w_spatial.dtype))
    w = w_spatial * causal[None]
    mixed = jnp.einsum('gts,bnsgc->bntgc', w, vc) + b_spatial.T[None, None, :, :, None]
    return u * mixed.reshape(B, S, GMLP_WIDTH)


def clamped_swiglu(a, b):
    a = jnp.minimum(a, SWIGLU_LIMIT)
    b = jnp.clip(b, -SWIGLU_LIMIT, SWIGLU_LIMIT)
    return (b + 1.0) * (a * jax.nn.sigmoid(SWIGLU_ALPHA * a))


def moe(h, w_router, b_router, w_gate, b_gate, w_up, b_up, w_down, b_down):
    B, S, D = h.shape
    T = B * S
    hf = h.reshape(T, D)
    logits = (hf @ w_router + b_router).astype(jnp.float32)
    top_val, top_idx = lax.top_k(logits, TOP_K)
    gates = jax.nn.softmax(top_val, axis=-1)
    flat_e = top_idx.reshape(-1).astype(jnp.int32)
    flat_g = gates.reshape(-1)
    order = jnp.argsort(flat_e)
    sorted_e = flat_e[order]
    sorted_tok = (order // TOP_K).astype(jnp.int32)
    sorted_g = flat_g[order]
    counts = jnp.bincount(flat_e, length=N_EXPERTS).astype(jnp.int32)
    padded = (counts + MOE_BLOCK - 1) // MOE_BLOCK * MOE_BLOCK
    pend = jnp.cumsum(padded)
    pstart = pend - padded
    ustart = jnp.cumsum(counts) - counts
    dest = pstart[sorted_e] + jnp.arange(T * TOP_K, dtype=jnp.int32) - ustart[sorted_e]
    capacity = T * TOP_K + N_EXPERTS * MOE_BLOCK
    n_blocks = capacity // MOE_BLOCK
    row_tok = jnp.full((capacity,), T, jnp.int32).at[dest].set(sorted_tok)
    row_g = jnp.zeros((capacity,), jnp.float32).at[dest].set(sorted_g)
    block_e = jnp.minimum(jnp.searchsorted(pend, jnp.arange(n_blocks, dtype=jnp.int32) * MOE_BLOCK, side='right'),
                          N_EXPERTS - 1).astype(jnp.int32)
    h_pad = jnp.concatenate([hf, jnp.zeros((1, D), hf.dtype)], axis=0)

    def expert_block(args):
        tok, g, e = args
        xb = h_pad[tok]
        a = xb @ w_gate[e] + b_gate[e]
        b = xb @ w_up[e] + b_up[e]
        y = clamped_swiglu(a, b) @ w_down[e] + b_down[e]
        return (y * g[:, None]).astype(h.dtype)

    ys = lax.map(expert_block, (row_tok.reshape(n_blocks, MOE_BLOCK), row_g.reshape(n_blocks, MOE_BLOCK), block_e))
    out = jnp.zeros((T + 1, D), h.dtype).at[row_tok].add(ys.reshape(capacity, D))
    return out[:T].reshape(B, S, D)


def setup_inputs(seed: int = 0) -> dict:
    key = jax.random.key(seed)
    ks = jax.random.split(key, 32)
    f32 = jnp.float32
    L, D, E, F = DEPTH, D_MODEL, N_EXPERTS, D_FF_EXPERT

    def nrm(k, shape, scale):
        return jax.random.normal(k, shape, f32) * scale

    return {
        "x": nrm(ks[0], (BATCH, SEQ, D), 1.0),
        "p": nrm(ks[1], (DEPTH, BATCH, SEQ, PLE_DIM), 1.0),
        "g_mix": 1.0 + nrm(ks[2], (L, D), 0.02),
        "w_in": nrm(ks[3], (L, D, IN_WIDTH), D ** -0.5),
        "attn_sinks": nrm(ks[4], (L, N_HEADS), 1.0),
        "g_sgu": 1.0 + nrm(ks[5], (L, GMLP_WIDTH), 0.02),
        "b_sgu": nrm(ks[6], (L, GMLP_WIDTH), 0.02),
        "w_spatial": nrm(ks[7], (L, GMLP_GROUPS, GMLP_CHUNK, GMLP_CHUNK), GMLP_CHUNK ** -0.5),
        "b_spatial": nrm(ks[8], (L, GMLP_GROUPS, GMLP_CHUNK), 0.02),
        "w_attn_proj": nrm(ks[9], (L, Q_WIDTH, D), Q_WIDTH ** -0.5),
        "w_sgu_proj": nrm(ks[10], (L, GMLP_WIDTH, D), GMLP_WIDTH ** -0.5),
        "w_out": nrm(ks[11], (L, D, D), D ** -0.5),
        "g_ffn": 1.0 + nrm(ks[12], (L, D), 0.02),
        "w_router": nrm(ks[13], (L, D, E), D ** -0.5),
        "b_router": nrm(ks[14], (L, E), 0.01),
        "w_gate": nrm(ks[15], (L, E, D, F), D ** -0.5),
        "b_gate": nrm(ks[16], (L, E, F), 0.01),
        "w_up": nrm(ks[17], (L, E, D, F), D ** -0.5),
        "b_up": nrm(ks[18], (L, E, F), 0.01),
        "w_down": nrm(ks[19], (L, E, F, D), F ** -0.5),
        "b_down": nrm(ks[20], (L, E, D), 0.01),
        "g_ple": 1.0 + nrm(ks[21], (L, D), 0.02),
        "w_ple_gate": nrm(ks[22], (L, D, D), D ** -0.5),
        "w_ple_proj": nrm(ks[23], (L, PLE_DIM, D), PLE_DIM ** -0.5),
        "g_final": 1.0 + nrm(ks[24], (D,), 0.02),
    }


def reference(x, p, g_mix, w_in, attn_sinks, g_sgu, b_sgu, w_spatial, b_spatial, w_attn_proj, w_sgu_proj,
              w_out, g_ffn, w_router, b_router, w_gate, b_gate, w_up, b_up, w_down, b_down,
              g_ple, w_ple_gate, w_ple_proj, g_final):
    B, S = x.shape[0], x.shape[1]
    for i in range(DEPTH):
        h = rmsnorm(x, g_mix[i])
        z = h @ w_in[i]
        q, k, v, gu, gv, ga, gb = jnp.split(z, IN_SPLITS, axis=-1)
        attn = sliding_window_attention(q.reshape(B, S, N_HEADS, HEAD_DIM),
                                        k.reshape(B, S, N_KV_HEADS, HEAD_DIM),
                                        v.reshape(B, S, N_KV_HEADS, HEAD_DIM),
                                        attn_sinks[i])
        sgu = chunked_spatial_gating(jax.nn.gelu(gu), jax.nn.gelu(gv), w_spatial[i], b_spatial[i],
                                     g_sgu[i], b_sgu[i])
        merged = jax.nn.sigmoid(ga) * (attn @ w_attn_proj[i]) + jax.nn.sigmoid(gb) * (sgu @ w_sgu_proj[i])
        x = x + merged @ w_out[i]
        x = x + moe(rmsnorm(x, g_ffn[i]), w_router[i], b_router[i], w_gate[i], b_gate[i],
                    w_up[i], b_up[i], w_down[i], b_down[i])
        hp = rmsnorm(x, g_ple[i])
        x = x + jax.nn.sigmoid(hp @ w_ple_gate[i]) * (p[i] @ w_ple_proj[i])
    return rmsnorm(x, g_final)
```

```cpp
#include <hip/hip_runtime.h>
#include <cstdint>
#include <cstdio>

#define DEV __device__ __forceinline__
#define LAS __attribute__((address_space(3)))
typedef unsigned short bf16;
typedef short bf16x8 __attribute__((ext_vector_type(8)));
typedef float f32x4 __attribute__((ext_vector_type(4)));
typedef float f32x16 __attribute__((ext_vector_type(16)));
typedef unsigned u32x4 __attribute__((ext_vector_type(4)));
typedef unsigned u32x2 __attribute__((ext_vector_type(2)));

#ifndef MK_ONE_LAUNCH
#define MK_ONE_LAUNCH 1
#endif

constexpr int NB = 16, SEQ = 2048, T = NB * SEQ, D = 1024;
constexpr int NZ = 3840, Z1W = 1792, Z2W = 2048;
constexpr int NE = 32, FF = 1024, PLE = 256;
constexpr float LOG2E = 1.4426950408889634f;
constexpr float QSCALE = 0.125f * LOG2E;
constexpr float RMS_EPS = 1e-6f, LN_EPS = 1e-5f;
constexpr int NWAVES = 8, NTHREADS = 512;
constexpr int LDS_BYTES = 147456;
constexpr int LDS_CTL = 146432;
constexpr int LC_CNT = 0, LC_START = 32, LC_SPLIT = 65, LC_TOTAL = 66, LC_BAR = 100;

constexpr size_t MiB = 1u << 20;
constexpr size_t WS_CTL = 0, CTL_ZERO_BYTES = 1 * MiB;
constexpr size_t WS_STATS = 1 * MiB;
constexpr size_t WS_WIN = 2 * MiB, WS_WAB = 10 * MiB, WS_WOUT = 12 * MiB, WS_WPG = 14 * MiB, WS_WPP = 16 * MiB, WS_WSP = 16 * MiB + 512 * 1024;
constexpr size_t WS_LIST = 18 * MiB, WS_INFO = 22 * MiB;
constexpr size_t WS_WD = 24 * MiB, WS_WGU = 88 * MiB;
constexpr size_t WS_H2 = 216 * MiB, WS_AP = 216 * MiB;
constexpr size_t WS_ACT = 280 * MiB, WS_Z2 = 280 * MiB, WS_Z1 = 408 * MiB, WS_TMP = 408 * MiB, WS_MRG = 472 * MiB;
constexpr size_t WS_Y0 = 88 * MiB, WS_Y1 = 280 * MiB, WS_PP = 24 * MiB, WS_HP = 416 * MiB, WS_PB = 552 * MiB, WS_END = 568 * MiB;
constexpr int Y0_CAP_ROWS = 98304;
constexpr int CW_TMO = 0, CW_GCOUNT = 64, CW_BAR = 4096;

struct Args { const float* in[25]; float* out; unsigned char* ws; int ph_lo, ph_hi; };

DEV unsigned f2bf(float f) { unsigned u = __builtin_bit_cast(unsigned, f); return (u + 0x7fffu + ((u >> 16) & 1u)) >> 16; }
DEV unsigned pk2(float lo, float hi) { return f2bf(lo) | (f2bf(hi) << 16); }
DEV float bf2f(unsigned b) { return __builtin_bit_cast(float, b << 16); }
DEV float bflo(unsigned w) { return __builtin_bit_cast(float, w << 16); }
DEV float bfhi(unsigned w) { return __builtin_bit_cast(float, w & 0xffff0000u); }
DEV float fexp2(float x) { return __builtin_amdgcn_exp2f(x); }
DEV float frcp(float x) { return __builtin_amdgcn_rcpf(x); }
DEV float sigmoidf_(float x) { return frcp(1.0f + fexp2(-x * LOG2E)); }
DEV float gelu_tanh(float x) { const float u = 1.5957691216057308f * (x + 0.044715f * x * x * x); return x * frcp(1.0f + fexp2(-u * LOG2E)); }
DEV float swiglu(float a, float b) { a = fminf(a, 7.0f); b = fminf(fmaxf(b, -7.0f), 7.0f); return (b + 1.0f) * (a * sigmoidf_(1.702f * a)); }
DEV float wave_sum(float v) {
#pragma unroll
    for (int o = 1; o < 64; o <<= 1) v += __shfl_xor(v, o);
    return v;
}
DEV float wave_max(float v) {
#pragma unroll
    for (int o = 1; o < 64; o <<= 1) v = fmaxf(v, __shfl_xor(v, o));
    return v;
}
DEV int crow(int reg, int h) { return (reg & 3) + 8 * (reg >> 2) + 4 * h; }

struct Frame { LAS unsigned char* lds; int tid, lane, wave, vcu, G, gw, NGW; };

#define XB_TMO      128
#define XB_XCNT(j)  (256  + 64 * (j))
#define XB_XSUB(j)  (1280 + 64 * (j))
#define XB_XGEN(j)  (2304 + 64 * (j))
#define XB_TOP      3328
#define XB_TOPGEN   3392
#define XCD_BAR_WORDS 3456
#define XB_SPIN_CAP (1u << 18)
DEV unsigned xb_ld(unsigned* p)              { return __hip_atomic_load(p, __ATOMIC_RELAXED, __HIP_MEMORY_SCOPE_AGENT); }
DEV unsigned xb_add(unsigned* p, unsigned v) { return __hip_atomic_fetch_add(p, v, __ATOMIC_RELAXED, __HIP_MEMORY_SCOPE_AGENT); }
DEV unsigned xb_xcc_id() { return (unsigned)__builtin_amdgcn_s_getreg((3 << 11) | 20) & 0xFu; }
#define XB_SPIN(cond, bar) do { unsigned _sp = 0; while (cond) { __builtin_amdgcn_s_sleep(1); \
    if ((++_sp & 255u) == 0u) { if (xb_ld(&(bar)[XB_TMO])) break; if (_sp > XB_SPIN_CAP) { atomicAdd(&(bar)[XB_TMO], 1u); break; } } } } while (0)
struct XcdBarrier { unsigned* bar; unsigned x; volatile LAS unsigned* st; };
DEV XcdBarrier xcd_barrier_post(unsigned* bar, volatile LAS unsigned* st) {
    XcdBarrier b; b.bar = bar; b.x = xb_xcc_id(); b.st = st;
    if (threadIdx.x == 0) (void)xb_add(&bar[XB_XCNT(b.x)], 1u);
    return b;
}
DEV void xcd_barrier_complete(unsigned* bar, unsigned x, unsigned& nloc, unsigned& nx) {
    const unsigned G = gridDim.x * gridDim.y * gridDim.z;
    unsigned sum, cnt, mine, sp = 0u;
    for (;;) {
        sum = 0u; cnt = 0u; mine = 0u;
#pragma unroll
        for (unsigned j = 0; j < 16; ++j) { const unsigned c = xb_ld(&bar[XB_XCNT(j)]); sum += c; cnt += (c > 0u) ? 1u : 0u; mine = (j == x) ? c : mine; }
        if (sum == G) break;
        __builtin_amdgcn_s_sleep(1);
        if ((++sp & 255u) == 0u) { if (xb_ld(&bar[XB_TMO])) break; if (sp > XB_SPIN_CAP) { atomicAdd(&bar[XB_TMO], 1u); break; } }
    }
    nloc = mine > 0u ? mine : 1u; nx = cnt > 0u ? cnt : 1u;
}
DEV void xcd_barrier(const XcdBarrier& b) {
    asm volatile("s_waitcnt vmcnt(0)" ::: "memory");
    __syncthreads();
    if (threadIdx.x == 0) {
        unsigned* bar = b.bar;
        __builtin_amdgcn_s_waitcnt(0);
        unsigned nloc = b.st[0], nx = b.st[1];
        if (nloc == 0u) { xcd_barrier_complete(bar, b.x, nloc, nx); b.st[0] = nloc; b.st[1] = nx; }
        const unsigned old = xb_add(&bar[XB_XSUB(b.x)], 1u);
        const unsigned gen = old / nloc;
        if (old + 1u == (gen + 1u) * nloc) {
            __builtin_amdgcn_fence(__ATOMIC_RELEASE, "agent");
            asm volatile("s_waitcnt vmcnt(0)" ::: "memory");
            const unsigned og = xb_add(&bar[XB_TOP], 1u);
            const unsigned tg = og / nx;
            if (og + 1u == (tg + 1u) * nx) xb_add(&bar[XB_TOPGEN], 1u);
            else XB_SPIN(xb_ld(&bar[XB_TOPGEN]) == tg, bar);
            __builtin_amdgcn_fence(__ATOMIC_ACQUIRE, "agent");
            xb_add(&bar[XB_XGEN(b.x)], 1u);
            asm volatile("s_waitcnt vmcnt(0)" ::: "memory");
        } else {
            XB_SPIN(xb_ld(&bar[XB_XGEN(b.x)]) == gen, bar);
            __builtin_amdgcn_fence(__ATOMIC_ACQUIRE, "agent");
            asm volatile("s_waitcnt vmcnt(0)" ::: "memory");
        }
    }
    __syncthreads();
}

template <class Epi>
DEV void ngemm_wave(const bf16* A, int lda, const bf16* Bt, int ldb, int mtiles, int ntiles, int K, const Frame& F, const Epi& epi) {
    const int r = F.lane & 31, h = F.lane >> 5;
    const int total = mtiles * ntiles;
    for (int t = F.gw; t < total; t += F.NGW) {
        const int tm = t / ntiles, tn = t % ntiles;
        const bf16* ap = A + (size_t)(tm * 32 + r) * lda + 8 * h;
        const bf16* bp = Bt + (size_t)(tn * 32 + r) * ldb + 8 * h;
        f32x16 acc;
#pragma unroll
        for (int i = 0; i < 16; ++i) acc[i] = 0.f;
#pragma unroll 8
        for (int k0 = 0; k0 < K; k0 += 16) {
            const bf16x8 a = *(const bf16x8*)(ap + k0), b = *(const bf16x8*)(bp + k0);
            acc = __builtin_amdgcn_mfma_f32_32x32x16_bf16(a, b, acc, 0, 0, 0);
        }
#pragma unroll
        for (int i = 0; i < 16; ++i) epi(tm * 32 + crow(i, h), tn * 32 + r, acc[i]);
    }
}

DEV int maprow(int mode, int n0) { return mode == 0 ? n0 : (256 * (n0 >> 7) + (n0 & 127) + (mode == 2 ? 128 : 0)); }
DEV void transpose_item(const float* W, int K, int N, bf16* WT, int ldt, int koff, int mode, LAS float* scr, int item, int lane) {
    const int nblk = N / 32, kb = item / nblk, nb = item % nblk, k0 = 64 * kb, n0 = 32 * nb;
#pragma unroll 8
    for (int i = 0; i < 32; ++i) { const int kk = 2 * i + (lane >> 5); scr[kk * 33 + (lane & 31)] = W[(size_t)(k0 + kk) * N + n0 + (lane & 31)]; }
    asm volatile("s_waitcnt lgkmcnt(0)" ::: "memory");
    const int c = lane & 7; const int rbase = maprow(mode, n0);
#pragma unroll
    for (int j = 0; j < 4; ++j) { const int n = (lane >> 3) + 8 * j; const LAS float* s = scr + (8 * c) * 33 + n;
        u32x4 o; o.x = pk2(s[0 * 33], s[1 * 33]); o.y = pk2(s[2 * 33], s[3 * 33]); o.z = pk2(s[4 * 33], s[5 * 33]); o.w = pk2(s[6 * 33], s[7 * 33]);
        *(u32x4*)(WT + (size_t)(rbase + n) * ldt + koff + k0 + 8 * c) = o; }
    asm volatile("s_waitcnt lgkmcnt(0)" ::: "memory");
}
DEV void rms_row_to_bf16(const float* xrow, const float* g, bf16* orow, int lane) {
    const f32x4* xr = (const f32x4*)xrow + lane; const f32x4* gr = (const f32x4*)g + lane;
    f32x4 v[4]; float s = 0.f;
#pragma unroll
    for (int j = 0; j < 4; ++j) { v[j] = xr[64 * j]; s += (v[j].x * v[j].x + v[j].y * v[j].y) + (v[j].z * v[j].z + v[j].w * v[j].w); }
    const float rstd = 1.0f / sqrtf(wave_sum(s) * (1.f / D) + RMS_EPS);
    unsigned long long* o8 = (unsigned long long*)orow + lane;
#pragma unroll
    for (int j = 0; j < 4; ++j) { const f32x4 gg = gr[64 * j];
        o8[64 * j] = (unsigned long long)pk2(v[j].x * rstd * gg.x, v[j].y * rstd * gg.y) | ((unsigned long long)pk2(v[j].z * rstd * gg.z, v[j].w * rstd * gg.w) << 32); }
}
DEV void phase_prologue(Frame& F, const Args& a) {
    unsigned char* ws = a.ws;
    LAS float* scr = (LAS float*)(F.lds + F.wave * 8448);
    bf16* Win_t = (bf16*)(ws + WS_WIN); bf16* Wab_t = (bf16*)(ws + WS_WAB); bf16* Wout_t = (bf16*)(ws + WS_WOUT); bf16* Wpg_t = (bf16*)(ws + WS_WPG);
    bf16* Wpp_t = (bf16*)(ws + WS_WPP); bf16* Wsp = (bf16*)(ws + WS_WSP); bf16* Wd_t = (bf16*)(ws + WS_WD); bf16* Wgu_t = (bf16*)(ws + WS_WGU);
    constexpr int I0 = 16 * 120, I1 = 8 * 32, I2 = 8 * 32, I3 = 16 * 32, I4 = 16 * 32, I5 = 4 * 32, IE = 512, NITEMS = I0 + I1 + I2 + I3 + I4 + I5 + NE * 3 * IE;
    for (int it = F.gw; it < NITEMS; it += F.NGW) {
        int r = it;
        if (r < I0) { transpose_item(a.in[3], D, NZ, Win_t, D, 0, 0, scr, r, F.lane); continue; } r -= I0;
        if (r < I1) { transpose_item(a.in[9], 512, D, Wab_t, D, 0, 0, scr, r, F.lane); continue; } r -= I1;
        if (r < I2) { transpose_item(a.in[10], 512, D, Wab_t, D, 512, 0, scr, r, F.lane); continue; } r -= I2;
        if (r < I3) { transpose_item(a.in[11], D, D, Wout_t, D, 0, 0, scr, r, F.lane); continue; } r -= I3;
        if (r < I4) { transpose_item(a.in[22], D, D, Wpg_t, D, 0, 0, scr, r, F.lane); continue; } r -= I4;
        if (r < I5) { transpose_item(a.in[23], PLE, D, Wpp_t, PLE, 0, 0, scr, r, F.lane); continue; } r -= I5;
        const int e = r / (3 * IE), q = r % (3 * IE), kind = q / IE, item = q % IE;
        if (kind == 0) transpose_item(a.in[15] + (size_t)e * D * FF, D, FF, Wgu_t + (size_t)e * 2048 * D, D, 0, 1, scr, item, F.lane);
        else if (kind == 1) transpose_item(a.in[17] + (size_t)e * D * FF, D, FF, Wgu_t + (size_t)e * 2048 * D, D, 0, 2, scr, item, F.lane);
        else transpose_item(a.in[19] + (size_t)e * FF * D, FF, D, Wd_t + (size_t)e * D * FF, FF, 0, 0, scr, item, F.lane);
    }
    for (int i = F.vcu * NTHREADS + F.tid; i < 4 * 128 * 128; i += F.G * NTHREADS) { const int s = i & 127, t = (i >> 7) & 127; Wsp[i] = (bf16)f2bf(s <= t ? a.in[7][i] : 0.f); }
    bf16* Hb = (bf16*)a.out; bf16* PB = (bf16*)(ws + WS_PB);
    for (int m = F.gw; m < T; m += F.NGW) {
        rms_row_to_bf16(a.in[0] + (size_t)m * D, a.in[2], Hb + (size_t)m * D, F.lane);
        const f32x4 pv = *((const f32x4*)(a.in[1] + (size_t)m * PLE) + F.lane);
        *((u32x2*)(PB + (size_t)m * PLE) + F.lane) = (u32x2){pk2(pv.x, pv.y), pk2(pv.z, pv.w)};
    }
}

struct EpiZ { bf16* Z1; bf16* Z2;
    DEV void operator()(int row, int col, float v) const {
        if (col < 512) Z1[(size_t)row * Z1W + col] = (bf16)f2bf(v * QSCALE);
        else if (col < 768) Z1[(size_t)row * Z1W + col] = (bf16)f2bf(v);
        else if (col < Z1W) Z1[(size_t)row * Z1W + col] = (bf16)f2bf(gelu_tanh(v));
        else Z2[(size_t)row * Z2W + (col - Z1W)] = (bf16)f2bf(sigmoidf_(v));
    } };

DEV void phase_lnstats(Frame& F, const Args& a) {
    const bf16* Z1 = (const bf16*)(a.ws + WS_Z1); float2* st = (float2*)(a.ws + WS_STATS);
    for (int m = F.gw; m < T; m += F.NGW) {
        const u32x4 w = *((const u32x4*)(Z1 + (size_t)m * Z1W + 1280) + F.lane);
        float v[8] = {bflo(w.x), bfhi(w.x), bflo(w.y), bfhi(w.y), bflo(w.z), bfhi(w.z), bflo(w.w), bfhi(w.w)};
        float s = 0.f;
#pragma unroll
        for (int j = 0; j < 8; ++j) s += v[j];
        const float mean = wave_sum(s) * (1.f / 512.f); float q = 0.f;
#pragma unroll
        for (int j = 0; j < 8; ++j) { const float d = v[j] - mean; q += d * d; }
        const float rstd = 1.0f / sqrtf(wave_sum(q) * (1.f / 512.f) + LN_EPS);
        if (F.lane == 0) st[m] = make_float2(mean, rstd);
    }
}

DEV void phase_mixers_ref(Frame& F, const Args& a) {
    const bf16* Z1 = (const bf16*)(a.ws + WS_Z1); bf16* AP = (bf16*)(a.ws + WS_AP);
    const float* sinks = a.in[4];
    const int gid = F.vcu * NTHREADS + F.tid, nthr = F.G * NTHREADS;
    for (int item = gid; item < T * 8; item += nthr) {
        const int hh = item / T, m = item % T, b = m / SEQ, t = m % SEQ, kvh = hh >> 2;
        const float slope2 = fexp2(-(float)(hh + 1)) * LOG2E, sink2 = sinks[hh] * LOG2E;
        float q[64], o[64];
        const u32x4* qp = (const u32x4*)(Z1 + (size_t)m * Z1W + hh * 64);
#pragma unroll
        for (int c = 0; c < 8; ++c) { const u32x4 w = qp[c]; q[8 * c] = bflo(w.x); q[8 * c + 1] = bfhi(w.x); q[8 * c + 2] = bflo(w.y); q[8 * c + 3] = bfhi(w.y); q[8 * c + 4] = bflo(w.z); q[8 * c + 5] = bfhi(w.z); q[8 * c + 6] = bflo(w.w); q[8 * c + 7] = bfhi(w.w); }
#pragma unroll
        for (int d = 0; d < 64; ++d) o[d] = 0.f;
        float mrun = sink2, l = 1.0f;
        const int s0 = t - 127 < 0 ? 0 : t - 127;
        for (int s = s0; s <= t; ++s) {
            const bf16* krow = Z1 + (size_t)(b * SEQ + s) * Z1W + 512 + kvh * 64; const bf16* vrow = krow + 128;
            float dot = 0.f;
#pragma unroll
            for (int c = 0; c < 8; ++c) { const u32x4 w = ((const u32x4*)krow)[c];
                dot += q[8 * c] * bflo(w.x) + q[8 * c + 1] * bfhi(w.x) + q[8 * c + 2] * bflo(w.y) + q[8 * c + 3] * bfhi(w.y) + q[8 * c + 4] * bflo(w.z) + q[8 * c + 5] * bfhi(w.z) + q[8 * c + 6] * bflo(w.w) + q[8 * c + 7] * bfhi(w.w); }
            const float sc = dot - slope2 * (float)(t - s);
            const float mnew = fmaxf(mrun, sc), alpha = fexp2(mrun - mnew), p = fexp2(sc - mnew);
            l = l * alpha + p; mrun = mnew;
#pragma unroll
            for (int c = 0; c < 8; ++c) { const u32x4 w = ((const u32x4*)vrow)[c];
                o[8 * c] = o[8 * c] * alpha + p * bflo(w.x); o[8 * c + 1] = o[8 * c + 1] * alpha + p * bfhi(w.x); o[8 * c + 2] = o[8 * c + 2] * alpha + p * bflo(w.y); o[8 * c + 3] = o[8 * c + 3] * alpha + p * bfhi(w.y);
                o[8 * c + 4] = o[8 * c + 4] * alpha + p * bflo(w.z); o[8 * c + 5] = o[8 * c + 5] * alpha + p * bfhi(w.z); o[8 * c + 6] = o[8 * c + 6] * alpha + p * bflo(w.w); o[8 * c + 7] = o[8 * c + 7] * alpha + p * bfhi(w.w); }
        }
        const float il = 1.0f / l;
        u32x4* op = (u32x4*)(AP + (size_t)m * D + hh * 64);
#pragma unroll
        for (int c = 0; c < 8; ++c) op[c] = (u32x4){pk2(o[8 * c] * il, o[8 * c + 1] * il), pk2(o[8 * c + 2] * il, o[8 * c + 3] * il), pk2(o[8 * c + 4] * il, o[8 * c + 5] * il), pk2(o[8 * c + 6] * il, o[8 * c + 7] * il)};
    }
    const bf16* Wsp = (const bf16*)(a.ws + WS_WSP); const float2* st = (const float2*)(a.ws + WS_STATS);
    const float* g_ln = a.in[5]; const float* b_ln = a.in[6]; const float* b_sp = a.in[8];
    for (int item = gid; item < T * 512; item += nthr) {
        const int m = item >> 9, c = item & 511, g = c >> 7, t = m & 127, m0 = m - t;
        const float gl = g_ln[c], bl = b_ln[c];
        const bf16* wrow = Wsp + ((size_t)g * 128 + t) * 128;
        float acc = 0.f;
        for (int s = 0; s <= t; ++s) {
            const float2 ms = st[m0 + s];
            const float vn = (bf2f(Z1[(size_t)(m0 + s) * Z1W + 1280 + c]) - ms.x) * ms.y * gl + bl;
            acc += bf2f(wrow[s]) * vn;
        }
        const float u = bf2f(Z1[(size_t)m * Z1W + 768 + c]);
        AP[(size_t)m * D + 512 + c] = (bf16)f2bf(u * (acc + b_sp[g * 128 + t]));
    }
}

struct EpiProjA { const bf16* Z2; bf16* TMP;
    DEV void operator()(int row, int col, float v) const { TMP[(size_t)row * D + col] = (bf16)f2bf(bf2f(Z2[(size_t)row * Z2W + col]) * v); } };
struct EpiProjB { const bf16* Z2; const bf16* TMP; bf16* MRG;
    DEV void operator()(int row, int col, float v) const { MRG[(size_t)row * D + col] = (bf16)f2bf(bf2f(TMP[(size_t)row * D + col]) + bf2f(Z2[(size_t)row * Z2W + 1024 + col]) * v); } };
struct EpiResid { const float* base; float* out;
    DEV void operator()(int row, int col, float v) const { out[(size_t)row * D + col] = base[(size_t)row * D + col] + v; } };

DEV void phase_router(Frame& F, const Args& a) {
    const float* x1 = a.out; const float* g_ffn = a.in[12]; const float* w_router = a.in[13]; const float* b_router = a.in[14];
    bf16* H2 = (bf16*)(a.ws + WS_H2); unsigned* gcount = (unsigned*)(a.ws + WS_CTL) + CW_GCOUNT; int* list = (int*)(a.ws + WS_LIST); u32x2* info = (u32x2*)(a.ws + WS_INFO);
    LAS float* wt = (LAS float*)F.lds;
    LAS unsigned* lcount = (LAS unsigned*)(F.lds + 131584);
    LAS unsigned* gbase = lcount + 32;
    LAS unsigned* rec = gbase + 32;
    const int lane = F.lane;
    for (int i = F.tid; i < D * NE; i += NTHREADS) { const int d = i >> 5, e = i & 31; wt[e * 1028 + d] = w_router[i]; }
    f32x4 gg[4];
#pragma unroll
    for (int j = 0; j < 4; ++j) gg[j] = *((const f32x4*)g_ffn + lane + 64 * j);
    const int my_e = lane >> 1; const float my_bias = b_router[my_e];
    for (int blk = F.vcu; blk < T / 128; blk += F.G) {
        if (F.tid < 32) lcount[F.tid] = 0u;
        __syncthreads();
        for (int rr = 0; rr < 16; ++rr) {
            const int rl = F.wave * 16 + rr, m = blk * 128 + rl;
            const f32x4* xr = (const f32x4*)(x1 + (size_t)m * D) + lane;
            f32x4 v[4]; float s = 0.f;
#pragma unroll
            for (int j = 0; j < 4; ++j) { v[j] = xr[64 * j]; s += (v[j].x * v[j].x + v[j].y * v[j].y) + (v[j].z * v[j].z + v[j].w * v[j].w); }
            const float rstd = 1.0f / sqrtf(wave_sum(s) * (1.f / D) + RMS_EPS);
#pragma unroll
            for (int j = 0; j < 4; ++j) v[j] = v[j] * rstd * gg[j];
            unsigned long long* o8 = (unsigned long long*)(H2 + (size_t)m * D) + lane;
#pragma unroll
            for (int j = 0; j < 4; ++j) o8[64 * j] = (unsigned long long)pk2(v[j].x, v[j].y) | ((unsigned long long)pk2(v[j].z, v[j].w) << 32);
            float part[32];
#pragma unroll
            for (int e = 0; e < 32; ++e) { float acc = 0.f;
#pragma unroll
                for (int j = 0; j < 4; ++j) { const f32x4 w = *(const LAS f32x4*)(wt + e * 1028 + 4 * lane + 256 * j); acc += (v[j].x * w.x + v[j].y * w.y) + (v[j].z * w.z + v[j].w * w.w); }
                part[e] = acc; }
#define TR_STEP(N, BIT, XM) { const bool hb = (lane >> BIT) & 1; _Pragma("unroll") for (int i = 0; i < N; ++i) { const float keep = hb ? part[i + N] : part[i]; const float send = hb ? part[i] : part[i + N]; part[i] = keep + __shfl_xor(send, XM); } }
            TR_STEP(16, 5, 32) TR_STEP(8, 4, 16) TR_STEP(4, 3, 8) TR_STEP(2, 2, 4) TR_STEP(1, 1, 2)
#undef TR_STEP
            float val = part[0] + __shfl_xor(part[0], 1) + my_bias;
            float topv[4]; int tope[4];
#pragma unroll
            for (int k = 0; k < 4; ++k) { const float mx = wave_max(val); const unsigned long long bal = __ballot(val == mx); const int src = __ffsll((long long)bal) - 1; const int ek = src >> 1;
                topv[k] = mx; tope[k] = ek; if (my_e == ek) val = -INFINITY; }
            const float e1 = __expf(topv[1] - topv[0]), e2 = __expf(topv[2] - topv[0]), e3 = __expf(topv[3] - topv[0]);
            const float inv = 1.0f / (1.0f + e1 + e2 + e3);
            if (lane < 4) {
                const int ek = lane == 0 ? tope[0] : lane == 1 ? tope[1] : lane == 2 ? tope[2] : tope[3];
                const float gk = (lane == 0 ? 1.0f : lane == 1 ? e1 : lane == 2 ? e2 : e3) * inv;
                const unsigned pos = atomicAdd((unsigned*)(lcount + ek), 1u);
                rec[(rl * 4 + lane) * 2] = (unsigned)ek | (pos << 8); rec[(rl * 4 + lane) * 2 + 1] = __builtin_bit_cast(unsigned, gk);
            }
        }
        __syncthreads();
        if (F.tid < 32) gbase[F.tid] = atomicAdd(gcount + F.tid, lcount[F.tid]);
        __syncthreads();
        { const int rl = F.tid >> 2, k = F.tid & 3, m = blk * 128 + rl; const unsigned w0 = rec[F.tid * 2], w1 = rec[F.tid * 2 + 1];
          const unsigned ek = w0 & 255u, gpos = gbase[ek] + (w0 >> 8);
          list[(size_t)ek * T + gpos] = m; info[(size_t)m * 4 + k] = (u32x2){ek | (gpos << 5), w1}; }
        __syncthreads();
    }
}

DEV void moe_layout(Frame& F, const Args& a) {
    volatile LAS int* L = (volatile LAS int*)(F.lds + LDS_CTL);
    if (F.tid == 0) {
        unsigned* gcount = (unsigned*)(a.ws + WS_CTL) + CW_GCOUNT; int st = 0;
        for (int e = 0; e < NE; ++e) { const int c = (int)__hip_atomic_load(gcount + e, __ATOMIC_RELAXED, __HIP_MEMORY_SCOPE_AGENT); L[LC_CNT + e] = c; L[LC_START + e] = st; st += (c + 255) & ~255; }
        L[LC_START + NE] = st; L[LC_TOTAL] = st;
        int sp = 0; while (sp < NE && 2 * L[LC_START + sp] < st) ++sp;
        L[LC_SPLIT] = sp;
    }
    __syncthreads();
}

DEV void phase_moe_up_ref(Frame& F, const Args& a) {
    moe_layout(F, a);
    volatile LAS int* L = (volatile LAS int*)(F.lds + LDS_CTL);
    const bf16* H2 = (const bf16*)(a.ws + WS_H2); const bf16* Wgu_t = (const bf16*)(a.ws + WS_WGU); bf16* ACT = (bf16*)(a.ws + WS_ACT); const int* list = (const int*)(a.ws + WS_LIST);
    const float* b_gate = a.in[16]; const float* b_up = a.in[18];
    const int r = F.lane & 31, h = F.lane >> 5, total = L[LC_TOTAL];
    const int items = (total / 32) * 32;
    for (int it = F.gw; it < items; it += F.NGW) {
        const int rt = it >> 5, ft = it & 31, s0 = rt * 32, f0 = ft * 32;
        int e = 0; while (e < NE - 1 && s0 >= L[LC_START + e + 1]) ++e;
        const int local = s0 + r - L[LC_START + e];
        const int tok = local < L[LC_CNT + e] ? list[(size_t)e * T + local] : 0;
        const bf16* ap = H2 + (size_t)tok * D + 8 * h;
        const bf16* bg = Wgu_t + ((size_t)e * 2048 + 256 * (f0 >> 7) + (f0 & 127) + r) * D + 8 * h; const bf16* bu = bg + (size_t)128 * D;
        f32x16 acca, accb;
#pragma unroll
        for (int i = 0; i < 16; ++i) { acca[i] = 0.f; accb[i] = 0.f; }
#pragma unroll 4
        for (int k0 = 0; k0 < D; k0 += 16) { const bf16x8 av = *(const bf16x8*)(ap + k0);
            acca = __builtin_amdgcn_mfma_f32_32x32x16_bf16(av, *(const bf16x8*)(bg + k0), acca, 0, 0, 0);
            accb = __builtin_amdgcn_mfma_f32_32x32x16_bf16(av, *(const bf16x8*)(bu + k0), accb, 0, 0, 0); }
        const float bgv = b_gate[e * FF + f0 + r], buv = b_up[e * FF + f0 + r];
#pragma unroll
        for (int i = 0; i < 16; ++i) ACT[(size_t)(s0 + crow(i, h)) * FF + f0 + r] = (bf16)f2bf(swiglu(acca[i] + bgv, accb[i] + buv));
    }
}
DEV void phase_moe_down_ref(Frame& F, const Args& a, int half) {
    moe_layout(F, a);
    volatile LAS int* L = (volatile LAS int*)(F.lds + LDS_CTL);
    const bf16* ACT = (const bf16*)(a.ws + WS_ACT); const bf16* Wd_t = (const bf16*)(a.ws + WS_WD); const float* b_down = a.in[20];
    const int r = F.lane & 31, h = F.lane >> 5, total = L[LC_TOTAL], srow = L[LC_START + L[LC_SPLIT]];
    const int row_lo = half == 0 ? 0 : srow, row_hi = half == 0 ? srow : total;
    bf16* Y = half == 0 ? (bf16*)(a.ws + WS_Y0) : (bf16*)(a.ws + WS_Y1) - (size_t)srow * D;
    const int items = ((row_hi - row_lo) / 32) * 32;
    for (int it = F.gw; it < items; it += F.NGW) {
        const int rt = it >> 5, nt = it & 31, s0 = row_lo + rt * 32, n0 = nt * 32;
        int e = 0; while (e < NE - 1 && s0 >= L[LC_START + e + 1]) ++e;
        const bf16* ap = ACT + (size_t)(s0 + r) * FF + 8 * h;
        const bf16* bp = Wd_t + ((size_t)e * D + n0 + r) * FF + 8 * h;
        f32x16 acc;
#pragma unroll
        for (int i = 0; i < 16; ++i) acc[i] = 0.f;
#pragma unroll 8
        for (int k0 = 0; k0 < FF; k0 += 16) acc = __builtin_amdgcn_mfma_f32_32x32x16_bf16(*(const bf16x8*)(ap + k0), *(const bf16x8*)(bp + k0), acc, 0, 0, 0);
        const float bd = b_down[e * D + n0 + r];
#pragma unroll
        for (int i = 0; i < 16; ++i) Y[(size_t)(s0 + crow(i, h)) * D + n0 + r] = (bf16)f2bf(acc[i] + bd);
    }
}

DEV void phase_combine(Frame& F, const Args& a) {
    moe_layout(F, a);
    volatile LAS int* L = (volatile LAS int*)(F.lds + LDS_CTL);
    const int srow = L[LC_START + L[LC_SPLIT]];
    const bf16* Y0 = (const bf16*)(a.ws + WS_Y0); const bf16* Y1 = (const bf16*)(a.ws + WS_Y1) - (size_t)srow * D;
    const u32x2* info = (const u32x2*)(a.ws + WS_INFO); bf16* HP = (bf16*)(a.ws + WS_HP); const float* g_ple = a.in[21];
    const int lane = F.lane;
    for (int m = F.gw; m < T; m += F.NGW) {
        f32x4* xr = (f32x4*)(a.out + (size_t)m * D) + lane;
        f32x4 v[4];
#pragma unroll
        for (int j = 0; j < 4; ++j) v[j] = xr[64 * j];
#pragma unroll
        for (int k = 0; k < 4; ++k) { const u32x2 w = info[(size_t)m * 4 + k]; const int e = w.x & 31, gpos = (int)(w.x >> 5); const unsigned wy = w.y; const float g = __uint_as_float(wy);
            const int row = L[LC_START + e] + gpos; const bf16* yr = (row < srow ? Y0 : Y1) + (size_t)row * D;
#pragma unroll
            for (int j = 0; j < 4; ++j) { const u32x2 yw = *((const u32x2*)yr + lane + 64 * j);
                v[j].x += g * bflo(yw.x); v[j].y += g * bfhi(yw.x); v[j].z += g * bflo(yw.y); v[j].w += g * bfhi(yw.y); } }
        float s = 0.f;
#pragma unroll
        for (int j = 0; j < 4; ++j) { xr[64 * j] = v[j]; s += (v[j].x * v[j].x + v[j].y * v[j].y) + (v[j].z * v[j].z + v[j].w * v[j].w); }
        const float rstd = 1.0f / sqrtf(wave_sum(s) * (1.f / D) + RMS_EPS);
        unsigned long long* o8 = (unsigned long long*)(HP + (size_t)m * D) + lane;
#pragma unroll
        for (int j = 0; j < 4; ++j) { const f32x4 gg = *((const f32x4*)g_ple + lane + 64 * j);
            o8[64 * j] = (unsigned long long)pk2(v[j].x * rstd * gg.x, v[j].y * rstd * gg.y) | ((unsigned long long)pk2(v[j].z * rstd * gg.z, v[j].w * rstd * gg.w) << 32); }
    }
}
struct EpiStoreBf16 { bf16* O; int ldc;
    DEV void operator()(int row, int col, float v) const { O[(size_t)row * ldc + col] = (bf16)f2bf(v); } };
struct EpiPle { const bf16* PP; float* out;
    DEV void operator()(int row, int col, float v) const { const size_t i = (size_t)row * D + col; out[i] = out[i] + sigmoidf_(v) * bf2f(PP[i]); } };

DEV void phase_final(Frame& F, const Args& a) {
    const float* g = a.in[24]; const int lane = F.lane;
    for (int m = F.gw; m < T; m += F.NGW) {
        f32x4* xr = (f32x4*)(a.out + (size_t)m * D) + lane;
        f32x4 v[4]; float s = 0.f;
#pragma unroll
        for (int j = 0; j < 4; ++j) { v[j] = xr[64 * j]; s += (v[j].x * v[j].x + v[j].y * v[j].y) + (v[j].z * v[j].z + v[j].w * v[j].w); }
        const float rstd = 1.0f / sqrtf(wave_sum(s) * (1.f / D) + RMS_EPS);
#pragma unroll
        for (int j = 0; j < 4; ++j) xr[64 * j] = v[j] * rstd * *((const f32x4*)g + lane + 64 * j);
    }
}

constexpr int NPHASES = 14;
__global__ void __launch_bounds__(NTHREADS, 2) fwd(Args a) {
    extern __shared__ __attribute__((aligned(16))) unsigned char lds_raw[];
    Frame F;
    F.lds = (LAS unsigned char*)lds_raw;
    F.tid = threadIdx.x; F.lane = F.tid & 63; F.wave = __builtin_amdgcn_readfirstlane(F.tid >> 6);
    F.G = gridDim.x; { const int bx = blockIdx.x; F.vcu = (F.G % 8 == 0) ? (bx % 8) * (F.G / 8) + bx / 8 : bx; }
    F.gw = F.vcu * NWAVES + F.wave; F.NGW = F.G * NWAVES;
    for (int u = F.tid; u < (LDS_BYTES - LDS_CTL) / 4; u += NTHREADS) ((LAS unsigned*)(F.lds + LDS_CTL))[u] = 0u;
    __syncthreads();
    unsigned* ctl = (unsigned*)(a.ws + WS_CTL);
    const bool one = (a.ph_hi - a.ph_lo) > 1;
    XcdBarrier bar; bar.bar = ctl + CW_BAR; bar.x = 0; bar.st = nullptr;
    if (one) bar = xcd_barrier_post(ctl + CW_BAR, (volatile LAS unsigned*)(F.lds + LDS_CTL) + LC_BAR);
    unsigned char* ws = a.ws;
#define IN(k) (a.ph_lo <= (k) && (k) < a.ph_hi)
#define SEAM(k) do { if (IN(k) && IN((k) + 1)) xcd_barrier(bar); } while (0)
    if (IN(0)) { phase_prologue(F, a); } SEAM(0);
    if (IN(1)) { EpiZ E{(bf16*)(ws + WS_Z1), (bf16*)(ws + WS_Z2)}; ngemm_wave((const bf16*)a.out, D, (const bf16*)(ws + WS_WIN), D, T / 32, NZ / 32, D, F, E); } SEAM(1);
    if (IN(2)) { phase_lnstats(F, a); } SEAM(2);
    if (IN(3)) { phase_mixers_ref(F, a); } SEAM(3);
    if (IN(4)) { EpiProjA E{(const bf16*)(ws + WS_Z2), (bf16*)(ws + WS_TMP)}; ngemm_wave((const bf16*)(ws + WS_AP), D, (const bf16*)(ws + WS_WAB), D, T / 32, D / 32, 512, F, E); } SEAM(4);
    if (IN(5)) { EpiProjB E{(const bf16*)(ws + WS_Z2), (const bf16*)(ws + WS_TMP), (bf16*)(ws + WS_MRG)}; ngemm_wave((const bf16*)(ws + WS_AP) + 512, D, (const bf16*)(ws + WS_WAB) + 512, D, T / 32, D / 32, 512, F, E); } SEAM(5);
    if (IN(6)) { EpiResid E{a.in[0], a.out}; ngemm_wave((const bf16*)(ws + WS_MRG), D, (const bf16*)(ws + WS_WOUT), D, T / 32, D / 32, D, F, E); } SEAM(6);
    if (IN(7)) { phase_router(F, a); } SEAM(7);
    if (IN(8)) { phase_moe_up_ref(F, a); } SEAM(8);
    if (IN(9)) { phase_moe_down_ref(F, a, 0); } SEAM(9);
    if (IN(10)) { phase_moe_down_ref(F, a, 1); } SEAM(10);
    if (IN(11)) { phase_combine(F, a); EpiStoreBf16 E{(bf16*)(ws + WS_PP), D}; ngemm_wave((const bf16*)(ws + WS_PB), PLE, (const bf16*)(ws + WS_WPP), PLE, T / 32, D / 32, PLE, F, E); } SEAM(11);
    if (IN(12)) { EpiPle E{(const bf16*)(ws + WS_PP), a.out}; ngemm_wave((const bf16*)(ws + WS_HP), D, (const bf16*)(ws + WS_WPG), D, T / 32, D / 32, D, F, E); } SEAM(12);
    if (IN(13)) { phase_final(F, a); }
#undef IN
#undef SEAM
}

extern "C" void kernel_launch(void* const* d_in, const int* in_sizes, int n_in, void* d_out, int out_size, void* d_ws, size_t ws_size, hipStream_t stream) {
    static int grid = 0;
    if (grid == 0) {
        if (n_in != 25 || in_sizes[0] != T * D || out_size != T * D || ws_size < WS_END) { fprintf(stderr, "kernel_launch: unexpected shapes (n_in %d, ws %zu)\n", n_in, ws_size); grid = -1; return; }
        int dev = 0, cus = 0;
        if (hipGetDevice(&dev) != hipSuccess || hipDeviceGetAttribute(&cus, hipDeviceAttributeMultiprocessorCount, dev) != hipSuccess) { grid = -1; return; }
        if (hipFuncSetAttribute((const void*)fwd, hipFuncAttributeMaxDynamicSharedMemorySize, LDS_BYTES) != hipSuccess) { grid = -1; return; }
        (void)hipGetLastError();
        grid = cus;
    }
    if (grid < 0) return;
    (void)hipMemsetAsync((char*)d_ws + WS_CTL, 0, CTL_ZERO_BYTES, stream);
    Args a{};
    for (int i = 0; i < 25; ++i) a.in[i] = (const float*)d_in[i];
    a.out = (float*)d_out; a.ws = (unsigned char*)d_ws;
#if MK_ONE_LAUNCH
    a.ph_lo = 0; a.ph_hi = NPHASES;
    hipLaunchKernelGGL(fwd, dim3(grid), dim3(NTHREADS), LDS_BYTES, stream, a);
#else
    for (int p = 0; p < NPHASES; ++p) { a.ph_lo = p; a.ph_hi = p + 1; hipLaunchKernelGGL(fwd, dim3(grid), dim3(NTHREADS), LDS_BYTES, stream, a); }
#endif
}
```

```cpp
#include <hip/hip_runtime.h>
#include <cstdint>
#include <cstdio>

#define DEV __device__ __forceinline__
#define LAS __attribute__((address_space(3)))
typedef unsigned short bf16;
typedef short bf16x8 __attribute__((ext_vector_type(8)));
typedef float f32x4 __attribute__((ext_vector_type(4)));
typedef float f32x16 __attribute__((ext_vector_type(16)));
typedef unsigned u32x4 __attribute__((ext_vector_type(4)));
typedef unsigned u32x2 __attribute__((ext_vector_type(2)));

#ifndef FAST_GEMM
#define FAST_GEMM 1
#endif
#ifndef FAST_G1
#define FAST_G1 FAST_GEMM
#endif
#ifndef FAST_G4
#define FAST_G4 FAST_GEMM
#endif
#ifndef FAST_G11
#define FAST_G11 FAST_GEMM
#endif
#ifndef FAST_MIX
#define FAST_MIX 1
#endif
#ifndef FAST_MOE
#define FAST_MOE 1
#endif
#ifndef MK_ONE_LAUNCH
#define MK_ONE_LAUNCH 1
#endif

constexpr int NB = 16, SEQ = 2048, T = NB * SEQ, D = 1024;
constexpr int NZ = 3840, Z1W = 1792, Z2W = 2048;
constexpr int NE = 32, FF = 1024, PLE = 256;
constexpr float LOG2E = 1.4426950408889634f;
constexpr float QSCALE = 0.125f * LOG2E;
constexpr float RMS_EPS = 1e-6f, LN_EPS = 1e-5f;
constexpr int NWAVES = 8, NTHREADS = 512;
constexpr int LDS_BYTES = 147456;
constexpr int LDS_CTL = 146432;
constexpr int LC_CNT = 0, LC_START = 32, LC_SPLIT = 65, LC_TOTAL = 66, LC_BAR = 100;

constexpr size_t MiB = 1u << 20;
constexpr size_t WS_CTL = 0, CTL_ZERO_BYTES = 1 * MiB;
constexpr size_t WS_STATS = 1 * MiB;
constexpr size_t WS_WIN = 2 * MiB, WS_WAB = 10 * MiB, WS_WOUT = 12 * MiB, WS_WPG = 14 * MiB, WS_WPP = 16 * MiB, WS_WSP = 16 * MiB + 512 * 1024;
constexpr size_t WS_LIST = 18 * MiB, WS_INFO = 22 * MiB;
constexpr size_t WS_WD = 24 * MiB, WS_WGU = 88 * MiB;
constexpr size_t WS_H2 = 216 * MiB, WS_AP = 216 * MiB;
constexpr size_t WS_ACT = 280 * MiB, WS_Z2 = 280 * MiB, WS_Z1 = 408 * MiB, WS_TMP = 408 * MiB, WS_MRG = 472 * MiB;
constexpr size_t WS_Y0 = 88 * MiB, WS_Y1 = 280 * MiB, WS_PP = 24 * MiB, WS_HP = 416 * MiB, WS_PB = 552 * MiB, WS_END = 568 * MiB;
constexpr int Y0_CAP_ROWS = 98304;
constexpr int CW_TMO = 0, CW_GCOUNT = 64, CW_BAR = 4096;

struct Args { const float* in[25]; float* out; unsigned char* ws; int ph_lo, ph_hi; };

DEV unsigned f2bf(float f) { unsigned u = __builtin_bit_cast(unsigned, f); return (u + 0x7fffu + ((u >> 16) & 1u)) >> 16; }
DEV unsigned pk2(float lo, float hi) { return f2bf(lo) | (f2bf(hi) << 16); }
DEV float bf2f(unsigned b) { return __builtin_bit_cast(float, b << 16); }
DEV float bflo(unsigned w) { return __builtin_bit_cast(float, w << 16); }
DEV float bfhi(unsigned w) { return __builtin_bit_cast(float, w & 0xffff0000u); }
DEV float fexp2(float x) { return __builtin_amdgcn_exp2f(x); }
DEV float frcp(float x) { return __builtin_amdgcn_rcpf(x); }
DEV float sigmoidf_(float x) { return frcp(1.0f + fexp2(-x * LOG2E)); }
DEV float gelu_tanh(float x) { const float u = 1.5957691216057308f * (x + 0.044715f * x * x * x); return x * frcp(1.0f + fexp2(-u * LOG2E)); }
DEV float swiglu(float a, float b) { a = fminf(a, 7.0f); b = fminf(fmaxf(b, -7.0f), 7.0f); return (b + 1.0f) * (a * sigmoidf_(1.702f * a)); }
DEV float wave_sum(float v) {
#pragma unroll
    for (int o = 1; o < 64; o <<= 1) v += __shfl_xor(v, o);
    return v;
}
DEV float wave_max(float v) {
#pragma unroll
    for (int o = 1; o < 64; o <<= 1) v = fmaxf(v, __shfl_xor(v, o));
    return v;
}
DEV int crow(int reg, int h) { return (reg & 3) + 8 * (reg >> 2) + 4 * h; }

struct Frame { LAS unsigned char* lds; int tid, lane, wave, vcu, G, gw, NGW; };

#define XB_TMO      128
#define XB_XCNT(j)  (256  + 64 * (j))
#define XB_XSUB(j)  (1280 + 64 * (j))
#define XB_XGEN(j)  (2304 + 64 * (j))
#define XB_TOP      3328
#define XB_TOPGEN   3392
#define XCD_BAR_WORDS 3456
#define XB_SPIN_CAP (1u << 18)
DEV unsigned xb_ld(unsigned* p)              { return __hip_atomic_load(p, __ATOMIC_RELAXED, __HIP_MEMORY_SCOPE_AGENT); }
DEV unsigned xb_add(unsigned* p, unsigned v) { return __hip_atomic_fetch_add(p, v, __ATOMIC_RELAXED, __HIP_MEMORY_SCOPE_AGENT); }
DEV unsigned xb_xcc_id() { return (unsigned)__builtin_amdgcn_s_getreg((3 << 11) | 20) & 0xFu; }
#define XB_SPIN(cond, bar) do { unsigned _sp = 0; while (cond) { __builtin_amdgcn_s_sleep(1); \
    if ((++_sp & 255u) == 0u) { if (xb_ld(&(bar)[XB_TMO])) break; if (_sp > XB_SPIN_CAP) { atomicAdd(&(bar)[XB_TMO], 1u); break; } } } } while (0)
struct XcdBarrier { unsigned* bar; unsigned x; volatile LAS unsigned* st; };
DEV XcdBarrier xcd_barrier_post(unsigned* bar, volatile LAS unsigned* st) {
    XcdBarrier b; b.bar = bar; b.x = xb_xcc_id(); b.st = st;
    if (threadIdx.x == 0) (void)xb_add(&bar[XB_XCNT(b.x)], 1u);
    return b;
}
DEV void xcd_barrier_complete(unsigned* bar, unsigned x, unsigned& nloc, unsigned& nx) {
    const unsigned G = gridDim.x * gridDim.y * gridDim.z;
    unsigned sum, cnt, mine, sp = 0u;
    for (;;) {
        sum = 0u; cnt = 0u; mine = 0u;
#pragma unroll
        for (unsigned j = 0; j < 16; ++j) { const unsigned c = xb_ld(&bar[XB_XCNT(j)]); sum += c; cnt += (c > 0u) ? 1u : 0u; mine = (j == x) ? c : mine; }
        if (sum == G) break;
        __builtin_amdgcn_s_sleep(1);
        if ((++sp & 255u) == 0u) { if (xb_ld(&bar[XB_TMO])) break; if (sp > XB_SPIN_CAP) { atomicAdd(&bar[XB_TMO], 1u); break; } }
    }
    nloc = mine > 0u ? mine : 1u; nx = cnt > 0u ? cnt : 1u;
}
DEV void xcd_barrier(const XcdBarrier& b) {
    asm volatile("s_waitcnt vmcnt(0)" ::: "memory");
    __syncthreads();
    if (threadIdx.x == 0) {
        unsigned* bar = b.bar;
        __builtin_amdgcn_s_waitcnt(0);
        unsigned nloc = b.st[0], nx = b.st[1];
        if (nloc == 0u) { xcd_barrier_complete(bar, b.x, nloc, nx); b.st[0] = nloc; b.st[1] = nx; }
        const unsigned old = xb_add(&bar[XB_XSUB(b.x)], 1u);
        const unsigned gen = old / nloc;
        if (old + 1u == (gen + 1u) * nloc) {
            __builtin_amdgcn_fence(__ATOMIC_RELEASE, "agent");
            asm volatile("s_waitcnt vmcnt(0)" ::: "memory");
            const unsigned og = xb_add(&bar[XB_TOP], 1u);
            const unsigned tg = og / nx;
            if (og + 1u == (tg + 1u) * nx) xb_add(&bar[XB_TOPGEN], 1u);
            else XB_SPIN(xb_ld(&bar[XB_TOPGEN]) == tg, bar);
            __builtin_amdgcn_fence(__ATOMIC_ACQUIRE, "agent");
            xb_add(&bar[XB_XGEN(b.x)], 1u);
            asm volatile("s_waitcnt vmcnt(0)" ::: "memory");
        } else {
            XB_SPIN(xb_ld(&bar[XB_XGEN(b.x)]) == gen, bar);
            __builtin_amdgcn_fence(__ATOMIC_ACQUIRE, "agent");
            asm volatile("s_waitcnt vmcnt(0)" ::: "memory");
        }
    }
    __syncthreads();
}

template <class Epi>
DEV void ngemm_wave(const bf16* A, int lda, const bf16* Bt, int ldb, int mtiles, int ntiles, int K, const Frame& F, const Epi& epi) {
    const int r = F.lane & 31, h = F.lane >> 5;
    const int total = mtiles * ntiles;
    for (int t = F.gw; t < total; t += F.NGW) {
        const int tm = t / ntiles, tn = t % ntiles;
        const bf16* ap = A + (size_t)(tm * 32 + r) * lda + 8 * h;
        const bf16* bp = Bt + (size_t)(tn * 32 + r) * ldb + 8 * h;
        f32x16 acc;
#pragma unroll
        for (int i = 0; i < 16; ++i) acc[i] = 0.f;
#pragma unroll 8
        for (int k0 = 0; k0 < K; k0 += 16) {
            const bf16x8 a = *(const bf16x8*)(ap + k0), b = *(const bf16x8*)(bp + k0);
            acc = __builtin_amdgcn_mfma_f32_32x32x16_bf16(a, b, acc, 0, 0, 0);
        }
#pragma unroll
        for (int i = 0; i < 16; ++i) epi(tm * 32 + crow(i, h), tn * 32 + r, acc[i]);
    }
}

DEV int maprow(int mode, int n0) { return mode == 0 ? n0 : (256 * (n0 >> 7) + (n0 & 127) + (mode == 2 ? 128 : 0)); }
DEV void transpose_item(const float* W, int K, int N, bf16* WT, int ldt, int koff, int mode, LAS float* scr, int item, int lane) {
    const int nblk = N / 32, kb = item / nblk, nb = item % nblk, k0 = 64 * kb, n0 = 32 * nb;
#pragma unroll 8
    for (int i = 0; i < 32; ++i) { const int kk = 2 * i + (lane >> 5); scr[kk * 33 + (lane & 31)] = W[(size_t)(k0 + kk) * N + n0 + (lane & 31)]; }
    asm volatile("s_waitcnt lgkmcnt(0)" ::: "memory");
    const int c = lane & 7; const int rbase = maprow(mode, n0);
#pragma unroll
    for (int j = 0; j < 4; ++j) { const int n = (lane >> 3) + 8 * j; const LAS float* s = scr + (8 * c) * 33 + n;
        u32x4 o; o.x = pk2(s[0 * 33], s[1 * 33]); o.y = pk2(s[2 * 33], s[3 * 33]); o.z = pk2(s[4 * 33], s[5 * 33]); o.w = pk2(s[6 * 33], s[7 * 33]);
        *(u32x4*)(WT + (size_t)(rbase + n) * ldt + koff + k0 + 8 * c) = o; }
    asm volatile("s_waitcnt lgkmcnt(0)" ::: "memory");
}
DEV void rms_row_to_bf16(const float* xrow, const float* g, bf16* orow, int lane) {
    const f32x4* xr = (const f32x4*)xrow + lane; const f32x4* gr = (const f32x4*)g + lane;
    f32x4 v[4]; float s = 0.f;
#pragma unroll
    for (int j = 0; j < 4; ++j) { v[j] = xr[64 * j]; s += (v[j].x * v[j].x + v[j].y * v[j].y) + (v[j].z * v[j].z + v[j].w * v[j].w); }
    const float rstd = 1.0f / sqrtf(wave_sum(s) * (1.f / D) + RMS_EPS);
    unsigned long long* o8 = (unsigned long long*)orow + lane;
#pragma unroll
    for (int j = 0; j < 4; ++j) { const f32x4 gg = gr[64 * j];
        o8[64 * j] = (unsigned long long)pk2(v[j].x * rstd * gg.x, v[j].y * rstd * gg.y) | ((unsigned long long)pk2(v[j].z * rstd * gg.z, v[j].w * rstd * gg.w) << 32); }
}
DEV void phase_prologue(Frame& F, const Args& a) {
    unsigned char* ws = a.ws;
    LAS float* scr = (LAS float*)(F.lds + F.wave * 8448);
    bf16* Win_t = (bf16*)(ws + WS_WIN); bf16* Wab_t = (bf16*)(ws + WS_WAB); bf16* Wout_t = (bf16*)(ws + WS_WOUT); bf16* Wpg_t = (bf16*)(ws + WS_WPG);
    bf16* Wpp_t = (bf16*)(ws + WS_WPP); bf16* Wsp = (bf16*)(ws + WS_WSP); bf16* Wd_t = (bf16*)(ws + WS_WD); bf16* Wgu_t = (bf16*)(ws + WS_WGU);
    constexpr int I0 = 16 * 120, I1 = 8 * 32, I2 = 8 * 32, I3 = 16 * 32, I4 = 16 * 32, I5 = 4 * 32, IE = 512, NITEMS = I0 + I1 + I2 + I3 + I4 + I5 + NE * 3 * IE;
    for (int it = F.gw; it < NITEMS; it += F.NGW) {
        int r = it;
        if (r < I0) { transpose_item(a.in[3], D, NZ, Win_t, D, 0, 0, scr, r, F.lane); continue; } r -= I0;
        if (r < I1) { transpose_item(a.in[9], 512, D, Wab_t, D, 0, 0, scr, r, F.lane); continue; } r -= I1;
        if (r < I2) { transpose_item(a.in[10], 512, D, Wab_t, D, 512, 0, scr, r, F.lane); continue; } r -= I2;
        if (r < I3) { transpose_item(a.in[11], D, D, Wout_t, D, 0, 0, scr, r, F.lane); continue; } r -= I3;
        if (r < I4) { transpose_item(a.in[22], D, D, Wpg_t, D, 0, 0, scr, r, F.lane); continue; } r -= I4;
        if (r < I5) { transpose_item(a.in[23], PLE, D, Wpp_t, PLE, 0, 0, scr, r, F.lane); continue; } r -= I5;
        const int e = r / (3 * IE), q = r % (3 * IE), kind = q / IE, item = q % IE;
        if (kind == 0) transpose_item(a.in[15] + (size_t)e * D * FF, D, FF, Wgu_t + (size_t)e * 2048 * D, D, 0, 1, scr, item, F.lane);
        else if (kind == 1) transpose_item(a.in[17] + (size_t)e * D * FF, D, FF, Wgu_t + (size_t)e * 2048 * D, D, 0, 2, scr, item, F.lane);
        else transpose_item(a.in[19] + (size_t)e * FF * D, FF, D, Wd_t + (size_t)e * D * FF, FF, 0, 0, scr, item, F.lane);
    }
    for (int i = F.vcu * NTHREADS + F.tid; i < 4 * 128 * 128; i += F.G * NTHREADS) { const int s = i & 127, t = (i >> 7) & 127; Wsp[i] = (bf16)f2bf(s <= t ? a.in[7][i] : 0.f); }
    bf16* Hb = (bf16*)a.out; bf16* PB = (bf16*)(ws + WS_PB);
    for (int m = F.gw; m < T; m += F.NGW) {
        rms_row_to_bf16(a.in[0] + (size_t)m * D, a.in[2], Hb + (size_t)m * D, F.lane);
        const f32x4 pv = *((const f32x4*)(a.in[1] + (size_t)m * PLE) + F.lane);
        *((u32x2*)(PB + (size_t)m * PLE) + F.lane) = (u32x2){pk2(pv.x, pv.y), pk2(pv.z, pv.w)};
    }
}

struct EpiZ { bf16* Z1; bf16* Z2;
    DEV void operator()(int row, int col, float v) const {
        if (col < 512) Z1[(size_t)row * Z1W + col] = (bf16)f2bf(v * QSCALE);
        else if (col < 768) Z1[(size_t)row * Z1W + col] = (bf16)f2bf(v);
        else if (col < Z1W) Z1[(size_t)row * Z1W + col] = (bf16)f2bf(gelu_tanh(v));
        else Z2[(size_t)row * Z2W + (col - Z1W)] = (bf16)f2bf(sigmoidf_(v));
    } };

DEV void phase_lnstats(Frame& F, const Args& a) {
    const bf16* Z1 = (const bf16*)(a.ws + WS_Z1); float2* st = (float2*)(a.ws + WS_STATS);
    for (int m = F.gw; m < T; m += F.NGW) {
        const u32x4 w = *((const u32x4*)(Z1 + (size_t)m * Z1W + 1280) + F.lane);
        float v[8] = {bflo(w.x), bfhi(w.x), bflo(w.y), bfhi(w.y), bflo(w.z), bfhi(w.z), bflo(w.w), bfhi(w.w)};
        float s = 0.f;
#pragma unroll
        for (int j = 0; j < 8; ++j) s += v[j];
        const float mean = wave_sum(s) * (1.f / 512.f); float q = 0.f;
#pragma unroll
        for (int j = 0; j < 8; ++j) { const float d = v[j] - mean; q += d * d; }
        const float rstd = 1.0f / sqrtf(wave_sum(q) * (1.f / 512.f) + LN_EPS);
        if (F.lane == 0) st[m] = make_float2(mean, rstd);
    }
}

DEV void phase_mixers_ref(Frame& F, const Args& a) {
    const bf16* Z1 = (const bf16*)(a.ws + WS_Z1); bf16* AP = (bf16*)(a.ws + WS_AP);
    const float* sinks = a.in[4];
    const int gid = F.vcu * NTHREADS + F.tid, nthr = F.G * NTHREADS;
    for (int item = gid; item < T * 8; item += nthr) {
        const int hh = item / T, m = item % T, b = m / SEQ, t = m % SEQ, kvh = hh >> 2;
        const float slope2 = fexp2(-(float)(hh + 1)) * LOG2E, sink2 = sinks[hh] * LOG2E;
        float q[64], o[64];
        const u32x4* qp = (const u32x4*)(Z1 + (size_t)m * Z1W + hh * 64);
#pragma unroll
        for (int c = 0; c < 8; ++c) { const u32x4 w = qp[c]; q[8 * c] = bflo(w.x); q[8 * c + 1] = bfhi(w.x); q[8 * c + 2] = bflo(w.y); q[8 * c + 3] = bfhi(w.y); q[8 * c + 4] = bflo(w.z); q[8 * c + 5] = bfhi(w.z); q[8 * c + 6] = bflo(w.w); q[8 * c + 7] = bfhi(w.w); }
#pragma unroll
        for (int d = 0; d < 64; ++d) o[d] = 0.f;
        float mrun = sink2, l = 1.0f;
        const int s0 = t - 127 < 0 ? 0 : t - 127;
        for (int s = s0; s <= t; ++s) {
            const bf16* krow = Z1 + (size_t)(b * SEQ + s) * Z1W + 512 + kvh * 64; const bf16* vrow = krow + 128;
            float dot = 0.f;
#pragma unroll
            for (int c = 0; c < 8; ++c) { const u32x4 w = ((const u32x4*)krow)[c];
                dot += q[8 * c] * bflo(w.x) + q[8 * c + 1] * bfhi(w.x) + q[8 * c + 2] * bflo(w.y) + q[8 * c + 3] * bfhi(w.y) + q[8 * c + 4] * bflo(w.z) + q[8 * c + 5] * bfhi(w.z) + q[8 * c + 6] * bflo(w.w) + q[8 * c + 7] * bfhi(w.w); }
            const float sc = dot - slope2 * (float)(t - s);
            const float mnew = fmaxf(mrun, sc), alpha = fexp2(mrun - mnew), p = fexp2(sc - mnew);
            l = l * alpha + p; mrun = mnew;
#pragma unroll
            for (int c = 0; c < 8; ++c) { const u32x4 w = ((const u32x4*)vrow)[c];
                o[8 * c] = o[8 * c] * alpha + p * bflo(w.x); o[8 * c + 1] = o[8 * c + 1] * alpha + p * bfhi(w.x); o[8 * c + 2] = o[8 * c + 2] * alpha + p * bflo(w.y); o[8 * c + 3] = o[8 * c + 3] * alpha + p * bfhi(w.y);
                o[8 * c + 4] = o[8 * c + 4] * alpha + p * bflo(w.z); o[8 * c + 5] = o[8 * c + 5] * alpha + p * bfhi(w.z); o[8 * c + 6] = o[8 * c + 6] * alpha + p * bflo(w.w); o[8 * c + 7] = o[8 * c + 7] * alpha + p * bfhi(w.w); }
        }
        const float il = 1.0f / l;
        u32x4* op = (u32x4*)(AP + (size_t)m * D + hh * 64);
#pragma unroll
        for (int c = 0; c < 8; ++c) op[c] = (u32x4){pk2(o[8 * c] * il, o[8 * c + 1] * il), pk2(o[8 * c + 2] * il, o[8 * c + 3] * il), pk2(o[8 * c + 4] * il, o[8 * c + 5] * il), pk2(o[8 * c + 6] * il, o[8 * c + 7] * il)};
    }
    const bf16* Wsp = (const bf16*)(a.ws + WS_WSP); const float2* st = (const float2*)(a.ws + WS_STATS);
    const float* g_ln = a.in[5]; const float* b_ln = a.in[6]; const float* b_sp = a.in[8];
    for (int item = gid; item < T * 512; item += nthr) {
        const int m = item >> 9, c = item & 511, g = c >> 7, t = m & 127, m0 = m - t;
        const float gl = g_ln[c], bl = b_ln[c];
        const bf16* wrow = Wsp + ((size_t)g * 128 + t) * 128;
        float acc = 0.f;
        for (int s = 0; s <= t; ++s) {
            const float2 ms = st[m0 + s];
            const float vn = (bf2f(Z1[(size_t)(m0 + s) * Z1W + 1280 + c]) - ms.x) * ms.y * gl + bl;
            acc += bf2f(wrow[s]) * vn;
        }
        const float u = bf2f(Z1[(size_t)m * Z1W + 768 + c]);
        AP[(size_t)m * D + 512 + c] = (bf16)f2bf(u * (acc + b_sp[g * 128 + t]));
    }
}

struct EpiProjA { const bf16* Z2; bf16* TMP;
    DEV void operator()(int row, int col, float v) const { TMP[(size_t)row * D + col] = (bf16)f2bf(bf2f(Z2[(size_t)row * Z2W + col]) * v); } };
struct EpiProjB { const bf16* Z2; const bf16* TMP; bf16* MRG;
    DEV void operator()(int row, int col, float v) const { MRG[(size_t)row * D + col] = (bf16)f2bf(bf2f(TMP[(size_t)row * D + col]) + bf2f(Z2[(size_t)row * Z2W + 1024 + col]) * v); } };
struct EpiResid { const float* base; float* out;
    DEV void operator()(int row, int col, float v) const { out[(size_t)row * D + col] = base[(size_t)row * D + col] + v; } };

DEV void phase_router(Frame& F, const Args& a) {
    const float* x1 = a.out; const float* g_ffn = a.in[12]; const float* w_router = a.in[13]; const float* b_router = a.in[14];
    bf16* H2 = (bf16*)(a.ws + WS_H2); unsigned* gcount = (unsigned*)(a.ws + WS_CTL) + CW_GCOUNT; int* list = (int*)(a.ws + WS_LIST); u32x2* info = (u32x2*)(a.ws + WS_INFO);
    LAS float* wt = (LAS float*)F.lds;
    LAS unsigned* lcount = (LAS unsigned*)(F.lds + 131584);
    LAS unsigned* gbase = lcount + 32;
    LAS unsigned* rec = gbase + 32;
    const int lane = F.lane;
    for (int i = F.tid; i < D * NE; i += NTHREADS) { const int d = i >> 5, e = i & 31; wt[e * 1028 + d] = w_router[i]; }
    f32x4 gg[4];
#pragma unroll
    for (int j = 0; j < 4; ++j) gg[j] = *((const f32x4*)g_ffn + lane + 64 * j);
    const int my_e = lane >> 1; const float my_bias = b_router[my_e];
    for (int blk = F.vcu; blk < T / 128; blk += F.G) {
        if (F.tid < 32) lcount[F.tid] = 0u;
        __syncthreads();
        for (int rr = 0; rr < 16; ++rr) {
            const int rl = F.wave * 16 + rr, m = blk * 128 + rl;
            const f32x4* xr = (const f32x4*)(x1 + (size_t)m * D) + lane;
            f32x4 v[4]; float s = 0.f;
#pragma unroll
            for (int j = 0; j < 4; ++j) { v[j] = xr[64 * j]; s += (v[j].x * v[j].x + v[j].y * v[j].y) + (v[j].z * v[j].z + v[j].w * v[j].w); }
            const float rstd = 1.0f / sqrtf(wave_sum(s) * (1.f / D) + RMS_EPS);
#pragma unroll
            for (int j = 0; j < 4; ++j) v[j] = v[j] * rstd * gg[j];
            unsigned long long* o8 = (unsigned long long*)(H2 + (size_t)m * D) + lane;
#pragma unroll
            for (int j = 0; j < 4; ++j) o8[64 * j] = (unsigned long long)pk2(v[j].x, v[j].y) | ((unsigned long long)pk2(v[j].z, v[j].w) << 32);
            float part[32];
#pragma unroll
            for (int e = 0; e < 32; ++e) { float acc = 0.f;
#pragma unroll
                for (int j = 0; j < 4; ++j) { const f32x4 w = *(const LAS f32x4*)(wt + e * 1028 + 4 * lane + 256 * j); acc += (v[j].x * w.x + v[j].y * w.y) + (v[j].z * w.z + v[j].w * w.w); }
                part[e] = acc; }
#define TR_STEP(N, BIT, XM) { const bool hb = (lane >> BIT) & 1; _Pragma("unroll") for (int i = 0; i < N; ++i) { const float keep = hb ? part[i + N] : part[i]; const float send = hb ? part[i] : part[i + N]; part[i] = keep + __shfl_xor(send, XM); } }
            TR_STEP(16, 5, 32) TR_STEP(8, 4, 16) TR_STEP(4, 3, 8) TR_STEP(2, 2, 4) TR_STEP(1, 1, 2)
#undef TR_STEP
            float val = part[0] + __shfl_xor(part[0], 1) + my_bias;
            float topv[4]; int tope[4];
#pragma unroll
            for (int k = 0; k < 4; ++k) { const float mx = wave_max(val); const unsigned long long bal = __ballot(val == mx); const int src = __ffsll((long long)bal) - 1; const int ek = src >> 1;
                topv[k] = mx; tope[k] = ek; if (my_e == ek) val = -INFINITY; }
            const float e1 = __expf(topv[1] - topv[0]), e2 = __expf(topv[2] - topv[0]), e3 = __expf(topv[3] - topv[0]);
            const float inv = 1.0f / (1.0f + e1 + e2 + e3);
            if (lane < 4) {
                const int ek = lane == 0 ? tope[0] : lane == 1 ? tope[1] : lane == 2 ? tope[2] : tope[3];
                const float gk = (lane == 0 ? 1.0f : lane == 1 ? e1 : lane == 2 ? e2 : e3) * inv;
                const unsigned pos = atomicAdd((unsigned*)(lcount + ek), 1u);
                rec[(rl * 4 + lane) * 2] = (unsigned)ek | (pos << 8); rec[(rl * 4 + lane) * 2 + 1] = __builtin_bit_cast(unsigned, gk);
            }
        }
        __syncthreads();
        if (F.tid < 32) gbase[F.tid] = atomicAdd(gcount + F.tid, lcount[F.tid]);
        __syncthreads();
        { const int rl = F.tid >> 2, k = F.tid & 3, m = blk * 128 + rl; const unsigned w0 = rec[F.tid * 2], w1 = rec[F.tid * 2 + 1];
          const unsigned ek = w0 & 255u, gpos = gbase[ek] + (w0 >> 8);
          list[(size_t)ek * T + gpos] = m; info[(size_t)m * 4 + k] = (u32x2){ek | (gpos << 5), w1}; }
        __syncthreads();
    }
}

DEV void moe_layout(Frame& F, const Args& a) {
    volatile LAS int* L = (volatile LAS int*)(F.lds + LDS_CTL);
    if (F.tid == 0) {
        unsigned* gcount = (unsigned*)(a.ws + WS_CTL) + CW_GCOUNT; int st = 0;
        for (int e = 0; e < NE; ++e) { const int c = (int)__hip_atomic_load(gcount + e, __ATOMIC_RELAXED, __HIP_MEMORY_SCOPE_AGENT); L[LC_CNT + e] = c; L[LC_START + e] = st; st += (c + 255) & ~255; }
        L[LC_START + NE] = st; L[LC_TOTAL] = st;
        int sp = 0; while (sp < NE && 2 * L[LC_START + sp] < st) ++sp;
        L[LC_SPLIT] = sp;
    }
    __syncthreads();
}

DEV void phase_moe_up_ref(Frame& F, const Args& a) {
    moe_layout(F, a);
    volatile LAS int* L = (volatile LAS int*)(F.lds + LDS_CTL);
    const bf16* H2 = (const bf16*)(a.ws + WS_H2); const bf16* Wgu_t = (const bf16*)(a.ws + WS_WGU); bf16* ACT = (bf16*)(a.ws + WS_ACT); const int* list = (const int*)(a.ws + WS_LIST);
    const float* b_gate = a.in[16]; const float* b_up = a.in[18];
    const int r = F.lane & 31, h = F.lane >> 5, total = L[LC_TOTAL];
    const int items = (total / 32) * 32;
    for (int it = F.gw; it < items; it += F.NGW) {
        const int rt = it >> 5, ft = it & 31, s0 = rt * 32, f0 = ft * 32;
        int e = 0; while (e < NE - 1 && s0 >= L[LC_START + e + 1]) ++e;
        const int local = s0 + r - L[LC_START + e];
        const int tok = local < L[LC_CNT + e] ? list[(size_t)e * T + local] : 0;
        const bf16* ap = H2 + (size_t)tok * D + 8 * h;
        const bf16* bg = Wgu_t + ((size_t)e * 2048 + 256 * (f0 >> 7) + (f0 & 127) + r) * D + 8 * h; const bf16* bu = bg + (size_t)128 * D;
        f32x16 acca, accb;
#pragma unroll
        for (int i = 0; i < 16; ++i) { acca[i] = 0.f; accb[i] = 0.f; }
#pragma unroll 4
        for (int k0 = 0; k0 < D; k0 += 16) { const bf16x8 av = *(const bf16x8*)(ap + k0);
            acca = __builtin_amdgcn_mfma_f32_32x32x16_bf16(av, *(const bf16x8*)(bg + k0), acca, 0, 0, 0);
            accb = __builtin_amdgcn_mfma_f32_32x32x16_bf16(av, *(const bf16x8*)(bu + k0), accb, 0, 0, 0); }
        const float bgv = b_gate[e * FF + f0 + r], buv = b_up[e * FF + f0 + r];
#pragma unroll
        for (int i = 0; i < 16; ++i) ACT[(size_t)(s0 + crow(i, h)) * FF + f0 + r] = (bf16)f2bf(swiglu(acca[i] + bgv, accb[i] + buv));
    }
}
DEV void phase_moe_down_ref(Frame& F, const Args& a, int half) {
    moe_layout(F, a);
    volatile LAS int* L = (volatile LAS int*)(F.lds + LDS_CTL);
    const bf16* ACT = (const bf16*)(a.ws + WS_ACT); const bf16* Wd_t = (const bf16*)(a.ws + WS_WD); const float* b_down = a.in[20];
    const int r = F.lane & 31, h = F.lane >> 5, total = L[LC_TOTAL], srow = L[LC_START + L[LC_SPLIT]];
    const int row_lo = half == 0 ? 0 : srow, row_hi = half == 0 ? srow : total;
    bf16* Y = half == 0 ? (bf16*)(a.ws + WS_Y0) : (bf16*)(a.ws + WS_Y1) - (size_t)srow * D;
    const int items = ((row_hi - row_lo) / 32) * 32;
    for (int it = F.gw; it < items; it += F.NGW) {
        const int rt = it >> 5, nt = it & 31, s0 = row_lo + rt * 32, n0 = nt * 32;
        int e = 0; while (e < NE - 1 && s0 >= L[LC_START + e + 1]) ++e;
        const bf16* ap = ACT + (size_t)(s0 + r) * FF + 8 * h;
        const bf16* bp = Wd_t + ((size_t)e * D + n0 + r) * FF + 8 * h;
        f32x16 acc;
#pragma unroll
        for (int i = 0; i < 16; ++i) acc[i] = 0.f;
#pragma unroll 8
        for (int k0 = 0; k0 < FF; k0 += 16) acc = __builtin_amdgcn_mfma_f32_32x32x16_bf16(*(const bf16x8*)(ap + k0), *(const bf16x8*)(bp + k0), acc, 0, 0, 0);
        const float bd = b_down[e * D + n0 + r];
#pragma unroll
        for (int i = 0; i < 16; ++i) Y[(size_t)(s0 + crow(i, h)) * D + n0 + r] = (bf16)f2bf(acc[i] + bd);
    }
}

DEV void phase_combine(Frame& F, const Args& a) {
    moe_layout(F, a);
    volatile LAS int* L = (volatile LAS int*)(F.lds + LDS_CTL);
    const int srow = L[LC_START + L[LC_SPLIT]];
    const bf16* Y0 = (const bf16*)(a.ws + WS_Y0); const bf16* Y1 = (const bf16*)(a.ws + WS_Y1) - (size_t)srow * D;
    const u32x2* info = (const u32x2*)(a.ws + WS_INFO); bf16* HP = (bf16*)(a.ws + WS_HP); const float* g_ple = a.in[21];
    const int lane = F.lane;
    for (int m = F.gw; m < T; m += F.NGW) {
        f32x4* xr = (f32x4*)(a.out + (size_t)m * D) + lane;
        f32x4 v[4];
#pragma unroll
        for (int j = 0; j < 4; ++j) v[j] = xr[64 * j];
#pragma unroll
        for (int k = 0; k < 4; ++k) { const u32x2 w = info[(size_t)m * 4 + k]; const int e = w.x & 31, gpos = (int)(w.x >> 5); const unsigned wy = w.y; const float g = __uint_as_float(wy);
            const int row = L[LC_START + e] + gpos; const bf16* yr = (row < srow ? Y0 : Y1) + (size_t)row * D;
#pragma unroll
            for (int j = 0; j < 4; ++j) { const u32x2 yw = *((const u32x2*)yr + lane + 64 * j);
                v[j].x += g * bflo(yw.x); v[j].y += g * bfhi(yw.x); v[j].z += g * bflo(yw.y); v[j].w += g * bfhi(yw.y); } }
        float s = 0.f;
#pragma unroll
        for (int j = 0; j < 4; ++j) { xr[64 * j] = v[j]; s += (v[j].x * v[j].x + v[j].y * v[j].y) + (v[j].z * v[j].z + v[j].w * v[j].w); }
        const float rstd = 1.0f / sqrtf(wave_sum(s) * (1.f / D) + RMS_EPS);
        unsigned long long* o8 = (unsigned long long*)(HP + (size_t)m * D) + lane;
#pragma unroll
        for (int j = 0; j < 4; ++j) { const f32x4 gg = *((const f32x4*)g_ple + lane + 64 * j);
            o8[64 * j] = (unsigned long long)pk2(v[j].x * rstd * gg.x, v[j].y * rstd * gg.y) | ((unsigned long long)pk2(v[j].z * rstd * gg.z, v[j].w * rstd * gg.w) << 32); }
    }
}
struct EpiStoreBf16 { bf16* O; int ldc;
    DEV void operator()(int row, int col, float v) const { O[(size_t)row * ldc + col] = (bf16)f2bf(v); } };
struct EpiPle { const bf16* PP; float* out;
    DEV void operator()(int row, int col, float v) const { const size_t i = (size_t)row * D + col; out[i] = out[i] + sigmoidf_(v) * bf2f(PP[i]); } };

DEV void phase_final(Frame& F, const Args& a) {
    const float* g = a.in[24]; const int lane = F.lane;
    for (int m = F.gw; m < T; m += F.NGW) {
        f32x4* xr = (f32x4*)(a.out + (size_t)m * D) + lane;
        f32x4 v[4]; float s = 0.f;
#pragma unroll
        for (int j = 0; j < 4; ++j) { v[j] = xr[64 * j]; s += (v[j].x * v[j].x + v[j].y * v[j].y) + (v[j].z * v[j].z + v[j].w * v[j].w); }
        const float rstd = 1.0f / sqrtf(wave_sum(s) * (1.f / D) + RMS_EPS);
#pragma unroll
        for (int j = 0; j < 4; ++j) xr[64 * j] = v[j] * rstd * *((const f32x4*)g + lane + 64 * j);
    }
}


namespace pg8 {
constexpr int BM = 256, BK = 64, HALF = 128, HTB = HALF * BK * 2, STAGE_BYTES = 8 * HTB;
DEV int lds_byte(int r, int c) { const int st = (r >> 4) * 2 + (c >> 5), rr = r & 15, cc = c & 31, ob = rr * 64 + cc * 2; return st * 1024 + (ob ^ (((ob >> 9) & 1) << 5)); }
DEV void stage_rc(int b, int& R, int& C) { const int st = b / 1024, sb = b % 1024, swz = sb ^ (((sb >> 9) & 1) << 5); R = (st >> 1) * 16 + swz / 64; C = (st & 1) * 32 + (swz % 64) / 2; }
DEV int perm32(int rho) { const int n = rho >> 4, i = rho & 15; return 8 * (i >> 2) + 4 * n + (i & 3); }
struct Unit { int pm, pn, e, mt; };
DEV unsigned cvt_pk_bf16(float lo, float hi) { unsigned r; asm volatile("v_cvt_pk_bf16_f32 %0, %1, %2" : "=v"(r) : "v"(lo), "v"(hi)); return r; }

template <class Epi, class Sched, bool GATHER>
DEV void gemm_phase(LAS unsigned char* lds, const bf16* A, int lda, const bf16* Bt, int ldb, int K, const Sched& S, const Epi& E, const int* list, volatile LAS int* L) {
    const int tid = threadIdx.x, wid = __builtin_amdgcn_readfirstlane(tid >> 6), lane = tid & 63, wr = wid >> 2, wc = wid & 3, fr = lane & 15, fq = lane >> 4;
    const int nt = K / BK;
    unsigned voffA[2], voffB[2]; int RA[2], CA[2];
#pragma unroll
    for (int i = 0; i < 2; ++i) { int R, C; stage_rc(tid * 16 + i * 8192, R, C); const int Rb = Epi::PERM ? ((R & ~31) + perm32(R & 31)) : R;
        voffA[i] = (unsigned)(R * lda + C) * 2u; voffB[i] = (unsigned)(Rb * ldb + C) * 2u; RA[i] = R; CA[i] = C; }
    const size_t kstep = (size_t)(BK * 2);
    const size_t hstepA = (size_t)HALF * lda * 2, hstepB = (size_t)HALF * ldb * 2;
    const unsigned ldsw = (unsigned)wid * 1024u;
    const int aoff = lds_byte(wr * 64 + fr, fq * 8), boff = lds_byte(wc * 32 + fr, fq * 8);
#define PG8_SA(b, h) (((b) * 2 + (h)) * HTB)
#define PG8_SB(b, h) ((4 + (b) * 2 + (h)) * HTB)
#define PG8_STAGE(bufoff, gbase, voff) do { _Pragma("unroll") for (int _i = 0; _i < 2; ++_i) \
        __builtin_amdgcn_global_load_lds((const unsigned*)((const char*)(gbase) + (voff)[_i]), (LAS unsigned*)(lds + (bufoff) + ldsw + _i * 8192), 16, 0, 0); } while (0)
#define PG8_LDA(dst, b, h) do { _Pragma("unroll") for (int m = 0; m < 4; ++m) _Pragma("unroll") for (int k = 0; k < 2; ++k) dst[m][k] = *(const LAS bf16x8*)(lds + PG8_SA(b, h) + aoff + m * 2048 + k * 1024); } while (0)
#define PG8_LDB(dst, b, h) do { _Pragma("unroll") for (int n = 0; n < 2; ++n) _Pragma("unroll") for (int k = 0; k < 2; ++k) dst[n][k] = *(const LAS bf16x8*)(lds + PG8_SB(b, h) + boff + n * 2048 + k * 1024); } while (0)
#define PG8_MMA(ai, bj, At, Bt_) do { __builtin_amdgcn_s_setprio(1); _Pragma("unroll") for (int m = 0; m < 4; ++m) _Pragma("unroll") for (int n = 0; n < 2; ++n) _Pragma("unroll") for (int k = 0; k < 2; ++k) \
        acc[ai][bj][m][n] = __builtin_amdgcn_mfma_f32_16x16x32_bf16(Bt_[n][k], At[m][k], acc[ai][bj][m][n], 0, 0, 0); __builtin_amdgcn_s_setprio(0); } while (0)
#define PG8_WAIT_V(n) asm volatile("s_waitcnt vmcnt(" #n ")" ::: "memory")
#define PG8_WAIT_L(n) asm volatile("s_waitcnt lgkmcnt(" #n ")" ::: "memory")
#define PG8_BAR __builtin_amdgcn_s_barrier()
#define PG8_SCHED __builtin_amdgcn_sched_barrier(0)
    unsigned aoc[2][2], aon[2][2];
#define PG8_GATHER_OFFS(dst, u) do { _Pragma("unroll") for (int _h = 0; _h < 2; ++_h) _Pragma("unroll") for (int _i = 0; _i < 2; ++_i) { \
        const int _idx = (u).mt * 256 + _h * HALF + RA[_i]; const int _tok = _idx < L[LC_CNT + (u).e] ? list[(size_t)(u).e * T + _idx] : 0; \
        dst[_h][_i] = (unsigned)(_tok * lda + CA[_i]) * 2u; } } while (0)
    Unit cur, nxt; int ui = 0;
    if (!S.next(0, cur)) return;
    f32x4 acc[2][2][4][2];
#pragma unroll
    for (int a = 0; a < 2; ++a)
#pragma unroll
        for (int b = 0; b < 2; ++b)
#pragma unroll
            for (int m = 0; m < 4; ++m)
#pragma unroll
                for (int n = 0; n < 2; ++n) acc[a][b][m][n] = (f32x4){0.f, 0.f, 0.f, 0.f};
    bf16x8 At[4][2], B0[2][2], B1[2][2];
    const char* cA; const char* cB = (const char*)Bt + S.brow(cur) * (size_t)ldb * 2;
    if constexpr (GATHER) { cA = (const char*)A; PG8_GATHER_OFFS(aoc, cur); }
    else { cA = (const char*)A + (size_t)cur.pm * BM * lda * 2;
#pragma unroll
        for (int i = 0; i < 2; ++i) { aoc[0][i] = voffA[i]; aoc[1][i] = voffA[i] + (unsigned)hstepA; } }
    PG8_STAGE(PG8_SB(0, 0), cB, voffB); PG8_STAGE(PG8_SB(0, 1), cB + hstepB, voffB); PG8_STAGE(PG8_SA(0, 0), cA, aoc[0]); PG8_STAGE(PG8_SA(0, 1), cA, aoc[1]);
    if (wr == 1) PG8_BAR;
    PG8_WAIT_V(2); PG8_BAR;
    PG8_STAGE(PG8_SB(1, 0), cB + kstep, voffB); PG8_STAGE(PG8_SA(1, 0), cA + kstep, aoc[0]); PG8_STAGE(PG8_SB(1, 1), cB + hstepB + kstep, voffB);
    PG8_WAIT_V(6); PG8_BAR;
    for (;;) {
        const bool has_next = S.next(ui + 1, nxt);
        const char* nA; const char* nB = has_next ? (const char*)Bt + S.brow(nxt) * (size_t)ldb * 2 : cB;
        if constexpr (GATHER) { nA = cA; if (has_next) PG8_GATHER_OFFS(aon, nxt); else {
#pragma unroll
            for (int h = 0; h < 2; ++h)
#pragma unroll
                for (int i = 0; i < 2; ++i) aon[h][i] = aoc[h][i]; } }
        else { nA = has_next ? (const char*)A + (size_t)nxt.pm * BM * lda * 2 : cA; }
#pragma unroll 1
        for (int t = 0; t < nt; t += 2) {
            const bool last = (t == nt - 2);
            const char* a1 = cA + (size_t)(t + 1) * kstep;
            const char* a2 = last ? nA : cA + (size_t)(t + 2) * kstep; const char* b2 = last ? nB : cB + (size_t)(t + 2) * kstep;
            const char* a3 = a2 + kstep; const char* b3 = b2 + kstep;
            unsigned ao2[2][2];
#pragma unroll
            for (int h = 0; h < 2; ++h)
#pragma unroll
                for (int i = 0; i < 2; ++i) ao2[h][i] = GATHER ? (last ? aon[h][i] : aoc[h][i]) : aoc[h][i];
            PG8_LDB(B0, 0, 0); PG8_LDB(B1, 0, 1); PG8_SCHED; PG8_LDA(At, 0, 0); PG8_STAGE(PG8_SA(1, 1), a1, aoc[1]);
            PG8_WAIT_V(8); PG8_WAIT_L(0); PG8_BAR; PG8_MMA(0, 0, At, B0); PG8_MMA(0, 1, At, B1); PG8_BAR; PG8_SCHED;
            PG8_LDA(At, 0, 1); PG8_STAGE(PG8_SB(0, 0), b2, voffB); PG8_STAGE(PG8_SB(0, 1), b2 + hstepB, voffB); PG8_STAGE(PG8_SA(0, 0), a2, ao2[0]);
            PG8_WAIT_V(8); PG8_WAIT_L(0); PG8_BAR; PG8_MMA(1, 0, At, B0); PG8_MMA(1, 1, At, B1); PG8_BAR; PG8_SCHED;
            PG8_LDB(B0, 1, 0); PG8_LDB(B1, 1, 1); PG8_SCHED; PG8_LDA(At, 1, 0); PG8_STAGE(PG8_SA(0, 1), a2, ao2[1]);
            PG8_WAIT_V(8); PG8_WAIT_L(0); PG8_BAR; PG8_MMA(0, 0, At, B0); PG8_MMA(0, 1, At, B1); PG8_BAR; PG8_SCHED;
            PG8_LDA(At, 1, 1); PG8_STAGE(PG8_SB(1, 0), b3, voffB); PG8_STAGE(PG8_SB(1, 1), b3 + hstepB, voffB); PG8_STAGE(PG8_SA(1, 0), a3, ao2[0]);
            PG8_WAIT_V(8); PG8_WAIT_L(0); PG8_BAR; PG8_MMA(1, 0, At, B0); PG8_MMA(1, 1, At, B1); PG8_BAR; PG8_SCHED;
        }
        if (wr == 0) PG8_BAR;
        E(acc, cur, wr, wc, fr, fq);
        if (!has_next) break;
#pragma unroll
        for (int a = 0; a < 2; ++a)
#pragma unroll
            for (int b = 0; b < 2; ++b)
#pragma unroll
                for (int m = 0; m < 4; ++m)
#pragma unroll
                    for (int n = 0; n < 2; ++n) acc[a][b][m][n] = (f32x4){0.f, 0.f, 0.f, 0.f};
        cur = nxt; cA = nA; cB = nB; ++ui;
        if constexpr (GATHER) {
#pragma unroll
            for (int h = 0; h < 2; ++h)
#pragma unroll
                for (int i = 0; i < 2; ++i) aoc[h][i] = aon[h][i]; }
        if (wr == 1) PG8_BAR;
    }
    PG8_WAIT_V(0);
    PG8_BAR;
#undef PG8_SA
#undef PG8_SB
#undef PG8_STAGE
#undef PG8_LDA
#undef PG8_LDB
#undef PG8_MMA
#undef PG8_WAIT_V
#undef PG8_WAIT_L
#undef PG8_BAR
#undef PG8_SCHED
#undef PG8_GATHER_OFFS
}

struct StaticOrder {
    int nM, nN, nwg, G, c;
    DEV void init(int M, int N, int G_, int c_) { nM = M / BM; nN = N / BM; nwg = nM * nN; G = G_; c = c_; }
    DEV bool next(int i, Unit& u) const {
        const long Lx = (long)i * G + c; if (Lx >= nwg) return false;
        int wgid = (int)Lx; { const int q = nwg / 8, r = nwg % 8, xcd = wgid % 8, off = wgid / 8; wgid = (xcd < r ? xcd * (q + 1) : r * (q + 1) + (xcd - r) * q) + off; }
        const int nig = 8 * nN, gid = wgid / nig, fm = gid * 8, gsz = (nM - fm) < 8 ? (nM - fm) : 8;
        u.pm = fm + ((wgid % nig) % gsz); u.pn = (wgid % nig) / gsz; u.e = 0; u.mt = 0; return true;
    }
    DEV size_t brow(const Unit& u) const { return (size_t)u.pn * BM; }
};
struct MoeOrder {
    volatile LAS int* L; int e_lo, e_hi, NT, G, c, brows;
    DEV bool next(int i, Unit& u) const {
        const int per = G >> 3; int U = (i * 8 + (c & 7)) * per + (c >> 3);
        int e = e_lo;
        for (; e < e_hi; ++e) { const int nu = (((L[LC_CNT + e] + 255) >> 8)) * NT; if (U < nu) break; U -= nu; }
        if (e >= e_hi) return false;
        const int GS = 32 / NT, nm = (L[LC_CNT + e] + 255) >> 8, g = U >> 5, q2 = U - (g << 5);
        const int gsz = (nm - GS * g) < GS ? (nm - GS * g) : GS;
        u.e = e; u.pn = q2 / gsz; u.mt = GS * g + q2 % gsz; u.pm = (L[LC_START + e] >> 8) + u.mt; return true;
    }
    DEV size_t brow(const Unit& u) const { return (size_t)u.e * brows + (size_t)u.pn * BM; }
};
}

using pg8::Unit;
DEV u32x4 pack8(const f32x4& v0, const f32x4& v1) { u32x4 w; w.x = pg8::cvt_pk_bf16(v0[0], v0[1]); w.y = pg8::cvt_pk_bf16(v0[2], v0[3]); w.z = pg8::cvt_pk_bf16(v1[0], v1[1]); w.w = pg8::cvt_pk_bf16(v1[2], v1[3]); return w; }
DEV f32x4 lo4(const u32x4& w) { return (f32x4){bflo(w.x), bfhi(w.x), bflo(w.y), bfhi(w.y)}; }
DEV f32x4 hi4(const u32x4& w) { return (f32x4){bflo(w.z), bfhi(w.z), bflo(w.w), bfhi(w.w)}; }
struct FEpiZ { static constexpr bool PERM = true; bf16* Z1; bf16* Z2;
    DEV void operator()(const f32x4 (&acc)[2][2][4][2], const Unit& u, int wr, int wc, int fr, int fq) const {
        const int row0 = u.pm * 256 + wr * 64 + fr, pn = u.pn;
        bf16* base; int ld, colt, kind;
        if (pn < 7) { base = Z1; ld = Z1W; colt = pn * 256; kind = pn < 2 ? 0 : (pn == 2 ? 1 : 2); } else { base = Z2; ld = Z2W; colt = (pn - 7) * 256; kind = 3; }
        const int col0 = colt + wc * 32 + 8 * fq;
#pragma unroll
        for (int ai = 0; ai < 2; ++ai)
#pragma unroll
            for (int m = 0; m < 4; ++m) { bf16* rowp = base + (size_t)(row0 + ai * 128 + m * 16) * ld + col0;
#pragma unroll
                for (int bj = 0; bj < 2; ++bj) { f32x4 v0 = acc[ai][bj][m][0], v1 = acc[ai][bj][m][1];
                    if (kind == 0) { v0 = v0 * QSCALE; v1 = v1 * QSCALE; }
                    else if (kind == 2) {
#pragma unroll
                        for (int j = 0; j < 4; ++j) { v0[j] = gelu_tanh(v0[j]); v1[j] = gelu_tanh(v1[j]); } }
                    else if (kind == 3) {
#pragma unroll
                        for (int j = 0; j < 4; ++j) { v0[j] = sigmoidf_(v0[j]); v1[j] = sigmoidf_(v1[j]); } }
                    *(u32x4*)(rowp + bj * 128) = pack8(v0, v1); } }
    } };
struct FEpiProjA { static constexpr bool PERM = true; const bf16* Z2; bf16* TMP;
    DEV void operator()(const f32x4 (&acc)[2][2][4][2], const Unit& u, int wr, int wc, int fr, int fq) const {
        const int row0 = u.pm * 256 + wr * 64 + fr, col0 = u.pn * 256 + wc * 32 + 8 * fq;
#pragma unroll
        for (int ai = 0; ai < 2; ++ai)
#pragma unroll
            for (int m = 0; m < 4; ++m) { const size_t r = (size_t)(row0 + ai * 128 + m * 16);
#pragma unroll
                for (int bj = 0; bj < 2; ++bj) { const u32x4 g = *(const u32x4*)(Z2 + r * Z2W + col0 + bj * 128);
                    *(u32x4*)(TMP + r * D + col0 + bj * 128) = pack8(acc[ai][bj][m][0] * lo4(g), acc[ai][bj][m][1] * hi4(g)); } }
    } };
struct FEpiProjB { static constexpr bool PERM = true; const bf16* Z2; const bf16* TMP; bf16* MRG;
    DEV void operator()(const f32x4 (&acc)[2][2][4][2], const Unit& u, int wr, int wc, int fr, int fq) const {
        const int row0 = u.pm * 256 + wr * 64 + fr, col0 = u.pn * 256 + wc * 32 + 8 * fq;
#pragma unroll
        for (int ai = 0; ai < 2; ++ai)
#pragma unroll
            for (int m = 0; m < 4; ++m) { const size_t r = (size_t)(row0 + ai * 128 + m * 16);
#pragma unroll
                for (int bj = 0; bj < 2; ++bj) { const u32x4 g = *(const u32x4*)(Z2 + r * Z2W + 1024 + col0 + bj * 128); const u32x4 t = *(const u32x4*)(TMP + r * D + col0 + bj * 128);
                    *(u32x4*)(MRG + r * D + col0 + bj * 128) = pack8(lo4(t) + acc[ai][bj][m][0] * lo4(g), hi4(t) + acc[ai][bj][m][1] * hi4(g)); } }
    } };
struct FEpiResid { static constexpr bool PERM = false; const float* base; float* out;
    DEV void operator()(const f32x4 (&acc)[2][2][4][2], const Unit& u, int wr, int wc, int fr, int fq) const {
        const int row0 = u.pm * 256 + wr * 64 + fr, col0 = u.pn * 256 + wc * 32 + 4 * fq;
#pragma unroll
        for (int ai = 0; ai < 2; ++ai)
#pragma unroll
            for (int m = 0; m < 4; ++m) { const size_t off = (size_t)(row0 + ai * 128 + m * 16) * D + col0;
#pragma unroll
                for (int bj = 0; bj < 2; ++bj)
#pragma unroll
                    for (int n = 0; n < 2; ++n) *(f32x4*)(out + off + bj * 128 + n * 16) = *(const f32x4*)(base + off + bj * 128 + n * 16) + acc[ai][bj][m][n]; }
    } };
struct FEpiMoeUp { static constexpr bool PERM = true; const float* b_gate; const float* b_up; bf16* ACT;
    DEV void operator()(const f32x4 (&acc)[2][2][4][2], const Unit& u, int wr, int wc, int fr, int fq) const {
        const int row0 = u.pm * 256 + wr * 64 + fr, f0 = u.pn * 128 + wc * 32 + 8 * fq;
        const f32x4 bg0 = *(const f32x4*)(b_gate + u.e * FF + f0), bg1 = *(const f32x4*)(b_gate + u.e * FF + f0 + 4), bu0 = *(const f32x4*)(b_up + u.e * FF + f0), bu1 = *(const f32x4*)(b_up + u.e * FF + f0 + 4);
#pragma unroll
        for (int ai = 0; ai < 2; ++ai)
#pragma unroll
            for (int m = 0; m < 4; ++m) { f32x4 a0 = acc[ai][0][m][0] + bg0, a1 = acc[ai][0][m][1] + bg1, b0 = acc[ai][1][m][0] + bu0, b1 = acc[ai][1][m][1] + bu1;
#pragma unroll
                for (int j = 0; j < 4; ++j) { a0[j] = swiglu(a0[j], b0[j]); a1[j] = swiglu(a1[j], b1[j]); }
                *(u32x4*)(ACT + (size_t)(row0 + ai * 128 + m * 16) * FF + f0) = pack8(a0, a1); }
    } };
struct FEpiMoeDown { static constexpr bool PERM = true; const float* b_down; bf16* Y;
    DEV void operator()(const f32x4 (&acc)[2][2][4][2], const Unit& u, int wr, int wc, int fr, int fq) const {
        const int row0 = u.pm * 256 + wr * 64 + fr, col0 = u.pn * 256 + wc * 32 + 8 * fq;
        f32x4 bv[2][2];
#pragma unroll
        for (int bj = 0; bj < 2; ++bj)
#pragma unroll
            for (int n = 0; n < 2; ++n) bv[bj][n] = *(const f32x4*)(b_down + u.e * D + col0 + bj * 128 + 4 * n);
#pragma unroll
        for (int ai = 0; ai < 2; ++ai)
#pragma unroll
            for (int m = 0; m < 4; ++m) { bf16* rowp = Y + (size_t)(row0 + ai * 128 + m * 16) * D + col0;
#pragma unroll
                for (int bj = 0; bj < 2; ++bj) *(u32x4*)(rowp + bj * 128) = pack8(acc[ai][bj][m][0] + bv[bj][0], acc[ai][bj][m][1] + bv[bj][1]); }
    } };
struct FEpiBf16 { static constexpr bool PERM = true; bf16* O; int ldc;
    DEV void operator()(const f32x4 (&acc)[2][2][4][2], const Unit& u, int wr, int wc, int fr, int fq) const {
        const int row0 = u.pm * 256 + wr * 64 + fr, col0 = u.pn * 256 + wc * 32 + 8 * fq;
#pragma unroll
        for (int ai = 0; ai < 2; ++ai)
#pragma unroll
            for (int m = 0; m < 4; ++m) { bf16* rowp = O + (size_t)(row0 + ai * 128 + m * 16) * ldc + col0;
#pragma unroll
                for (int bj = 0; bj < 2; ++bj) *(u32x4*)(rowp + bj * 128) = pack8(acc[ai][bj][m][0], acc[ai][bj][m][1]); }
    } };
struct FEpiPle { static constexpr bool PERM = false; const bf16* PP; float* out;
    DEV void operator()(const f32x4 (&acc)[2][2][4][2], const Unit& u, int wr, int wc, int fr, int fq) const {
        const int row0 = u.pm * 256 + wr * 64 + fr, col0 = u.pn * 256 + wc * 32 + 4 * fq;
#pragma unroll
        for (int ai = 0; ai < 2; ++ai)
#pragma unroll
            for (int m = 0; m < 4; ++m) { const size_t off = (size_t)(row0 + ai * 128 + m * 16) * D + col0;
#pragma unroll
                for (int bj = 0; bj < 2; ++bj)
#pragma unroll
                    for (int n = 0; n < 2; ++n) { const size_t o = off + bj * 128 + n * 16; const u32x2 pw = *(const u32x2*)(PP + o); const f32x4 a = acc[ai][bj][m][n];
                        f32x4 r = *(const f32x4*)(out + o);
                        r[0] += sigmoidf_(a[0]) * bflo(pw.x); r[1] += sigmoidf_(a[1]) * bfhi(pw.x); r[2] += sigmoidf_(a[2]) * bflo(pw.y); r[3] += sigmoidf_(a[3]) * bfhi(pw.y);
                        *(f32x4*)(out + o) = r; }
                asm volatile("" ::: "memory"); }
    } };


#define MFMA32(a, b, c) __builtin_amdgcn_mfma_f32_32x32x16_bf16((a), (b), (c), 0, 0, 0)
DEV void phase_mixers_fast(Frame& F, const Args& a) {
    const bf16* Z1 = (const bf16*)(a.ws + WS_Z1); bf16* AP = (bf16*)(a.ws + WS_AP);
    const int tid = F.tid, lane = F.lane, r = lane & 31, h = lane >> 5, wave = F.wave;
    {
        LAS unsigned char* Kl = F.lds;
        LAS unsigned char* Vl = F.lds + 36864;
        LAS float* wsf = (LAS float*)(F.lds + 70144) + wave * 64;
        const float* sinks = a.in[4];
        for (int u = F.vcu; u < 512; u += F.G) {
            const int kvh = u & 1, bn = u >> 1, b = bn >> 4, n = bn & 15;
            const int tok0 = b * SEQ + n * 128, key0 = tok0 - 128;
            __syncthreads();
#pragma unroll
            for (int i = 0; i < 4; ++i) { const int idx = tid + 512 * i, key = idx >> 3, ch = idx & 7;
                u32x4 v = (u32x4){0u, 0u, 0u, 0u};
                if (n > 0 || key >= 128) v = *(const u32x4*)(Z1 + (size_t)(key0 + key) * Z1W + 512 + kvh * 64 + ch * 8);
                *(LAS u32x4*)(Kl + key * 144 + ch * 16) = v; }
#pragma unroll
            for (int i = 0; i < 2; ++i) { const int idx = tid + 512 * i, kp = idx >> 3, ch = idx & 7;
                u32x4 v0 = (u32x4){0u, 0u, 0u, 0u}, v1 = v0;
                if (n > 0 || kp >= 64) { const bf16* vp = Z1 + (size_t)(key0 + 2 * kp) * Z1W + 640 + kvh * 64 + ch * 8; v0 = *(const u32x4*)vp; v1 = *(const u32x4*)(vp + Z1W); }
                LAS unsigned char* dst = Vl + (ch * 8) * 520 + kp * 4;
                *(LAS unsigned*)(dst + 0 * 520) = (v0.x & 0xffffu) | (v1.x << 16); *(LAS unsigned*)(dst + 1 * 520) = (v0.x >> 16) | (v1.x & 0xffff0000u);
                *(LAS unsigned*)(dst + 2 * 520) = (v0.y & 0xffffu) | (v1.y << 16); *(LAS unsigned*)(dst + 3 * 520) = (v0.y >> 16) | (v1.y & 0xffff0000u);
                *(LAS unsigned*)(dst + 4 * 520) = (v0.z & 0xffffu) | (v1.z << 16); *(LAS unsigned*)(dst + 5 * 520) = (v0.z >> 16) | (v1.z & 0xffff0000u);
                *(LAS unsigned*)(dst + 6 * 520) = (v0.w & 0xffffu) | (v1.w << 16); *(LAS unsigned*)(dst + 7 * 520) = (v0.w >> 16) | (v1.w & 0xffff0000u); }
            __syncthreads();
            const int g = wave >> 1, qh = wave & 1, hh = kvh * 4 + g;
            const float slope2 = fexp2(-(float)(hh + 1)) * LOG2E, sink2 = sinks[hh] * LOG2E;
#pragma unroll 1
            for (int qs = 0; qs < 2; ++qs) {
                const int q0 = qh * 64 + qs * 32, kt0 = q0 >> 5, ql = q0 + r;
                bf16x8 qf[4];
#pragma unroll
                for (int ds = 0; ds < 4; ++ds) qf[ds] = *(const bf16x8*)(Z1 + (size_t)(tok0 + ql) * Z1W + hh * 64 + 16 * ds + 8 * h);
                f32x16 p[5];
#pragma unroll
                for (int t = 0; t < 5; ++t) {
#pragma unroll
                    for (int i = 0; i < 16; ++i) p[t][i] = 0.f;
                    const LAS unsigned char* kb = Kl + (32 * (kt0 + t) + r) * 144 + 16 * h;
#pragma unroll
                    for (int ds = 0; ds < 4; ++ds) p[t] = MFMA32(*(const LAS bf16x8*)(kb + 32 * ds), qf[ds], p[t]);
                }
                float mx = sink2;
#pragma unroll
                for (int t = 0; t < 5; ++t)
#pragma unroll
                    for (int i = 0; i < 16; ++i) { const int sk = 32 * (kt0 + t) + crow(i, h), dist = ql + 128 - sk;
                        const bool ok = ((unsigned)dist < 128u) && (n > 0 || sk >= 128);
                        const float v = ok ? p[t][i] - slope2 * (float)dist : -INFINITY; p[t][i] = v; mx = fmaxf(mx, v); }
                mx = fmaxf(mx, __shfl_xor(mx, 32));
                float ls = 0.f;
#pragma unroll
                for (int t = 0; t < 5; ++t)
#pragma unroll
                    for (int i = 0; i < 16; ++i) { const float e = fexp2(p[t][i] - mx); p[t][i] = e; ls += e; }
                ls += __shfl_xor(ls, 32); ls += fexp2(sink2 - mx);
                f32x16 o[2];
#pragma unroll
                for (int i = 0; i < 16; ++i) { o[0][i] = 0.f; o[1][i] = 0.f; }
#pragma unroll
                for (int t = 0; t < 5; ++t)
#pragma unroll
                    for (int s2 = 0; s2 < 2; ++s2) {
                        u32x4 pw; pw.x = pg8::cvt_pk_bf16(p[t][8 * s2 + 0], p[t][8 * s2 + 1]); pw.y = pg8::cvt_pk_bf16(p[t][8 * s2 + 2], p[t][8 * s2 + 3]);
                        pw.z = pg8::cvt_pk_bf16(p[t][8 * s2 + 4], p[t][8 * s2 + 5]); pw.w = pg8::cvt_pk_bf16(p[t][8 * s2 + 6], p[t][8 * s2 + 7]);
                        const bf16x8 pf = __builtin_bit_cast(bf16x8, pw);
#pragma unroll
                        for (int db = 0; db < 2; ++db) { const LAS unsigned char* vb = Vl + (db * 32 + r) * 520 + (32 * (kt0 + t) + 16 * s2 + 4 * h) * 2;
                            const u32x2 lo = *(const LAS u32x2*)vb, hi = *(const LAS u32x2*)(vb + 16);
                            u32x4 vw; vw.x = lo.x; vw.y = lo.y; vw.z = hi.x; vw.w = hi.y;
                            o[db] = MFMA32(pf, __builtin_bit_cast(bf16x8, vw), o[db]); }
                    }
                asm volatile("" ::: "memory");
                if (h == 0) wsf[r] = ls;
                asm volatile("s_waitcnt lgkmcnt(0)" ::: "memory");
                bf16* op = AP + (size_t)tok0 * D + hh * 64 + r;
#pragma unroll
                for (int i = 0; i < 16; ++i) { const int q = q0 + crow(i, h); const float il = frcp(wsf[crow(i, h)]);
                    op[(size_t)q * D] = (bf16)f2bf(o[0][i] * il); op[(size_t)q * D + 32] = (bf16)f2bf(o[1][i] * il); }
                asm volatile("s_waitcnt lgkmcnt(0)" ::: "memory");
            }
        }
    }
    {
        LAS unsigned char* vT = F.lds;
        LAS float* stl = (LAS float*)(F.lds + 69632);
        const bf16* Wsp = (const bf16*)(a.ws + WS_WSP); const float* g_ln = a.in[5]; const float* b_ln = a.in[6]; const float* b_sp = a.in[8];
        for (int u = F.vcu; u < 256; u += F.G) {
            const int tok0 = u * 128;
            __syncthreads();
            for (int rr = 0; rr < 16; ++rr) { const int t = wave * 16 + rr;
                const u32x4 w = *((const u32x4*)(Z1 + (size_t)(tok0 + t) * Z1W + 1280) + lane);
                float v[8] = {bflo(w.x), bfhi(w.x), bflo(w.y), bfhi(w.y), bflo(w.z), bfhi(w.z), bflo(w.w), bfhi(w.w)};
                float s = 0.f;
#pragma unroll
                for (int j = 0; j < 8; ++j) s += v[j];
                const float mean = wave_sum(s) * (1.f / 512.f); float q = 0.f;
#pragma unroll
                for (int j = 0; j < 8; ++j) { const float d = v[j] - mean; q += d * d; }
                const float rstd = 1.0f / sqrtf(wave_sum(q) * (1.f / 512.f) + LN_EPS);
                if (lane == 0) { stl[2 * t] = mean; stl[2 * t + 1] = rstd; } }
#pragma unroll 1
            for (int hf = 0; hf < 2; ++hf) {
                __syncthreads();
#pragma unroll
                for (int i = 0; i < 4; ++i) { const int c8 = wave * 4 + i, tp = lane, ch0 = 256 * hf + 8 * c8;
                    const bf16* vp = Z1 + (size_t)(tok0 + 2 * tp) * Z1W + 1280 + ch0;
                    const u32x4 w0 = *(const u32x4*)vp, w1 = *(const u32x4*)(vp + Z1W);
                    const float m0 = stl[4 * tp], r0 = stl[4 * tp + 1], m1 = stl[4 * tp + 2], r1 = stl[4 * tp + 3];
                    const f32x4 ga = *(const f32x4*)(g_ln + ch0), gb = *(const f32x4*)(g_ln + ch0 + 4), ba = *(const f32x4*)(b_ln + ch0), bb = *(const f32x4*)(b_ln + ch0 + 4);
                    LAS unsigned char* dst = vT + (8 * c8) * 272 + tp * 4;
#define VT_W(j, w0c, w1c, gg, bbv, SEL) *(LAS unsigned*)(dst + (j) * 272) = pg8::cvt_pk_bf16((SEL(w0c) - m0) * r0 * (gg) + (bbv), (SEL(w1c) - m1) * r1 * (gg) + (bbv))
                    VT_W(0, w0.x, w1.x, ga.x, ba.x, bflo); VT_W(1, w0.x, w1.x, ga.y, ba.y, bfhi); VT_W(2, w0.y, w1.y, ga.z, ba.z, bflo); VT_W(3, w0.y, w1.y, ga.w, ba.w, bfhi);
                    VT_W(4, w0.z, w1.z, gb.x, bb.x, bflo); VT_W(5, w0.z, w1.z, gb.y, bb.y, bfhi); VT_W(6, w0.w, w1.w, gb.z, bb.z, bflo); VT_W(7, w0.w, w1.w, gb.w, bb.w, bfhi);
#undef VT_W
                }
                __syncthreads();
                const int gl = wave >> 2, cq = wave & 3, g = 2 * hf + gl, chb = gl * 128 + cq * 32;
                const int chg = 256 * hf + chb + r;
#pragma unroll 1
                for (int tt = 0; tt < 4; ++tt) {
                    f32x16 acc;
#pragma unroll
                    for (int i = 0; i < 16; ++i) acc[i] = 0.f;
                    const bf16* wp = Wsp + ((size_t)g * 128 + 32 * tt + r) * 128 + 8 * h;
                    const LAS unsigned char* bp = vT + (chb + r) * 272 + 16 * h;
#pragma unroll 2
                    for (int ss = 0; ss < 2 * tt + 2; ++ss) acc = MFMA32(*(const bf16x8*)(wp + 16 * ss), *(const LAS bf16x8*)(bp + 32 * ss), acc);
#pragma unroll
                    for (int i = 0; i < 16; ++i) { const int t = 32 * tt + crow(i, h); const size_t tok = (size_t)(tok0 + t);
                        const float uu = bf2f(Z1[tok * Z1W + 768 + chg]);
                        AP[tok * D + 512 + chg] = (bf16)f2bf(uu * (acc[i] + b_sp[g * 128 + t])); }
                }
            }
        }
    }
    __syncthreads();
}

constexpr int NPHASES = 14;
__global__ void __launch_bounds__(NTHREADS, 2) fwd(Args a) {
    extern __shared__ __attribute__((aligned(16))) unsigned char lds_raw[];
    Frame F;
    F.lds = (LAS unsigned char*)lds_raw;
    F.tid = threadIdx.x; F.lane = F.tid & 63; F.wave = __builtin_amdgcn_readfirstlane(F.tid >> 6);
    F.G = gridDim.x; { const int bx = blockIdx.x; F.vcu = (F.G % 8 == 0) ? (bx % 8) * (F.G / 8) + bx / 8 : bx; }
    F.gw = F.vcu * NWAVES + F.wave; F.NGW = F.G * NWAVES;
    for (int u = F.tid; u < (LDS_BYTES - LDS_CTL) / 4; u += NTHREADS) ((LAS unsigned*)(F.lds + LDS_CTL))[u] = 0u;
    __syncthreads();
    unsigned* ctl = (unsigned*)(a.ws + WS_CTL);
    const bool one = (a.ph_hi - a.ph_lo) > 1;
    XcdBarrier bar; bar.bar = ctl + CW_BAR; bar.x = 0; bar.st = nullptr;
    if (one) bar = xcd_barrier_post(ctl + CW_BAR, (volatile LAS unsigned*)(F.lds + LDS_CTL) + LC_BAR);
    unsigned char* ws = a.ws;
#define IN(k) (a.ph_lo <= (k) && (k) < a.ph_hi)
#define SEAM(k) do { if (IN(k) && IN((k) + 1)) xcd_barrier(bar); } while (0)
    if (IN(0)) { phase_prologue(F, a); } SEAM(0);
    volatile LAS int* Lc = (volatile LAS int*)(F.lds + LDS_CTL);
#if FAST_G1
    if (IN(1)) { FEpiZ E{(bf16*)(ws + WS_Z1), (bf16*)(ws + WS_Z2)}; pg8::StaticOrder S; S.init(T, NZ, F.G, (int)blockIdx.x);
        pg8::gemm_phase<FEpiZ, pg8::StaticOrder, false>(F.lds, (const bf16*)a.out, D, (const bf16*)(ws + WS_WIN), D, D, S, E, nullptr, Lc); } SEAM(1);
#else
    if (IN(1)) { EpiZ E{(bf16*)(ws + WS_Z1), (bf16*)(ws + WS_Z2)}; ngemm_wave((const bf16*)a.out, D, (const bf16*)(ws + WS_WIN), D, T / 32, NZ / 32, D, F, E); } SEAM(1);
#endif
#if FAST_MIX
    if (IN(3)) { phase_mixers_fast(F, a); } SEAM(3);
#else
    if (IN(2)) { phase_lnstats(F, a); } SEAM(2);
    if (IN(3)) { phase_mixers_ref(F, a); } SEAM(3);
#endif
#if FAST_G4
    if (IN(4)) { FEpiProjA E{(const bf16*)(ws + WS_Z2), (bf16*)(ws + WS_TMP)}; pg8::StaticOrder S; S.init(T, D, F.G, (int)blockIdx.x);
        pg8::gemm_phase<FEpiProjA, pg8::StaticOrder, false>(F.lds, (const bf16*)(ws + WS_AP), D, (const bf16*)(ws + WS_WAB), D, 512, S, E, nullptr, Lc); } SEAM(4);
    if (IN(5)) { FEpiProjB E{(const bf16*)(ws + WS_Z2), (const bf16*)(ws + WS_TMP), (bf16*)(ws + WS_MRG)}; pg8::StaticOrder S; S.init(T, D, F.G, (int)blockIdx.x);
        pg8::gemm_phase<FEpiProjB, pg8::StaticOrder, false>(F.lds, (const bf16*)(ws + WS_AP) + 512, D, (const bf16*)(ws + WS_WAB) + 512, D, 512, S, E, nullptr, Lc); } SEAM(5);
    if (IN(6)) { FEpiResid E{a.in[0], a.out}; pg8::StaticOrder S; S.init(T, D, F.G, (int)blockIdx.x);
        pg8::gemm_phase<FEpiResid, pg8::StaticOrder, false>(F.lds, (const bf16*)(ws + WS_MRG), D, (const bf16*)(ws + WS_WOUT), D, D, S, E, nullptr, Lc); } SEAM(6);
#else
    if (IN(4)) { EpiProjA E{(const bf16*)(ws + WS_Z2), (bf16*)(ws + WS_TMP)}; ngemm_wave((const bf16*)(ws + WS_AP), D, (const bf16*)(ws + WS_WAB), D, T / 32, D / 32, 512, F, E); } SEAM(4);
    if (IN(5)) { EpiProjB E{(const bf16*)(ws + WS_Z2), (const bf16*)(ws + WS_TMP), (bf16*)(ws + WS_MRG)}; ngemm_wave((const bf16*)(ws + WS_AP) + 512, D, (const bf16*)(ws + WS_WAB) + 512, D, T / 32, D / 32, 512, F, E); } SEAM(5);
    if (IN(6)) { EpiResid E{a.in[0], a.out}; ngemm_wave((const bf16*)(ws + WS_MRG), D, (const bf16*)(ws + WS_WOUT), D, T / 32, D / 32, D, F, E); } SEAM(6);
#endif
    if (IN(7)) { phase_router(F, a); } SEAM(7);
#if FAST_MOE
    if (IN(8)) { moe_layout(F, a); FEpiMoeUp E{a.in[16], a.in[18], (bf16*)(ws + WS_ACT)}; pg8::MoeOrder S{Lc, 0, NE, 8, F.G, (int)blockIdx.x, 2048};
        pg8::gemm_phase<FEpiMoeUp, pg8::MoeOrder, true>(F.lds, (const bf16*)(ws + WS_H2), D, (const bf16*)(ws + WS_WGU), D, D, S, E, (const int*)(ws + WS_LIST), Lc); } SEAM(8);
    if (IN(9)) { moe_layout(F, a); FEpiMoeDown E{a.in[20], (bf16*)(ws + WS_Y0)}; pg8::MoeOrder S{Lc, 0, Lc[LC_SPLIT], 4, F.G, (int)blockIdx.x, 1024};
        pg8::gemm_phase<FEpiMoeDown, pg8::MoeOrder, false>(F.lds, (const bf16*)(ws + WS_ACT), FF, (const bf16*)(ws + WS_WD), FF, FF, S, E, nullptr, Lc); } SEAM(9);
    if (IN(10)) { moe_layout(F, a); const int srow = Lc[LC_START + Lc[LC_SPLIT]]; FEpiMoeDown E{a.in[20], (bf16*)(ws + WS_Y1) - (size_t)srow * D}; pg8::MoeOrder S{Lc, Lc[LC_SPLIT], NE, 4, F.G, (int)blockIdx.x, 1024};
        pg8::gemm_phase<FEpiMoeDown, pg8::MoeOrder, false>(F.lds, (const bf16*)(ws + WS_ACT), FF, (const bf16*)(ws + WS_WD), FF, FF, S, E, nullptr, Lc); } SEAM(10);
#else
    if (IN(8)) { phase_moe_up_ref(F, a); } SEAM(8);
    if (IN(9)) { phase_moe_down_ref(F, a, 0); } SEAM(9);
    if (IN(10)) { phase_moe_down_ref(F, a, 1); } SEAM(10);
#endif
#if FAST_G11
    if (IN(11)) { phase_combine(F, a); __syncthreads(); FEpiBf16 E{(bf16*)(ws + WS_PP), D}; pg8::StaticOrder S; S.init(T, D, F.G, (int)blockIdx.x);
        pg8::gemm_phase<FEpiBf16, pg8::StaticOrder, false>(F.lds, (const bf16*)(ws + WS_PB), PLE, (const bf16*)(ws + WS_WPP), PLE, PLE, S, E, nullptr, Lc); } SEAM(11);
    if (IN(12)) { FEpiPle E{(const bf16*)(ws + WS_PP), a.out}; pg8::StaticOrder S; S.init(T, D, F.G, (int)blockIdx.x);
        pg8::gemm_phase<FEpiPle, pg8::StaticOrder, false>(F.lds, (const bf16*)(ws + WS_HP), D, (const bf16*)(ws + WS_WPG), D, D, S, E, nullptr, Lc); } SEAM(12);
#else
    if (IN(11)) { phase_combine(F, a); EpiStoreBf16 E{(bf16*)(ws + WS_PP), D}; ngemm_wave((const bf16*)(ws + WS_PB), PLE, (const bf16*)(ws + WS_WPP), PLE, T / 32, D / 32, PLE, F, E); } SEAM(11);
    if (IN(12)) { EpiPle E{(const bf16*)(ws + WS_PP), a.out}; ngemm_wave((const bf16*)(ws + WS_HP), D, (const bf16*)(ws + WS_WPG), D, T / 32, D / 32, D, F, E); } SEAM(12);
#endif
    if (IN(13)) { phase_final(F, a); }
#undef IN
#undef SEAM
}

extern "C" void kernel_launch(void* const* d_in, const int* in_sizes, int n_in, void* d_out, int out_size, void* d_ws, size_t ws_size, hipStream_t stream) {
    static int grid = 0;
    if (grid == 0) {
        if (n_in != 25 || in_sizes[0] != T * D || out_size != T * D || ws_size < WS_END) { fprintf(stderr, "kernel_launch: unexpected shapes (n_in %d, ws %zu)\n", n_in, ws_size); grid = -1; return; }
        int dev = 0, cus = 0;
        if (hipGetDevice(&dev) != hipSuccess || hipDeviceGetAttribute(&cus, hipDeviceAttributeMultiprocessorCount, dev) != hipSuccess) { grid = -1; return; }
        if (hipFuncSetAttribute((const void*)fwd, hipFuncAttributeMaxDynamicSharedMemorySize, LDS_BYTES) != hipSuccess) { grid = -1; return; }
        (void)hipGetLastError();
        grid = cus;
    }
    if (grid < 0) return;
    (void)hipMemsetAsync((char*)d_ws + WS_CTL, 0, CTL_ZERO_BYTES, stream);
    Args a{};
    for (int i = 0; i < 25; ++i) a.in[i] = (const float*)d_in[i];
    a.out = (float*)d_out; a.ws = (unsigned char*)d_ws;
#if MK_ONE_LAUNCH
    a.ph_lo = 0; a.ph_hi = NPHASES;
    hipLaunchKernelGGL(fwd, dim3(grid), dim3(NTHREADS), LDS_BYTES, stream, a);
#else
    for (int p = 0; p < NPHASES; ++p) { a.ph_lo = p; a.ph_hi = p + 1; hipLaunchKernelGGL(fwd, dim3(grid), dim3(NTHREADS), LDS_BYTES, stream, a); }
#endif
}
```

```cpp
#include <hip/hip_runtime.h>
#include <cstdint>
#include <cstdio>

#define DEV __device__ __forceinline__
#define LAS __attribute__((address_space(3)))
typedef unsigned short bf16;
typedef short bf16x8 __attribute__((ext_vector_type(8)));
typedef float f32x4 __attribute__((ext_vector_type(4)));
typedef float f32x16 __attribute__((ext_vector_type(16)));
typedef unsigned u32x4 __attribute__((ext_vector_type(4)));
typedef unsigned u32x2 __attribute__((ext_vector_type(2)));

#ifndef FAST_GEMM
#define FAST_GEMM 1
#endif
#ifndef FAST_G1
#define FAST_G1 FAST_GEMM
#endif
#ifndef FAST_G4
#define FAST_G4 FAST_GEMM
#endif
#ifndef FAST_G11
#define FAST_G11 FAST_GEMM
#endif
#ifndef FAST_MIX
#define FAST_MIX 1
#endif
#ifndef FAST_MOE
#define FAST_MOE 1
#endif
#ifndef MK_ONE_LAUNCH
#define MK_ONE_LAUNCH 1
#endif

constexpr int NB = 16, SEQ = 2048, T = NB * SEQ, D = 1024;
constexpr int NZ = 3840, Z1W = 1792, Z2W = 2048;
constexpr int NE = 32, FF = 1024, PLE = 256;
constexpr float LOG2E = 1.4426950408889634f;
constexpr float QSCALE = 0.125f * LOG2E;
constexpr float RMS_EPS = 1e-6f, LN_EPS = 1e-5f;
constexpr int NWAVES = 8, NTHREADS = 512;
constexpr int LDS_BYTES = 147456;
constexpr int LDS_CTL = 146432;
constexpr int LC_CNT = 0, LC_START = 32, LC_SPLIT = 65, LC_TOTAL = 66, LC_BAR = 100;

constexpr size_t MiB = 1u << 20;
constexpr size_t WS_CTL = 0, CTL_ZERO_BYTES = 1 * MiB;
constexpr size_t WS_STATS = 1 * MiB;
constexpr size_t WS_WIN = 2 * MiB, WS_WAB = 10 * MiB, WS_WOUT = 12 * MiB, WS_WPG = 14 * MiB, WS_WPP = 16 * MiB, WS_WSP = 16 * MiB + 512 * 1024;
constexpr size_t WS_LIST = 18 * MiB, WS_INFO = 22 * MiB;
constexpr size_t WS_WD = 24 * MiB, WS_WGU = 88 * MiB;
constexpr size_t WS_H2 = 216 * MiB, WS_AP = 216 * MiB;
constexpr size_t WS_ACT = 280 * MiB, WS_Z2 = 280 * MiB, WS_Z1 = 408 * MiB, WS_TMP = 408 * MiB, WS_MRG = 472 * MiB;
constexpr size_t WS_Y0 = 88 * MiB, WS_Y1 = 280 * MiB, WS_PP = 24 * MiB, WS_HP = 416 * MiB, WS_PB = 552 * MiB, WS_END = 572 * MiB;
constexpr size_t WS_RSTD = 1 * MiB + 512 * 1024;
constexpr size_t WS_WRH = 17 * MiB, WS_WRL = 17 * MiB + 64 * 1024;
constexpr size_t WS_SRS2 = 568 * MiB;
constexpr int Y0_CAP_ROWS = 98304;
constexpr int CW_TMO = 0, CW_GCOUNT = 64, CW_BAR = 4096;

struct Args { const float* in[25]; float* out; unsigned char* ws; int ph_lo, ph_hi; };

DEV unsigned f2bf(float f) { unsigned u = __builtin_bit_cast(unsigned, f); return (u + 0x7fffu + ((u >> 16) & 1u)) >> 16; }
DEV unsigned pk2(float lo, float hi) { return f2bf(lo) | (f2bf(hi) << 16); }
DEV float bf2f(unsigned b) { return __builtin_bit_cast(float, b << 16); }
DEV float bflo(unsigned w) { return __builtin_bit_cast(float, w << 16); }
DEV float bfhi(unsigned w) { return __builtin_bit_cast(float, w & 0xffff0000u); }
DEV float fexp2(float x) { return __builtin_amdgcn_exp2f(x); }
DEV float frcp(float x) { return __builtin_amdgcn_rcpf(x); }
DEV float sigmoidf_(float x) { return frcp(1.0f + fexp2(-x * LOG2E)); }
DEV float gelu_tanh(float x) { const float u = 1.5957691216057308f * (x + 0.044715f * x * x * x); return x * frcp(1.0f + fexp2(-u * LOG2E)); }
DEV float swiglu(float a, float b) { a = fminf(a, 7.0f); b = fminf(fmaxf(b, -7.0f), 7.0f); return (b + 1.0f) * (a * sigmoidf_(1.702f * a)); }
DEV float wave_sum(float v) {
#pragma unroll
    for (int o = 1; o < 64; o <<= 1) v += __shfl_xor(v, o);
    return v;
}
DEV float wave_max(float v) {
#pragma unroll
    for (int o = 1; o < 64; o <<= 1) v = fmaxf(v, __shfl_xor(v, o));
    return v;
}
DEV int crow(int reg, int h) { return (reg & 3) + 8 * (reg >> 2) + 4 * h; }

struct Frame { LAS unsigned char* lds; int tid, lane, wave, vcu, G, gw, NGW; };

#define XB_TMO      128
#define XB_XCNT(j)  (256  + 64 * (j))
#define XB_XSUB(j)  (1280 + 64 * (j))
#define XB_XGEN(j)  (2304 + 64 * (j))
#define XB_TOP      3328
#define XB_TOPGEN   3392
#define XCD_BAR_WORDS 3456
#define XB_SPIN_CAP (1u << 18)
DEV unsigned xb_ld(unsigned* p)              { return __hip_atomic_load(p, __ATOMIC_RELAXED, __HIP_MEMORY_SCOPE_AGENT); }
DEV unsigned xb_add(unsigned* p, unsigned v) { return __hip_atomic_fetch_add(p, v, __ATOMIC_RELAXED, __HIP_MEMORY_SCOPE_AGENT); }
DEV unsigned xb_xcc_id() { return (unsigned)__builtin_amdgcn_s_getreg((3 << 11) | 20) & 0xFu; }
#define XB_SPIN(cond, bar) do { unsigned _sp = 0; while (cond) { __builtin_amdgcn_s_sleep(1); \
    if ((++_sp & 255u) == 0u) { if (xb_ld(&(bar)[XB_TMO])) break; if (_sp > XB_SPIN_CAP) { atomicAdd(&(bar)[XB_TMO], 1u); break; } } } } while (0)
struct XcdBarrier { unsigned* bar; unsigned x; volatile LAS unsigned* st; };
DEV XcdBarrier xcd_barrier_post(unsigned* bar, volatile LAS unsigned* st) {
    XcdBarrier b; b.bar = bar; b.x = xb_xcc_id(); b.st = st;
    if (threadIdx.x == 0) (void)xb_add(&bar[XB_XCNT(b.x)], 1u);
    return b;
}
DEV void xcd_barrier_complete(unsigned* bar, unsigned x, unsigned& nloc, unsigned& nx) {
    const unsigned G = gridDim.x * gridDim.y * gridDim.z;
    unsigned sum, cnt, mine, sp = 0u;
    for (;;) {
        sum = 0u; cnt = 0u; mine = 0u;
#pragma unroll
        for (unsigned j = 0; j < 16; ++j) { const unsigned c = xb_ld(&bar[XB_XCNT(j)]); sum += c; cnt += (c > 0u) ? 1u : 0u; mine = (j == x) ? c : mine; }
        if (sum == G) break;
        __builtin_amdgcn_s_sleep(1);
        if ((++sp & 255u) == 0u) { if (xb_ld(&bar[XB_TMO])) break; if (sp > XB_SPIN_CAP) { atomicAdd(&bar[XB_TMO], 1u); break; } }
    }
    nloc = mine > 0u ? mine : 1u; nx = cnt > 0u ? cnt : 1u;
}
DEV void xcd_barrier(const XcdBarrier& b) {
    asm volatile("s_waitcnt vmcnt(0)" ::: "memory");
    __syncthreads();
    if (threadIdx.x == 0) {
        unsigned* bar = b.bar;
        __builtin_amdgcn_s_waitcnt(0);
        unsigned nloc = b.st[0], nx = b.st[1];
        if (nloc == 0u) { xcd_barrier_complete(bar, b.x, nloc, nx); b.st[0] = nloc; b.st[1] = nx; }
        const unsigned old = xb_add(&bar[XB_XSUB(b.x)], 1u);
        const unsigned gen = old / nloc;
        if (old + 1u == (gen + 1u) * nloc) {
            __builtin_amdgcn_fence(__ATOMIC_RELEASE, "agent");
            asm volatile("s_waitcnt vmcnt(0)" ::: "memory");
            const unsigned og = xb_add(&bar[XB_TOP], 1u);
            const unsigned tg = og / nx;
            if (og + 1u == (tg + 1u) * nx) xb_add(&bar[XB_TOPGEN], 1u);
            else XB_SPIN(xb_ld(&bar[XB_TOPGEN]) == tg, bar);
            __builtin_amdgcn_fence(__ATOMIC_ACQUIRE, "agent");
            xb_add(&bar[XB_XGEN(b.x)], 1u);
            asm volatile("s_waitcnt vmcnt(0)" ::: "memory");
        } else {
            XB_SPIN(xb_ld(&bar[XB_XGEN(b.x)]) == gen, bar);
            __builtin_amdgcn_fence(__ATOMIC_ACQUIRE, "agent");
            asm volatile("s_waitcnt vmcnt(0)" ::: "memory");
        }
    }
    __syncthreads();
}

template <class Epi>
DEV void ngemm_wave(const bf16* A, int lda, const bf16* Bt, int ldb, int mtiles, int ntiles, int K, const Frame& F, const Epi& epi) {
    const int r = F.lane & 31, h = F.lane >> 5;
    const int total = mtiles * ntiles;
    for (int t = F.gw; t < total; t += F.NGW) {
        const int tm = t / ntiles, tn = t % ntiles;
        const bf16* ap = A + (size_t)(tm * 32 + r) * lda + 8 * h;
        const bf16* bp = Bt + (size_t)(tn * 32 + r) * ldb + 8 * h;
        f32x16 acc;
#pragma unroll
        for (int i = 0; i < 16; ++i) acc[i] = 0.f;
#pragma unroll 8
        for (int k0 = 0; k0 < K; k0 += 16) {
            const bf16x8 a = *(const bf16x8*)(ap + k0), b = *(const bf16x8*)(bp + k0);
            acc = __builtin_amdgcn_mfma_f32_32x32x16_bf16(a, b, acc, 0, 0, 0);
        }
#pragma unroll
        for (int i = 0; i < 16; ++i) epi(tm * 32 + crow(i, h), tn * 32 + r, acc[i]);
    }
}

DEV int maprow(int mode, int n0) { return mode == 0 ? n0 : (256 * (n0 >> 7) + (n0 & 127) + (mode == 2 ? 128 : 0)); }
DEV void transpose_item(const float* W, int K, int N, bf16* WT, int ldt, int koff, int mode, LAS float* scr, int item, int lane) {
    const int nblk = N / 32, kb = item / nblk, nb = item % nblk, k0 = 64 * kb, n0 = 32 * nb;
#pragma unroll 8
    for (int i = 0; i < 32; ++i) { const int kk = 2 * i + (lane >> 5); scr[kk * 33 + (lane & 31)] = W[(size_t)(k0 + kk) * N + n0 + (lane & 31)]; }
    asm volatile("s_waitcnt lgkmcnt(0)" ::: "memory");
    const int c = lane & 7; const int rbase = maprow(mode, n0);
#pragma unroll
    for (int j = 0; j < 4; ++j) { const int n = (lane >> 3) + 8 * j; const LAS float* s = scr + (8 * c) * 33 + n;
        u32x4 o; o.x = pk2(s[0 * 33], s[1 * 33]); o.y = pk2(s[2 * 33], s[3 * 33]); o.z = pk2(s[4 * 33], s[5 * 33]); o.w = pk2(s[6 * 33], s[7 * 33]);
        *(u32x4*)(WT + (size_t)(rbase + n) * ldt + koff + k0 + 8 * c) = o; }
    asm volatile("s_waitcnt lgkmcnt(0)" ::: "memory");
}
DEV void rms_row_to_bf16(const float* xrow, const float* g, bf16* orow, int lane) {
    const f32x4* xr = (const f32x4*)xrow + lane; const f32x4* gr = (const f32x4*)g + lane;
    f32x4 v[4]; float s = 0.f;
#pragma unroll
    for (int j = 0; j < 4; ++j) { v[j] = xr[64 * j]; s += (v[j].x * v[j].x + v[j].y * v[j].y) + (v[j].z * v[j].z + v[j].w * v[j].w); }
    const float rstd = 1.0f / sqrtf(wave_sum(s) * (1.f / D) + RMS_EPS);
    unsigned long long* o8 = (unsigned long long*)orow + lane;
#pragma unroll
    for (int j = 0; j < 4; ++j) { const f32x4 gg = gr[64 * j];
        o8[64 * j] = (unsigned long long)pk2(v[j].x * rstd * gg.x, v[j].y * rstd * gg.y) | ((unsigned long long)pk2(v[j].z * rstd * gg.z, v[j].w * rstd * gg.w) << 32); }
}
DEV void phase_prologue(Frame& F, const Args& a) {
    unsigned char* ws = a.ws;
    LAS float* scr = (LAS float*)(F.lds + F.wave * 8448);
    bf16* Win_t = (bf16*)(ws + WS_WIN); bf16* Wab_t = (bf16*)(ws + WS_WAB); bf16* Wout_t = (bf16*)(ws + WS_WOUT); bf16* Wpg_t = (bf16*)(ws + WS_WPG);
    bf16* Wpp_t = (bf16*)(ws + WS_WPP); bf16* Wsp = (bf16*)(ws + WS_WSP); bf16* Wd_t = (bf16*)(ws + WS_WD); bf16* Wgu_t = (bf16*)(ws + WS_WGU);
    constexpr int I0 = 16 * 120, I1 = 8 * 32, I2 = 8 * 32, I3 = 16 * 32, I4 = 16 * 32, I5 = 4 * 32, IE = 512, NITEMS = I0 + I1 + I2 + I3 + I4 + I5 + NE * 3 * IE;
    for (int it = F.gw; it < NITEMS; it += F.NGW) {
        int r = it;
        if (r < I0) { transpose_item(a.in[3], D, NZ, Win_t, D, 0, 0, scr, r, F.lane); continue; } r -= I0;
        if (r < I1) { transpose_item(a.in[9], 512, D, Wab_t, D, 0, 0, scr, r, F.lane); continue; } r -= I1;
        if (r < I2) { transpose_item(a.in[10], 512, D, Wab_t, D, 512, 0, scr, r, F.lane); continue; } r -= I2;
        if (r < I3) { transpose_item(a.in[11], D, D, Wout_t, D, 0, 0, scr, r, F.lane); continue; } r -= I3;
        if (r < I4) { transpose_item(a.in[22], D, D, Wpg_t, D, 0, 0, scr, r, F.lane); continue; } r -= I4;
        if (r < I5) { transpose_item(a.in[23], PLE, D, Wpp_t, PLE, 0, 0, scr, r, F.lane); continue; } r -= I5;
        const int e = r / (3 * IE), q = r % (3 * IE), kind = q / IE, item = q % IE;
        if (kind == 0) transpose_item(a.in[15] + (size_t)e * D * FF, D, FF, Wgu_t + (size_t)e * 2048 * D, D, 0, 1, scr, item, F.lane);
        else if (kind == 1) transpose_item(a.in[17] + (size_t)e * D * FF, D, FF, Wgu_t + (size_t)e * 2048 * D, D, 0, 2, scr, item, F.lane);
        else transpose_item(a.in[19] + (size_t)e * FF * D, FF, D, Wd_t + (size_t)e * D * FF, FF, 0, 0, scr, item, F.lane);
    }
    { bf16* wh = (bf16*)(ws + WS_WRH); bf16* wl = (bf16*)(ws + WS_WRL);
      for (int i = F.vcu * NTHREADS + F.tid; i < D * NE; i += F.G * NTHREADS) { const int d = i >> 5, e = i & 31; const float w = a.in[13][i]; const unsigned hb = f2bf(w);
          wh[e * D + d] = (bf16)hb; wl[e * D + d] = (bf16)f2bf(w - bf2f(hb)); } }
    for (int i = F.vcu * NTHREADS + F.tid; i < 4 * 128 * 128; i += F.G * NTHREADS) { const int s = i & 127, t = (i >> 7) & 127; Wsp[i] = (bf16)f2bf(s <= t ? a.in[7][i] : 0.f); }
    bf16* Hb = (bf16*)a.out; bf16* PB = (bf16*)(ws + WS_PB);
    for (int m = F.gw; m < T; m += F.NGW) {
        rms_row_to_bf16(a.in[0] + (size_t)m * D, a.in[2], Hb + (size_t)m * D, F.lane);
        const f32x4 pv = *((const f32x4*)(a.in[1] + (size_t)m * PLE) + F.lane);
        *((u32x2*)(PB + (size_t)m * PLE) + F.lane) = (u32x2){pk2(pv.x, pv.y), pk2(pv.z, pv.w)};
    }
}

struct EpiZ { bf16* Z1; bf16* Z2;
    DEV void operator()(int row, int col, float v) const {
        if (col < 512) Z1[(size_t)row * Z1W + col] = (bf16)f2bf(v * QSCALE);
        else if (col < 768) Z1[(size_t)row * Z1W + col] = (bf16)f2bf(v);
        else if (col < Z1W) Z1[(size_t)row * Z1W + col] = (bf16)f2bf(gelu_tanh(v));
        else Z2[(size_t)row * Z2W + (col - Z1W)] = (bf16)f2bf(sigmoidf_(v));
    } };

DEV void phase_lnstats(Frame& F, const Args& a) {
    const bf16* Z1 = (const bf16*)(a.ws + WS_Z1); float2* st = (float2*)(a.ws + WS_STATS);
    for (int m = F.gw; m < T; m += F.NGW) {
        const u32x4 w = *((const u32x4*)(Z1 + (size_t)m * Z1W + 1280) + F.lane);
        float v[8] = {bflo(w.x), bfhi(w.x), bflo(w.y), bfhi(w.y), bflo(w.z), bfhi(w.z), bflo(w.w), bfhi(w.w)};
        float s = 0.f;
#pragma unroll
        for (int j = 0; j < 8; ++j) s += v[j];
        const float mean = wave_sum(s) * (1.f / 512.f); float q = 0.f;
#pragma unroll
        for (int j = 0; j < 8; ++j) { const float d = v[j] - mean; q += d * d; }
        const float rstd = 1.0f / sqrtf(wave_sum(q) * (1.f / 512.f) + LN_EPS);
        if (F.lane == 0) st[m] = make_float2(mean, rstd);
    }
}

DEV void phase_mixers_ref(Frame& F, const Args& a) {
    const bf16* Z1 = (const bf16*)(a.ws + WS_Z1); bf16* AP = (bf16*)(a.ws + WS_AP);
    const float* sinks = a.in[4];
    const int gid = F.vcu * NTHREADS + F.tid, nthr = F.G * NTHREADS;
    for (int item = gid; item < T * 8; item += nthr) {
        const int hh = item / T, m = item % T, b = m / SEQ, t = m % SEQ, kvh = hh >> 2;
        const float slope2 = fexp2(-(float)(hh + 1)) * LOG2E, sink2 = sinks[hh] * LOG2E;
        float q[64], o[64];
        const u32x4* qp = (const u32x4*)(Z1 + (size_t)m * Z1W + hh * 64);
#pragma unroll
        for (int c = 0; c < 8; ++c) { const u32x4 w = qp[c]; q[8 * c] = bflo(w.x); q[8 * c + 1] = bfhi(w.x); q[8 * c + 2] = bflo(w.y); q[8 * c + 3] = bfhi(w.y); q[8 * c + 4] = bflo(w.z); q[8 * c + 5] = bfhi(w.z); q[8 * c + 6] = bflo(w.w); q[8 * c + 7] = bfhi(w.w); }
#pragma unroll
        for (int d = 0; d < 64; ++d) o[d] = 0.f;
        float mrun = sink2, l = 1.0f;
        const int s0 = t - 127 < 0 ? 0 : t - 127;
        for (int s = s0; s <= t; ++s) {
            const bf16* krow = Z1 + (size_t)(b * SEQ + s) * Z1W + 512 + kvh * 64; const bf16* vrow = krow + 128;
            float dot = 0.f;
#pragma unroll
            for (int c = 0; c < 8; ++c) { const u32x4 w = ((const u32x4*)krow)[c];
                dot += q[8 * c] * bflo(w.x) + q[8 * c + 1] * bfhi(w.x) + q[8 * c + 2] * bflo(w.y) + q[8 * c + 3] * bfhi(w.y) + q[8 * c + 4] * bflo(w.z) + q[8 * c + 5] * bfhi(w.z) + q[8 * c + 6] * bflo(w.w) + q[8 * c + 7] * bfhi(w.w); }
            const float sc = dot - slope2 * (float)(t - s);
            const float mnew = fmaxf(mrun, sc), alpha = fexp2(mrun - mnew), p = fexp2(sc - mnew);
            l = l * alpha + p; mrun = mnew;
#pragma unroll
            for (int c = 0; c < 8; ++c) { const u32x4 w = ((const u32x4*)vrow)[c];
                o[8 * c] = o[8 * c] * alpha + p * bflo(w.x); o[8 * c + 1] = o[8 * c + 1] * alpha + p * bfhi(w.x); o[8 * c + 2] = o[8 * c + 2] * alpha + p * bflo(w.y); o[8 * c + 3] = o[8 * c + 3] * alpha + p * bfhi(w.y);
                o[8 * c + 4] = o[8 * c + 4] * alpha + p * bflo(w.z); o[8 * c + 5] = o[8 * c + 5] * alpha + p * bfhi(w.z); o[8 * c + 6] = o[8 * c + 6] * alpha + p * bflo(w.w); o[8 * c + 7] = o[8 * c + 7] * alpha + p * bfhi(w.w); }
        }
        const float il = 1.0f / l;
        u32x4* op = (u32x4*)(AP + (size_t)m * D + hh * 64);
#pragma unroll
        for (int c = 0; c < 8; ++c) op[c] = (u32x4){pk2(o[8 * c] * il, o[8 * c + 1] * il), pk2(o[8 * c + 2] * il, o[8 * c + 3] * il), pk2(o[8 * c + 4] * il, o[8 * c + 5] * il), pk2(o[8 * c + 6] * il, o[8 * c + 7] * il)};
    }
    const bf16* Wsp = (const bf16*)(a.ws + WS_WSP); const float2* st = (const float2*)(a.ws + WS_STATS);
    const float* g_ln = a.in[5]; const float* b_ln = a.in[6]; const float* b_sp = a.in[8];
    for (int item = gid; item < T * 512; item += nthr) {
        const int m = item >> 9, c = item & 511, g = c >> 7, t = m & 127, m0 = m - t;
        const float gl = g_ln[c], bl = b_ln[c];
        const bf16* wrow = Wsp + ((size_t)g * 128 + t) * 128;
        float acc = 0.f;
        for (int s = 0; s <= t; ++s) {
            const float2 ms = st[m0 + s];
            const float vn = (bf2f(Z1[(size_t)(m0 + s) * Z1W + 1280 + c]) - ms.x) * ms.y * gl + bl;
            acc += bf2f(wrow[s]) * vn;
        }
        const float u = bf2f(Z1[(size_t)m * Z1W + 768 + c]);
        AP[(size_t)m * D + 512 + c] = (bf16)f2bf(u * (acc + b_sp[g * 128 + t]));
    }
}

struct EpiProjA { const bf16* Z2; bf16* TMP;
    DEV void operator()(int row, int col, float v) const { TMP[(size_t)row * D + col] = (bf16)f2bf(bf2f(Z2[(size_t)row * Z2W + col]) * v); } };
struct EpiProjB { const bf16* Z2; const bf16* TMP; bf16* MRG;
    DEV void operator()(int row, int col, float v) const { MRG[(size_t)row * D + col] = (bf16)f2bf(bf2f(TMP[(size_t)row * D + col]) + bf2f(Z2[(size_t)row * Z2W + 1024 + col]) * v); } };
struct EpiResid { const float* base; float* out;
    DEV void operator()(int row, int col, float v) const { out[(size_t)row * D + col] = base[(size_t)row * D + col] + v; } };

DEV void phase_router(Frame& F, const Args& a) {
    const float* x1 = a.out; const float* g_ffn = a.in[12]; const float* w_router = a.in[13]; const float* b_router = a.in[14];
    bf16* H2 = (bf16*)(a.ws + WS_H2); unsigned* gcount = (unsigned*)(a.ws + WS_CTL) + CW_GCOUNT; int* list = (int*)(a.ws + WS_LIST); u32x2* info = (u32x2*)(a.ws + WS_INFO);
    LAS float* wt = (LAS float*)F.lds;
    LAS unsigned* lcount = (LAS unsigned*)(F.lds + 131584);
    LAS unsigned* gbase = lcount + 32;
    LAS unsigned* rec = gbase + 32;
    const int lane = F.lane;
    for (int i = F.tid; i < D * NE; i += NTHREADS) { const int d = i >> 5, e = i & 31; wt[e * 1028 + d] = w_router[i]; }
    f32x4 gg[4];
#pragma unroll
    for (int j = 0; j < 4; ++j) gg[j] = *((const f32x4*)g_ffn + lane + 64 * j);
    const int my_e = lane >> 1; const float my_bias = b_router[my_e];
    for (int blk = F.vcu; blk < T / 128; blk += F.G) {
        if (F.tid < 32) lcount[F.tid] = 0u;
        __syncthreads();
        for (int rr = 0; rr < 16; ++rr) {
            const int rl = F.wave * 16 + rr, m = blk * 128 + rl;
            const f32x4* xr = (const f32x4*)(x1 + (size_t)m * D) + lane;
            f32x4 v[4]; float s = 0.f;
#pragma unroll
            for (int j = 0; j < 4; ++j) { v[j] = xr[64 * j]; s += (v[j].x * v[j].x + v[j].y * v[j].y) + (v[j].z * v[j].z + v[j].w * v[j].w); }
            const float rstd = 1.0f / sqrtf(wave_sum(s) * (1.f / D) + RMS_EPS);
#pragma unroll
            for (int j = 0; j < 4; ++j) v[j] = v[j] * rstd * gg[j];
            unsigned long long* o8 = (unsigned long long*)(H2 + (size_t)m * D) + lane;
#pragma unroll
            for (int j = 0; j < 4; ++j) o8[64 * j] = (unsigned long long)pk2(v[j].x, v[j].y) | ((unsigned long long)pk2(v[j].z, v[j].w) << 32);
            float part[32];
#pragma unroll
            for (int e = 0; e < 32; ++e) { float acc = 0.f;
#pragma unroll
                for (int j = 0; j < 4; ++j) { const f32x4 w = *(const LAS f32x4*)(wt + e * 1028 + 4 * lane + 256 * j); acc += (v[j].x * w.x + v[j].y * w.y) + (v[j].z * w.z + v[j].w * w.w); }
                part[e] = acc; }
#define TR_STEP(N, BIT, XM) { const bool hb = (lane >> BIT) & 1; _Pragma("unroll") for (int i = 0; i < N; ++i) { const float keep = hb ? part[i + N] : part[i]; const float send = hb ? part[i] : part[i + N]; part[i] = keep + __shfl_xor(send, XM); } }
            TR_STEP(16, 5, 32) TR_STEP(8, 4, 16) TR_STEP(4, 3, 8) TR_STEP(2, 2, 4) TR_STEP(1, 1, 2)
#undef TR_STEP
            float val = part[0] + __shfl_xor(part[0], 1) + my_bias;
            float topv[4]; int tope[4];
#pragma unroll
            for (int k = 0; k < 4; ++k) { const float mx = wave_max(val); const unsigned long long bal = __ballot(val == mx); const int src = __ffsll((long long)bal) - 1; const int ek = src >> 1;
                topv[k] = mx; tope[k] = ek; if (my_e == ek) val = -INFINITY; }
            const float e1 = __expf(topv[1] - topv[0]), e2 = __expf(topv[2] - topv[0]), e3 = __expf(topv[3] - topv[0]);
            const float inv = 1.0f / (1.0f + e1 + e2 + e3);
            if (lane < 4) {
                const int ek = lane == 0 ? tope[0] : lane == 1 ? tope[1] : lane == 2 ? tope[2] : tope[3];
                const float gk = (lane == 0 ? 1.0f : lane == 1 ? e1 : lane == 2 ? e2 : e3) * inv;
                const unsigned pos = atomicAdd((unsigned*)(lcount + ek), 1u);
                rec[(rl * 4 + lane) * 2] = (unsigned)ek | (pos << 8); rec[(rl * 4 + lane) * 2 + 1] = __builtin_bit_cast(unsigned, gk);
            }
        }
        __syncthreads();
        if (F.tid < 32) gbase[F.tid] = atomicAdd(gcount + F.tid, lcount[F.tid]);
        __syncthreads();
        { const int rl = F.tid >> 2, k = F.tid & 3, m = blk * 128 + rl; const unsigned w0 = rec[F.tid * 2], w1 = rec[F.tid * 2 + 1];
          const unsigned ek = w0 & 255u, gpos = gbase[ek] + (w0 >> 8);
          list[(size_t)ek * T + gpos] = m; info[(size_t)m * 4 + k] = (u32x2){ek | (gpos << 5), w1}; }
        __syncthreads();
    }
}


DEV void phase_router2(Frame& F, const Args& a) {
    const float* x1 = a.out; const float* g_ffn = a.in[12]; const float* b_router = a.in[14];
    bf16* H2 = (bf16*)(a.ws + WS_H2); unsigned* gcount = (unsigned*)(a.ws + WS_CTL) + CW_GCOUNT; int* list = (int*)(a.ws + WS_LIST); u32x2* info = (u32x2*)(a.ws + WS_INFO);
    float* rstd_g = (float*)(a.ws + WS_RSTD); float* srs = (float*)(a.ws + WS_SRS2);
    LAS unsigned char* WRh = F.lds;
    LAS unsigned char* WRl = F.lds + 66048;
    LAS float* lg = (LAS float*)F.lds;
    LAS float* rs = (LAS float*)(F.lds + 132096);
    LAS unsigned* lcount = (LAS unsigned*)(F.lds + 132096 + 512);
    LAS unsigned* gbase = lcount + 32;
    LAS unsigned* rec = gbase + 32;
    const int lane = F.lane, wave = F.wave, fr = lane & 15, kq = lane >> 4;
    for (int blk = F.vcu; blk < T / 128; blk += F.G) {
        __syncthreads();
        { const bf16* wh = (const bf16*)(a.ws + WS_WRH); const bf16* wl = (const bf16*)(a.ws + WS_WRL);
          for (int i = F.tid; i < 32 * 128; i += NTHREADS) { const int e = i >> 7, c = i & 127;
              *(LAS u32x4*)(WRh + e * 2064 + c * 16) = *(const u32x4*)(wh + e * 1024 + c * 8); *(LAS u32x4*)(WRl + e * 2064 + c * 16) = *(const u32x4*)(wl + e * 1024 + c * 8); } }
        if (F.tid < 32) lcount[F.tid] = 0u;
        __syncthreads();
        const int row = blk * 128 + wave * 16 + fr;
        const float* xp = x1 + (size_t)row * D + 8 * kq; const float* gp = g_ffn + 8 * kq; bf16* hp = H2 + (size_t)row * D + 8 * kq;
        f32x4 acc0 = (f32x4){0.f, 0.f, 0.f, 0.f}, acc1 = acc0; float ss = 0.f;
#pragma unroll 4
        for (int k0 = 0; k0 < D; k0 += 32) {
            const f32x4 xa = *(const f32x4*)(xp + k0), xb = *(const f32x4*)(xp + k0 + 4), ga = *(const f32x4*)(gp + k0), gb = *(const f32x4*)(gp + k0 + 4);
            ss += (xa.x * xa.x + xa.y * xa.y) + (xa.z * xa.z + xa.w * xa.w) + (xb.x * xb.x + xb.y * xb.y) + (xb.z * xb.z + xb.w * xb.w);
            const f32x4 pa = xa * ga, pb = xb * gb;
            u32x4 hw; hw.x = pk2(pa.x, pa.y); hw.y = pk2(pa.z, pa.w); hw.z = pk2(pb.x, pb.y); hw.w = pk2(pb.z, pb.w);
            *(u32x4*)(hp + k0) = hw;
            u32x4 lw; lw.x = pk2(pa.x - bflo(hw.x), pa.y - bfhi(hw.x)); lw.y = pk2(pa.z - bflo(hw.y), pa.w - bfhi(hw.y)); lw.z = pk2(pb.x - bflo(hw.z), pb.y - bfhi(hw.z)); lw.w = pk2(pb.z - bflo(hw.w), pb.w - bfhi(hw.w));
            const bf16x8 ah = __builtin_bit_cast(bf16x8, hw), al = __builtin_bit_cast(bf16x8, lw);
            const LAS unsigned char* bh = WRh + fr * 2064 + (k0 + 8 * kq) * 2; const LAS unsigned char* bl = WRl + fr * 2064 + (k0 + 8 * kq) * 2;
            const bf16x8 bh0 = *(const LAS bf16x8*)bh, bh1 = *(const LAS bf16x8*)(bh + 16 * 2064), bl0 = *(const LAS bf16x8*)bl, bl1 = *(const LAS bf16x8*)(bl + 16 * 2064);
            acc0 = __builtin_amdgcn_mfma_f32_16x16x32_bf16(ah, bh0, acc0, 0, 0, 0); acc1 = __builtin_amdgcn_mfma_f32_16x16x32_bf16(ah, bh1, acc1, 0, 0, 0);
            acc0 = __builtin_amdgcn_mfma_f32_16x16x32_bf16(ah, bl0, acc0, 0, 0, 0); acc1 = __builtin_amdgcn_mfma_f32_16x16x32_bf16(ah, bl1, acc1, 0, 0, 0);
            acc0 = __builtin_amdgcn_mfma_f32_16x16x32_bf16(al, bh0, acc0, 0, 0, 0); acc1 = __builtin_amdgcn_mfma_f32_16x16x32_bf16(al, bh1, acc1, 0, 0, 0);
        }
        ss += __shfl_xor(ss, 16); ss += __shfl_xor(ss, 32);
        const float rstd = 1.0f / sqrtf(ss * (1.f / D) + RMS_EPS);
        if (kq == 0) { rs[wave * 16 + fr] = rstd; rstd_g[row] = rstd; }
        __syncthreads();
        { const float b0 = b_router[fr], b1 = b_router[16 + fr];
#pragma unroll
          for (int i = 0; i < 4; ++i) { const int rl = wave * 16 + 4 * kq + i; const float r_ = rs[rl]; lg[rl * 33 + fr] = acc0[i] * r_ + b0; lg[rl * 33 + 16 + fr] = acc1[i] * r_ + b1; } }
        __syncthreads();
        if (F.tid < 128) {
            const int rl = F.tid; float v[32];
#pragma unroll
            for (int e = 0; e < 32; ++e) v[e] = lg[rl * 33 + e];
            float topv[4]; int tope[4];
#pragma unroll
            for (int k = 0; k < 4; ++k) { float mx = v[0]; int mi = 0;
#pragma unroll
                for (int e = 1; e < 32; ++e) { const bool gt = v[e] > mx; mx = gt ? v[e] : mx; mi = gt ? e : mi; }
                topv[k] = mx; tope[k] = mi;
#pragma unroll
                for (int e = 0; e < 32; ++e) v[e] = (e == mi) ? -INFINITY : v[e]; }
            const float e1 = __expf(topv[1] - topv[0]), e2 = __expf(topv[2] - topv[0]), e3 = __expf(topv[3] - topv[0]);
            const float inv = 1.0f / (1.0f + e1 + e2 + e3);
            const float gk[4] = {inv, e1 * inv, e2 * inv, e3 * inv};
#pragma unroll
            for (int k = 0; k < 4; ++k) { const unsigned pos = atomicAdd((unsigned*)(lcount + tope[k]), 1u);
                rec[(rl * 4 + k) * 2] = (unsigned)tope[k] | (pos << 8); rec[(rl * 4 + k) * 2 + 1] = __float_as_uint(gk[k]); }
        }
        __syncthreads();
        if (F.tid < 32) gbase[F.tid] = atomicAdd(gcount + F.tid, lcount[F.tid]);
        __syncthreads();
        { const int rl = F.tid >> 2, k = F.tid & 3, m = blk * 128 + rl; const unsigned w0 = rec[F.tid * 2], w1 = rec[F.tid * 2 + 1];
          const unsigned ek = w0 & 255u, gpos = gbase[ek] + (w0 >> 8);
          list[(size_t)ek * T + gpos] = m; srs[(size_t)ek * T + gpos] = rs[rl]; info[(size_t)m * 4 + k] = (u32x2){ek | (gpos << 5), w1}; }
    }
    __syncthreads();
}

DEV void moe_layout(Frame& F, const Args& a) {
    volatile LAS int* L = (volatile LAS int*)(F.lds + LDS_CTL);
    if (F.tid == 0) {
        unsigned* gcount = (unsigned*)(a.ws + WS_CTL) + CW_GCOUNT; int st = 0;
        for (int e = 0; e < NE; ++e) { const int c = (int)__hip_atomic_load(gcount + e, __ATOMIC_RELAXED, __HIP_MEMORY_SCOPE_AGENT); L[LC_CNT + e] = c; L[LC_START + e] = st; st += (c + 255) & ~255; }
        L[LC_START + NE] = st; L[LC_TOTAL] = st;
        int sp = 0; while (sp < NE && 2 * L[LC_START + sp] < st) ++sp;
        L[LC_SPLIT] = sp;
    }
    __syncthreads();
}

DEV void phase_moe_up_ref(Frame& F, const Args& a) {
    moe_layout(F, a);
    volatile LAS int* L = (volatile LAS int*)(F.lds + LDS_CTL);
    const bf16* H2 = (const bf16*)(a.ws + WS_H2); const bf16* Wgu_t = (const bf16*)(a.ws + WS_WGU); bf16* ACT = (bf16*)(a.ws + WS_ACT); const int* list = (const int*)(a.ws + WS_LIST);
    const float* b_gate = a.in[16]; const float* b_up = a.in[18];
    const int r = F.lane & 31, h = F.lane >> 5, total = L[LC_TOTAL];
    const int items = (total / 32) * 32;
    for (int it = F.gw; it < items; it += F.NGW) {
        const int rt = it >> 5, ft = it & 31, s0 = rt * 32, f0 = ft * 32;
        int e = 0; while (e < NE - 1 && s0 >= L[LC_START + e + 1]) ++e;
        const int local = s0 + r - L[LC_START + e];
        const int tok = local < L[LC_CNT + e] ? list[(size_t)e * T + local] : 0;
        const bf16* ap = H2 + (size_t)tok * D + 8 * h;
        const bf16* bg = Wgu_t + ((size_t)e * 2048 + 256 * (f0 >> 7) + (f0 & 127) + r) * D + 8 * h; const bf16* bu = bg + (size_t)128 * D;
        f32x16 acca, accb;
#pragma unroll
        for (int i = 0; i < 16; ++i) { acca[i] = 0.f; accb[i] = 0.f; }
#pragma unroll 4
        for (int k0 = 0; k0 < D; k0 += 16) { const bf16x8 av = *(const bf16x8*)(ap + k0);
            acca = __builtin_amdgcn_mfma_f32_32x32x16_bf16(av, *(const bf16x8*)(bg + k0), acca, 0, 0, 0);
            accb = __builtin_amdgcn_mfma_f32_32x32x16_bf16(av, *(const bf16x8*)(bu + k0), accb, 0, 0, 0); }
        const float bgv = b_gate[e * FF + f0 + r], buv = b_up[e * FF + f0 + r];
#pragma unroll
        for (int i = 0; i < 16; ++i) ACT[(size_t)(s0 + crow(i, h)) * FF + f0 + r] = (bf16)f2bf(swiglu(acca[i] + bgv, accb[i] + buv));
    }
}
DEV void phase_moe_down_ref(Frame& F, const Args& a, int half) {
    moe_layout(F, a);
    volatile LAS int* L = (volatile LAS int*)(F.lds + LDS_CTL);
    const bf16* ACT = (const bf16*)(a.ws + WS_ACT); const bf16* Wd_t = (const bf16*)(a.ws + WS_WD); const float* b_down = a.in[20];
    const int r = F.lane & 31, h = F.lane >> 5, total = L[LC_TOTAL], srow = L[LC_START + L[LC_SPLIT]];
    const int row_lo = half == 0 ? 0 : srow, row_hi = half == 0 ? srow : total;
    bf16* Y = half == 0 ? (bf16*)(a.ws + WS_Y0) : (bf16*)(a.ws + WS_Y1) - (size_t)srow * D;
    const int items = ((row_hi - row_lo) / 32) * 32;
    for (int it = F.gw; it < items; it += F.NGW) {
        const int rt = it >> 5, nt = it & 31, s0 = row_lo + rt * 32, n0 = nt * 32;
        int e = 0; while (e < NE - 1 && s0 >= L[LC_START + e + 1]) ++e;
        const bf16* ap = ACT + (size_t)(s0 + r) * FF + 8 * h;
        const bf16* bp = Wd_t + ((size_t)e * D + n0 + r) * FF + 8 * h;
        f32x16 acc;
#pragma unroll
        for (int i = 0; i < 16; ++i) acc[i] = 0.f;
#pragma unroll 8
        for (int k0 = 0; k0 < FF; k0 += 16) acc = __builtin_amdgcn_mfma_f32_32x32x16_bf16(*(const bf16x8*)(ap + k0), *(const bf16x8*)(bp + k0), acc, 0, 0, 0);
        const float bd = b_down[e * D + n0 + r];
#pragma unroll
        for (int i = 0; i < 16; ++i) Y[(size_t)(s0 + crow(i, h)) * D + n0 + r] = (bf16)f2bf(acc[i] + bd);
    }
}

DEV void phase_combine(Frame& F, const Args& a) {
    moe_layout(F, a);
    volatile LAS int* L = (volatile LAS int*)(F.lds + LDS_CTL);
    const int srow = L[LC_START + L[LC_SPLIT]];
    const bf16* Y0 = (const bf16*)(a.ws + WS_Y0); const bf16* Y1 = (const bf16*)(a.ws + WS_Y1) - (size_t)srow * D;
    const u32x2* info = (const u32x2*)(a.ws + WS_INFO); bf16* HP = (bf16*)(a.ws + WS_HP); const float* g_ple = a.in[21];
    const int lane = F.lane;
    for (int m = F.gw; m < T; m += F.NGW) {
        f32x4* xr = (f32x4*)(a.out + (size_t)m * D) + lane;
        f32x4 v[4];
#pragma unroll
        for (int j = 0; j < 4; ++j) v[j] = xr[64 * j];
#pragma unroll
        for (int k = 0; k < 4; ++k) { const u32x2 w = info[(size_t)m * 4 + k]; const int e = w.x & 31, gpos = (int)(w.x >> 5); const unsigned wy = w.y; const float g = __uint_as_float(wy);
            const int row = L[LC_START + e] + gpos; const bf16* yr = (row < srow ? Y0 : Y1) + (size_t)row * D;
#pragma unroll
            for (int j = 0; j < 4; ++j) { const u32x2 yw = *((const u32x2*)yr + lane + 64 * j);
                v[j].x += g * bflo(yw.x); v[j].y += g * bfhi(yw.x); v[j].z += g * bflo(yw.y); v[j].w += g * bfhi(yw.y); } }
        float s = 0.f;
#pragma unroll
        for (int j = 0; j < 4; ++j) { xr[64 * j] = v[j]; s += (v[j].x * v[j].x + v[j].y * v[j].y) + (v[j].z * v[j].z + v[j].w * v[j].w); }
        const float rstd = 1.0f / sqrtf(wave_sum(s) * (1.f / D) + RMS_EPS);
        unsigned long long* o8 = (unsigned long long*)(HP + (size_t)m * D) + lane;
#pragma unroll
        for (int j = 0; j < 4; ++j) { const f32x4 gg = *((const f32x4*)g_ple + lane + 64 * j);
            o8[64 * j] = (unsigned long long)pk2(v[j].x * rstd * gg.x, v[j].y * rstd * gg.y) | ((unsigned long long)pk2(v[j].z * rstd * gg.z, v[j].w * rstd * gg.w) << 32); }
    }
}
struct EpiStoreBf16 { bf16* O; int ldc;
    DEV void operator()(int row, int col, float v) const { O[(size_t)row * ldc + col] = (bf16)f2bf(v); } };
struct EpiPle { const bf16* PP; float* out;
    DEV void operator()(int row, int col, float v) const { const size_t i = (size_t)row * D + col; out[i] = out[i] + sigmoidf_(v) * bf2f(PP[i]); } };

DEV void phase_final(Frame& F, const Args& a) {
    const float* g = a.in[24]; const int lane = F.lane;
    for (int m = F.gw; m < T; m += F.NGW) {
        f32x4* xr = (f32x4*)(a.out + (size_t)m * D) + lane;
        f32x4 v[4]; float s = 0.f;
#pragma unroll
        for (int j = 0; j < 4; ++j) { v[j] = xr[64 * j]; s += (v[j].x * v[j].x + v[j].y * v[j].y) + (v[j].z * v[j].z + v[j].w * v[j].w); }
        const float rstd = 1.0f / sqrtf(wave_sum(s) * (1.f / D) + RMS_EPS);
#pragma unroll
        for (int j = 0; j < 4; ++j) xr[64 * j] = v[j] * rstd * *((const f32x4*)g + lane + 64 * j);
    }
}


namespace pg8 {
constexpr int BM = 256, BK = 64, HALF = 128, HTB = HALF * BK * 2, STAGE_BYTES = 8 * HTB;
DEV int lds_byte(int r, int c) { const int st = (r >> 4) * 2 + (c >> 5), rr = r & 15, cc = c & 31, ob = rr * 64 + cc * 2; return st * 1024 + (ob ^ (((ob >> 9) & 1) << 5)); }
DEV void stage_rc(int b, int& R, int& C) { const int st = b / 1024, sb = b % 1024, swz = sb ^ (((sb >> 9) & 1) << 5); R = (st >> 1) * 16 + swz / 64; C = (st & 1) * 32 + (swz % 64) / 2; }
DEV int perm32(int rho) { const int n = rho >> 4, i = rho & 15; return 8 * (i >> 2) + 4 * n + (i & 3); }
struct Unit { int pm, pn, e, mt; };
DEV unsigned cvt_pk_bf16(float lo, float hi) { unsigned r; asm volatile("v_cvt_pk_bf16_f32 %0, %1, %2" : "=v"(r) : "v"(lo), "v"(hi)); return r; }

template <class Epi, class Sched, bool GATHER>
DEV void gemm_phase(LAS unsigned char* lds, const bf16* A, int lda, const bf16* Bt, int ldb, int K, const Sched& S, const Epi& E, const int* list, volatile LAS int* L) {
    const int tid = threadIdx.x, wid = __builtin_amdgcn_readfirstlane(tid >> 6), lane = tid & 63, wr = wid >> 2, wc = wid & 3, fr = lane & 15, fq = lane >> 4;
    const int nt = K / BK;
    unsigned voffA[2], voffB[2]; int RA[2], CA[2];
#pragma unroll
    for (int i = 0; i < 2; ++i) { int R, C; stage_rc(tid * 16 + i * 8192, R, C); const int Rb = Epi::PERM ? ((R & ~31) + perm32(R & 31)) : R;
        voffA[i] = (unsigned)(R * lda + C) * 2u; voffB[i] = (unsigned)(Rb * ldb + C) * 2u; RA[i] = R; CA[i] = C; }
    const size_t kstep = (size_t)(BK * 2);
    const size_t hstepA = (size_t)HALF * lda * 2, hstepB = (size_t)HALF * ldb * 2;
    const unsigned ldsw = (unsigned)wid * 1024u;
    const int aoff = lds_byte(wr * 64 + fr, fq * 8), boff = lds_byte(wc * 32 + fr, fq * 8);
#define PG8_SA(b, h) (((b) * 2 + (h)) * HTB)
#define PG8_SB(b, h) ((4 + (b) * 2 + (h)) * HTB)
#define PG8_STAGE(bufoff, gbase, voff) do { _Pragma("unroll") for (int _i = 0; _i < 2; ++_i) \
        __builtin_amdgcn_global_load_lds((const unsigned*)((const char*)(gbase) + (voff)[_i]), (LAS unsigned*)(lds + (bufoff) + ldsw + _i * 8192), 16, 0, 0); } while (0)
#define PG8_LDA(dst, b, h) do { _Pragma("unroll") for (int m = 0; m < 4; ++m) _Pragma("unroll") for (int k = 0; k < 2; ++k) dst[m][k] = *(const LAS bf16x8*)(lds + PG8_SA(b, h) + aoff + m * 2048 + k * 1024); } while (0)
#define PG8_LDB(dst, b, h) do { _Pragma("unroll") for (int n = 0; n < 2; ++n) _Pragma("unroll") for (int k = 0; k < 2; ++k) dst[n][k] = *(const LAS bf16x8*)(lds + PG8_SB(b, h) + boff + n * 2048 + k * 1024); } while (0)
#define PG8_MMA(ai, bj, At, Bt_) do { __builtin_amdgcn_s_setprio(1); _Pragma("unroll") for (int m = 0; m < 4; ++m) _Pragma("unroll") for (int n = 0; n < 2; ++n) _Pragma("unroll") for (int k = 0; k < 2; ++k) \
        acc[ai][bj][m][n] = __builtin_amdgcn_mfma_f32_16x16x32_bf16(Bt_[n][k], At[m][k], acc[ai][bj][m][n], 0, 0, 0); __builtin_amdgcn_s_setprio(0); } while (0)
#define PG8_WAIT_V(n) asm volatile("s_waitcnt vmcnt(" #n ")" ::: "memory")
#define PG8_WAIT_L(n) asm volatile("s_waitcnt lgkmcnt(" #n ")" ::: "memory")
#define PG8_BAR __builtin_amdgcn_s_barrier()
#define PG8_SCHED __builtin_amdgcn_sched_barrier(0)
    unsigned aoc[2][2], aon[2][2];
#define PG8_GATHER_OFFS(dst, u) do { _Pragma("unroll") for (int _h = 0; _h < 2; ++_h) _Pragma("unroll") for (int _i = 0; _i < 2; ++_i) { \
        const int _idx = (u).mt * 256 + _h * HALF + RA[_i]; const int _tok = _idx < L[LC_CNT + (u).e] ? list[(size_t)(u).e * T + _idx] : 0; \
        dst[_h][_i] = (unsigned)(_tok * lda + CA[_i]) * 2u; } } while (0)
    Unit cur, nxt; int ui = 0;
    if (!S.next(0, cur)) return;
    f32x4 acc[2][2][4][2];
#pragma unroll
    for (int a = 0; a < 2; ++a)
#pragma unroll
        for (int b = 0; b < 2; ++b)
#pragma unroll
            for (int m = 0; m < 4; ++m)
#pragma unroll
                for (int n = 0; n < 2; ++n) acc[a][b][m][n] = (f32x4){0.f, 0.f, 0.f, 0.f};
    bf16x8 At[4][2], B0[2][2], B1[2][2];
    const char* cA; const char* cB = (const char*)Bt + S.brow(cur) * (size_t)ldb * 2;
    if constexpr (GATHER) { cA = (const char*)A; PG8_GATHER_OFFS(aoc, cur); }
    else { cA = (const char*)A + (size_t)cur.pm * BM * lda * 2;
#pragma unroll
        for (int i = 0; i < 2; ++i) { aoc[0][i] = voffA[i]; aoc[1][i] = voffA[i] + (unsigned)hstepA; } }
    PG8_STAGE(PG8_SB(0, 0), cB, voffB); PG8_STAGE(PG8_SB(0, 1), cB + hstepB, voffB); PG8_STAGE(PG8_SA(0, 0), cA, aoc[0]); PG8_STAGE(PG8_SA(0, 1), cA, aoc[1]);
    if (wr == 1) PG8_BAR;
    PG8_WAIT_V(2); PG8_BAR;
    PG8_STAGE(PG8_SB(1, 0), cB + kstep, voffB); PG8_STAGE(PG8_SA(1, 0), cA + kstep, aoc[0]); PG8_STAGE(PG8_SB(1, 1), cB + hstepB + kstep, voffB);
    PG8_WAIT_V(6); PG8_BAR;
    for (;;) {
        const bool has_next = S.next(ui + 1, nxt);
        const char* nA; const char* nB = has_next ? (const char*)Bt + S.brow(nxt) * (size_t)ldb * 2 : cB;
        if constexpr (GATHER) { nA = cA; if (has_next) PG8_GATHER_OFFS(aon, nxt); else {
#pragma unroll
            for (int h = 0; h < 2; ++h)
#pragma unroll
                for (int i = 0; i < 2; ++i) aon[h][i] = aoc[h][i]; } }
        else { nA = has_next ? (const char*)A + (size_t)nxt.pm * BM * lda * 2 : cA; }
#pragma unroll 1
        for (int t = 0; t < nt; t += 2) {
            const bool last = (t == nt - 2);
            const char* a1 = cA + (size_t)(t + 1) * kstep;
            const char* a2 = last ? nA : cA + (size_t)(t + 2) * kstep; const char* b2 = last ? nB : cB + (size_t)(t + 2) * kstep;
            const char* a3 = a2 + kstep; const char* b3 = b2 + kstep;
            unsigned ao2[2][2];
#pragma unroll
            for (int h = 0; h < 2; ++h)
#pragma unroll
                for (int i = 0; i < 2; ++i) ao2[h][i] = GATHER ? (last ? aon[h][i] : aoc[h][i]) : aoc[h][i];
            PG8_LDB(B0, 0, 0); PG8_LDB(B1, 0, 1); PG8_SCHED; PG8_LDA(At, 0, 0); PG8_STAGE(PG8_SA(1, 1), a1, aoc[1]);
            PG8_WAIT_V(8); PG8_WAIT_L(0); PG8_BAR; PG8_MMA(0, 0, At, B0); PG8_MMA(0, 1, At, B1); PG8_BAR; PG8_SCHED;
            PG8_LDA(At, 0, 1); PG8_STAGE(PG8_SB(0, 0), b2, voffB); PG8_STAGE(PG8_SB(0, 1), b2 + hstepB, voffB); PG8_STAGE(PG8_SA(0, 0), a2, ao2[0]);
            PG8_WAIT_V(8); PG8_WAIT_L(0); PG8_BAR; PG8_MMA(1, 0, At, B0); PG8_MMA(1, 1, At, B1); PG8_BAR; PG8_SCHED;
            PG8_LDB(B0, 1, 0); PG8_LDB(B1, 1, 1); PG8_SCHED; PG8_LDA(At, 1, 0); PG8_STAGE(PG8_SA(0, 1), a2, ao2[1]);
            PG8_WAIT_V(8); PG8_WAIT_L(0); PG8_BAR; PG8_MMA(0, 0, At, B0); PG8_MMA(0, 1, At, B1); PG8_BAR; PG8_SCHED;
            PG8_LDA(At, 1, 1); PG8_STAGE(PG8_SB(1, 0), b3, voffB); PG8_STAGE(PG8_SB(1, 1), b3 + hstepB, voffB); PG8_STAGE(PG8_SA(1, 0), a3, ao2[0]);
            PG8_WAIT_V(8); PG8_WAIT_L(0); PG8_BAR; PG8_MMA(1, 0, At, B0); PG8_MMA(1, 1, At, B1); PG8_BAR; PG8_SCHED;
        }
        if (wr == 0) PG8_BAR;
        E(acc, cur, wr, wc, fr, fq);
        if (!has_next) break;
#pragma unroll
        for (int a = 0; a < 2; ++a)
#pragma unroll
            for (int b = 0; b < 2; ++b)
#pragma unroll
                for (int m = 0; m < 4; ++m)
#pragma unroll
                    for (int n = 0; n < 2; ++n) acc[a][b][m][n] = (f32x4){0.f, 0.f, 0.f, 0.f};
        cur = nxt; cA = nA; cB = nB; ++ui;
        if constexpr (GATHER) {
#pragma unroll
            for (int h = 0; h < 2; ++h)
#pragma unroll
                for (int i = 0; i < 2; ++i) aoc[h][i] = aon[h][i]; }
        if (wr == 1) PG8_BAR;
    }
    PG8_WAIT_V(0);
    PG8_BAR;
#undef PG8_SA
#undef PG8_SB
#undef PG8_STAGE
#undef PG8_LDA
#undef PG8_LDB
#undef PG8_MMA
#undef PG8_WAIT_V
#undef PG8_WAIT_L
#undef PG8_BAR
#undef PG8_SCHED
#undef PG8_GATHER_OFFS
}

struct StaticOrder {
    int nM, nN, nwg, G, c;
    DEV void init(int M, int N, int G_, int c_) { nM = M / BM; nN = N / BM; nwg = nM * nN; G = G_; c = c_; }
    DEV bool next(int i, Unit& u) const {
        const long Lx = (long)i * G + c; if (Lx >= nwg) return false;
        int wgid = (int)Lx; { const int q = nwg / 8, r = nwg % 8, xcd = wgid % 8, off = wgid / 8; wgid = (xcd < r ? xcd * (q + 1) : r * (q + 1) + (xcd - r) * q) + off; }
        const int nig = 8 * nN, gid = wgid / nig, fm = gid * 8, gsz = (nM - fm) < 8 ? (nM - fm) : 8;
        u.pm = fm + ((wgid % nig) % gsz); u.pn = (wgid % nig) / gsz; u.e = 0; u.mt = 0; return true;
    }
    DEV size_t brow(const Unit& u) const { return (size_t)u.pn * BM; }
};
struct MoeOrder {
    volatile LAS int* L; int e_lo, e_hi, NT, G, c, brows;
    DEV bool next(int i, Unit& u) const {
        const int per = G >> 3; int U = (i * 8 + (c & 7)) * per + (c >> 3);
        int e = e_lo;
        for (; e < e_hi; ++e) { const int nu = (((L[LC_CNT + e] + 255) >> 8)) * NT; if (U < nu) break; U -= nu; }
        if (e >= e_hi) return false;
        const int GS = 32 / NT, nm = (L[LC_CNT + e] + 255) >> 8, g = U >> 5, q2 = U - (g << 5);
        const int gsz = (nm - GS * g) < GS ? (nm - GS * g) : GS;
        u.e = e; u.pn = q2 / gsz; u.mt = GS * g + q2 % gsz; u.pm = (L[LC_START + e] >> 8) + u.mt; return true;
    }
    DEV size_t brow(const Unit& u) const { return (size_t)u.e * brows + (size_t)u.pn * BM; }
};
}

using pg8::Unit;
DEV u32x4 pack8(const f32x4& v0, const f32x4& v1) { u32x4 w; w.x = pg8::cvt_pk_bf16(v0[0], v0[1]); w.y = pg8::cvt_pk_bf16(v0[2], v0[3]); w.z = pg8::cvt_pk_bf16(v1[0], v1[1]); w.w = pg8::cvt_pk_bf16(v1[2], v1[3]); return w; }
DEV f32x4 lo4(const u32x4& w) { return (f32x4){bflo(w.x), bfhi(w.x), bflo(w.y), bfhi(w.y)}; }
DEV f32x4 hi4(const u32x4& w) { return (f32x4){bflo(w.z), bfhi(w.z), bflo(w.w), bfhi(w.w)}; }
struct FEpiZ { static constexpr bool PERM = true; bf16* Z1; bf16* Z2;
    DEV void operator()(const f32x4 (&acc)[2][2][4][2], const Unit& u, int wr, int wc, int fr, int fq) const {
        const int row0 = u.pm * 256 + wr * 64 + fr, pn = u.pn;
        bf16* base; int ld, colt, kind;
        if (pn < 7) { base = Z1; ld = Z1W; colt = pn * 256; kind = pn < 2 ? 0 : (pn == 2 ? 1 : 2); } else { base = Z2; ld = Z2W; colt = (pn - 7) * 256; kind = 3; }
        const int col0 = colt + wc * 32 + 8 * fq;
#pragma unroll
        for (int ai = 0; ai < 2; ++ai)
#pragma unroll
            for (int m = 0; m < 4; ++m) { bf16* rowp = base + (size_t)(row0 + ai * 128 + m * 16) * ld + col0;
#pragma unroll
                for (int bj = 0; bj < 2; ++bj) { f32x4 v0 = acc[ai][bj][m][0], v1 = acc[ai][bj][m][1];
                    if (kind == 0) { v0 = v0 * QSCALE; v1 = v1 * QSCALE; }
                    else if (kind == 2) {
#pragma unroll
                        for (int j = 0; j < 4; ++j) { v0[j] = gelu_tanh(v0[j]); v1[j] = gelu_tanh(v1[j]); } }
                    else if (kind == 3) {
#pragma unroll
                        for (int j = 0; j < 4; ++j) { v0[j] = sigmoidf_(v0[j]); v1[j] = sigmoidf_(v1[j]); } }
                    *(u32x4*)(rowp + bj * 128) = pack8(v0, v1); } }
    } };
struct FEpiProjA { static constexpr bool PERM = true; const bf16* Z2; bf16* TMP;
    DEV void operator()(const f32x4 (&acc)[2][2][4][2], const Unit& u, int wr, int wc, int fr, int fq) const {
        const int row0 = u.pm * 256 + wr * 64 + fr, col0 = u.pn * 256 + wc * 32 + 8 * fq;
#pragma unroll
        for (int ai = 0; ai < 2; ++ai)
#pragma unroll
            for (int m = 0; m < 4; ++m) { const size_t r = (size_t)(row0 + ai * 128 + m * 16);
#pragma unroll
                for (int bj = 0; bj < 2; ++bj) { const u32x4 g = *(const u32x4*)(Z2 + r * Z2W + col0 + bj * 128);
                    *(u32x4*)(TMP + r * D + col0 + bj * 128) = pack8(acc[ai][bj][m][0] * lo4(g), acc[ai][bj][m][1] * hi4(g)); } }
    } };
struct FEpiProjB { static constexpr bool PERM = true; const bf16* Z2; const bf16* TMP; bf16* MRG;
    DEV void operator()(const f32x4 (&acc)[2][2][4][2], const Unit& u, int wr, int wc, int fr, int fq) const {
        const int row0 = u.pm * 256 + wr * 64 + fr, col0 = u.pn * 256 + wc * 32 + 8 * fq;
#pragma unroll
        for (int ai = 0; ai < 2; ++ai)
#pragma unroll
            for (int m = 0; m < 4; ++m) { const size_t r = (size_t)(row0 + ai * 128 + m * 16);
#pragma unroll
                for (int bj = 0; bj < 2; ++bj) { const u32x4 g = *(const u32x4*)(Z2 + r * Z2W + 1024 + col0 + bj * 128); const u32x4 t = *(const u32x4*)(TMP + r * D + col0 + bj * 128);
                    *(u32x4*)(MRG + r * D + col0 + bj * 128) = pack8(lo4(t) + acc[ai][bj][m][0] * lo4(g), hi4(t) + acc[ai][bj][m][1] * hi4(g)); } }
    } };
struct FEpiResid { static constexpr bool PERM = false; const float* base; float* out;
    DEV void operator()(const f32x4 (&acc)[2][2][4][2], const Unit& u, int wr, int wc, int fr, int fq) const {
        const int row0 = u.pm * 256 + wr * 64 + fr, col0 = u.pn * 256 + wc * 32 + 4 * fq;
#pragma unroll
        for (int ai = 0; ai < 2; ++ai)
#pragma unroll
            for (int m = 0; m < 4; ++m) { const size_t off = (size_t)(row0 + ai * 128 + m * 16) * D + col0;
#pragma unroll
                for (int bj = 0; bj < 2; ++bj)
#pragma unroll
                    for (int n = 0; n < 2; ++n) *(f32x4*)(out + off + bj * 128 + n * 16) = *(const f32x4*)(base + off + bj * 128 + n * 16) + acc[ai][bj][m][n]; }
    } };
struct FEpiMoeUp { static constexpr bool PERM = true; const float* b_gate; const float* b_up; bf16* ACT; const float* srs;
    DEV void operator()(const f32x4 (&acc)[2][2][4][2], const Unit& u, int wr, int wc, int fr, int fq) const {
        const int row0 = u.pm * 256 + wr * 64 + fr, f0 = u.pn * 128 + wc * 32 + 8 * fq;
        const f32x4 bg0 = *(const f32x4*)(b_gate + u.e * FF + f0), bg1 = *(const f32x4*)(b_gate + u.e * FF + f0 + 4), bu0 = *(const f32x4*)(b_up + u.e * FF + f0), bu1 = *(const f32x4*)(b_up + u.e * FF + f0 + 4);
#pragma unroll
        for (int ai = 0; ai < 2; ++ai)
#pragma unroll
            for (int m = 0; m < 4; ++m) { const float rr_ = srs[(size_t)u.e * T + u.mt * 256 + ai * 128 + wr * 64 + m * 16 + fr];
                f32x4 a0 = acc[ai][0][m][0] * rr_ + bg0, a1 = acc[ai][0][m][1] * rr_ + bg1, b0 = acc[ai][1][m][0] * rr_ + bu0, b1 = acc[ai][1][m][1] * rr_ + bu1;
#pragma unroll
                for (int j = 0; j < 4; ++j) { a0[j] = swiglu(a0[j], b0[j]); a1[j] = swiglu(a1[j], b1[j]); }
                *(u32x4*)(ACT + (size_t)(row0 + ai * 128 + m * 16) * FF + f0) = pack8(a0, a1); }
    } };
struct FEpiMoeDown { static constexpr bool PERM = true; const float* b_down; bf16* Y;
    DEV void operator()(const f32x4 (&acc)[2][2][4][2], const Unit& u, int wr, int wc, int fr, int fq) const {
        const int row0 = u.pm * 256 + wr * 64 + fr, col0 = u.pn * 256 + wc * 32 + 8 * fq;
        f32x4 bv[2][2];
#pragma unroll
        for (int bj = 0; bj < 2; ++bj)
#pragma unroll
            for (int n = 0; n < 2; ++n) bv[bj][n] = *(const f32x4*)(b_down + u.e * D + col0 + bj * 128 + 4 * n);
#pragma unroll
        for (int ai = 0; ai < 2; ++ai)
#pragma unroll
            for (int m = 0; m < 4; ++m) { bf16* rowp = Y + (size_t)(row0 + ai * 128 + m * 16) * D + col0;
#pragma unroll
                for (int bj = 0; bj < 2; ++bj) *(u32x4*)(rowp + bj * 128) = pack8(acc[ai][bj][m][0] + bv[bj][0], acc[ai][bj][m][1] + bv[bj][1]); }
    } };
struct FEpiBf16 { static constexpr bool PERM = true; bf16* O; int ldc;
    DEV void operator()(const f32x4 (&acc)[2][2][4][2], const Unit& u, int wr, int wc, int fr, int fq) const {
        const int row0 = u.pm * 256 + wr * 64 + fr, col0 = u.pn * 256 + wc * 32 + 8 * fq;
#pragma unroll
        for (int ai = 0; ai < 2; ++ai)
#pragma unroll
            for (int m = 0; m < 4; ++m) { bf16* rowp = O + (size_t)(row0 + ai * 128 + m * 16) * ldc + col0;
#pragma unroll
                for (int bj = 0; bj < 2; ++bj) *(u32x4*)(rowp + bj * 128) = pack8(acc[ai][bj][m][0], acc[ai][bj][m][1]); }
    } };
struct FEpiPle { static constexpr bool PERM = false; const bf16* PP; float* out;
    DEV void operator()(const f32x4 (&acc)[2][2][4][2], const Unit& u, int wr, int wc, int fr, int fq) const {
        const int row0 = u.pm * 256 + wr * 64 + fr, col0 = u.pn * 256 + wc * 32 + 4 * fq;
#pragma unroll
        for (int ai = 0; ai < 2; ++ai)
#pragma unroll
            for (int m = 0; m < 4; ++m) { const size_t off = (size_t)(row0 + ai * 128 + m * 16) * D + col0;
#pragma unroll
                for (int bj = 0; bj < 2; ++bj)
#pragma unroll
                    for (int n = 0; n < 2; ++n) { const size_t o = off + bj * 128 + n * 16; const u32x2 pw = *(const u32x2*)(PP + o); const f32x4 a = acc[ai][bj][m][n];
                        f32x4 r = *(const f32x4*)(out + o);
                        r[0] += sigmoidf_(a[0]) * bflo(pw.x); r[1] += sigmoidf_(a[1]) * bfhi(pw.x); r[2] += sigmoidf_(a[2]) * bflo(pw.y); r[3] += sigmoidf_(a[3]) * bfhi(pw.y);
                        *(f32x4*)(out + o) = r; }
                asm volatile("" ::: "memory"); }
    } };


#define MFMA32(a, b, c) __builtin_amdgcn_mfma_f32_32x32x16_bf16((a), (b), (c), 0, 0, 0)
DEV void phase_mixers_fast(Frame& F, const Args& a) {
    const bf16* Z1 = (const bf16*)(a.ws + WS_Z1); bf16* AP = (bf16*)(a.ws + WS_AP);
    const int tid = F.tid, lane = F.lane, r = lane & 31, h = lane >> 5, wave = F.wave;
    {
        LAS unsigned char* Kl = F.lds;
        LAS unsigned char* Vl = F.lds + 36864;
        LAS float* wsf = (LAS float*)(F.lds + 70144) + wave * 64;
        const float* sinks = a.in[4];
        for (int u = F.vcu; u < 512; u += F.G) {
            const int kvh = u & 1, bn = u >> 1, b = bn >> 4, n = bn & 15;
            const int tok0 = b * SEQ + n * 128, key0 = tok0 - 128;
            __syncthreads();
#pragma unroll
            for (int i = 0; i < 4; ++i) { const int idx = tid + 512 * i, key = idx >> 3, ch = idx & 7;
                u32x4 v = (u32x4){0u, 0u, 0u, 0u};
                if (n > 0 || key >= 128) v = *(const u32x4*)(Z1 + (size_t)(key0 + key) * Z1W + 512 + kvh * 64 + ch * 8);
                *(LAS u32x4*)(Kl + key * 144 + ch * 16) = v; }
#pragma unroll
            for (int i = 0; i < 2; ++i) { const int idx = tid + 512 * i, kp = idx >> 3, ch = idx & 7;
                u32x4 v0 = (u32x4){0u, 0u, 0u, 0u}, v1 = v0;
                if (n > 0 || kp >= 64) { const bf16* vp = Z1 + (size_t)(key0 + 2 * kp) * Z1W + 640 + kvh * 64 + ch * 8; v0 = *(const u32x4*)vp; v1 = *(const u32x4*)(vp + Z1W); }
                LAS unsigned char* dst = Vl + (ch * 8) * 520 + kp * 4;
                *(LAS unsigned*)(dst + 0 * 520) = (v0.x & 0xffffu) | (v1.x << 16); *(LAS unsigned*)(dst + 1 * 520) = (v0.x >> 16) | (v1.x & 0xffff0000u);
                *(LAS unsigned*)(dst + 2 * 520) = (v0.y & 0xffffu) | (v1.y << 16); *(LAS unsigned*)(dst + 3 * 520) = (v0.y >> 16) | (v1.y & 0xffff0000u);
                *(LAS unsigned*)(dst + 4 * 520) = (v0.z & 0xffffu) | (v1.z << 16); *(LAS unsigned*)(dst + 5 * 520) = (v0.z >> 16) | (v1.z & 0xffff0000u);
                *(LAS unsigned*)(dst + 6 * 520) = (v0.w & 0xffffu) | (v1.w << 16); *(LAS unsigned*)(dst + 7 * 520) = (v0.w >> 16) | (v1.w & 0xffff0000u); }
            __syncthreads();
            const int g = wave >> 1, qh = wave & 1, hh = kvh * 4 + g;
            const float slope2 = fexp2(-(float)(hh + 1)) * LOG2E, sink2 = sinks[hh] * LOG2E;
#pragma unroll 1
            for (int qs = 0; qs < 2; ++qs) {
                const int q0 = qh * 64 + qs * 32, kt0 = q0 >> 5, ql = q0 + r;
                bf16x8 qf[4];
#pragma unroll
                for (int ds = 0; ds < 4; ++ds) qf[ds] = *(const bf16x8*)(Z1 + (size_t)(tok0 + ql) * Z1W + hh * 64 + 16 * ds + 8 * h);
                f32x16 p[5];
#pragma unroll
                for (int t = 0; t < 5; ++t) {
#pragma unroll
                    for (int i = 0; i < 16; ++i) p[t][i] = 0.f;
                    const LAS unsigned char* kb = Kl + (32 * (kt0 + t) + r) * 144 + 16 * h;
#pragma unroll
                    for (int ds = 0; ds < 4; ++ds) p[t] = MFMA32(*(const LAS bf16x8*)(kb + 32 * ds), qf[ds], p[t]);
                }
                float mx = sink2;
#pragma unroll
                for (int t = 0; t < 5; ++t)
#pragma unroll
                    for (int i = 0; i < 16; ++i) { const int sk = 32 * (kt0 + t) + crow(i, h), dist = ql + 128 - sk;
                        const bool ok = ((unsigned)dist < 128u) && (n > 0 || sk >= 128);
                        const float v = ok ? p[t][i] - slope2 * (float)dist : -INFINITY; p[t][i] = v; mx = fmaxf(mx, v); }
                mx = fmaxf(mx, __shfl_xor(mx, 32));
                float ls = 0.f;
#pragma unroll
                for (int t = 0; t < 5; ++t)
#pragma unroll
                    for (int i = 0; i < 16; ++i) { const float e = fexp2(p[t][i] - mx); p[t][i] = e; ls += e; }
                ls += __shfl_xor(ls, 32); ls += fexp2(sink2 - mx);
                f32x16 o[2];
#pragma unroll
                for (int i = 0; i < 16; ++i) { o[0][i] = 0.f; o[1][i] = 0.f; }
#pragma unroll
                for (int t = 0; t < 5; ++t)
#pragma unroll
                    for (int s2 = 0; s2 < 2; ++s2) {
                        u32x4 pw; pw.x = pg8::cvt_pk_bf16(p[t][8 * s2 + 0], p[t][8 * s2 + 1]); pw.y = pg8::cvt_pk_bf16(p[t][8 * s2 + 2], p[t][8 * s2 + 3]);
                        pw.z = pg8::cvt_pk_bf16(p[t][8 * s2 + 4], p[t][8 * s2 + 5]); pw.w = pg8::cvt_pk_bf16(p[t][8 * s2 + 6], p[t][8 * s2 + 7]);
                        const bf16x8 pf = __builtin_bit_cast(bf16x8, pw);
#pragma unroll
                        for (int db = 0; db < 2; ++db) { const LAS unsigned char* vb = Vl + (db * 32 + r) * 520 + (32 * (kt0 + t) + 16 * s2 + 4 * h) * 2;
                            const u32x2 lo = *(const LAS u32x2*)vb, hi = *(const LAS u32x2*)(vb + 16);
                            u32x4 vw; vw.x = lo.x; vw.y = lo.y; vw.z = hi.x; vw.w = hi.y;
                            o[db] = MFMA32(pf, __builtin_bit_cast(bf16x8, vw), o[db]); }
                    }
                asm volatile("" ::: "memory");
                if (h == 0) wsf[r] = ls;
                asm volatile("s_waitcnt lgkmcnt(0)" ::: "memory");
                bf16* op = AP + (size_t)tok0 * D + hh * 64 + r;
#pragma unroll
                for (int i = 0; i < 16; ++i) { const int q = q0 + crow(i, h); const float il = frcp(wsf[crow(i, h)]);
                    op[(size_t)q * D] = (bf16)f2bf(o[0][i] * il); op[(size_t)q * D + 32] = (bf16)f2bf(o[1][i] * il); }
                asm volatile("s_waitcnt lgkmcnt(0)" ::: "memory");
            }
        }
    }
    {
        LAS unsigned char* vT = F.lds;
        LAS float* stl = (LAS float*)(F.lds + 69632);
        const bf16* Wsp = (const bf16*)(a.ws + WS_WSP); const float* g_ln = a.in[5]; const float* b_ln = a.in[6]; const float* b_sp = a.in[8];
        for (int u = F.vcu; u < 256; u += F.G) {
            const int tok0 = u * 128;
            __syncthreads();
            for (int rr = 0; rr < 16; ++rr) { const int t = wave * 16 + rr;
                const u32x4 w = *((const u32x4*)(Z1 + (size_t)(tok0 + t) * Z1W + 1280) + lane);
                float v[8] = {bflo(w.x), bfhi(w.x), bflo(w.y), bfhi(w.y), bflo(w.z), bfhi(w.z), bflo(w.w), bfhi(w.w)};
                float s = 0.f;
#pragma unroll
                for (int j = 0; j < 8; ++j) s += v[j];
                const float mean = wave_sum(s) * (1.f / 512.f); float q = 0.f;
#pragma unroll
                for (int j = 0; j < 8; ++j) { const float d = v[j] - mean; q += d * d; }
                const float rstd = 1.0f / sqrtf(wave_sum(q) * (1.f / 512.f) + LN_EPS);
                if (lane == 0) { stl[2 * t] = mean; stl[2 * t + 1] = rstd; } }
#pragma unroll 1
            for (int hf = 0; hf < 2; ++hf) {
                __syncthreads();
#pragma unroll
                for (int i = 0; i < 4; ++i) { const int c8 = wave * 4 + i, tp = lane, ch0 = 256 * hf + 8 * c8;
                    const bf16* vp = Z1 + (size_t)(tok0 + 2 * tp) * Z1W + 1280 + ch0;
                    const u32x4 w0 = *(const u32x4*)vp, w1 = *(const u32x4*)(vp + Z1W);
                    const float m0 = stl[4 * tp], r0 = stl[4 * tp + 1], m1 = stl[4 * tp + 2], r1 = stl[4 * tp + 3];
                    const f32x4 ga = *(const f32x4*)(g_ln + ch0), gb = *(const f32x4*)(g_ln + ch0 + 4), ba = *(const f32x4*)(b_ln + ch0), bb = *(const f32x4*)(b_ln + ch0 + 4);
                    LAS unsigned char* dst = vT + (8 * c8) * 272 + tp * 4;
#define VT_W(j, w0c, w1c, gg, bbv, SEL) *(LAS unsigned*)(dst + (j) * 272) = pg8::cvt_pk_bf16((SEL(w0c) - m0) * r0 * (gg) + (bbv), (SEL(w1c) - m1) * r1 * (gg) + (bbv))
                    VT_W(0, w0.x, w1.x, ga.x, ba.x, bflo); VT_W(1, w0.x, w1.x, ga.y, ba.y, bfhi); VT_W(2, w0.y, w1.y, ga.z, ba.z, bflo); VT_W(3, w0.y, w1.y, ga.w, ba.w, bfhi);
                    VT_W(4, w0.z, w1.z, gb.x, bb.x, bflo); VT_W(5, w0.z, w1.z, gb.y, bb.y, bfhi); VT_W(6, w0.w, w1.w, gb.z, bb.z, bflo); VT_W(7, w0.w, w1.w, gb.w, bb.w, bfhi);
#undef VT_W
                }
                __syncthreads();
                const int gl = wave >> 2, cq = wave & 3, g = 2 * hf + gl, chb = gl * 128 + cq * 32;
                const int chg = 256 * hf + chb + r;
#pragma unroll 1
                for (int tt = 0; tt < 4; ++tt) {
                    f32x16 acc;
#pragma unroll
                    for (int i = 0; i < 16; ++i) acc[i] = 0.f;
                    const bf16* wp = Wsp + ((size_t)g * 128 + 32 * tt + r) * 128 + 8 * h;
                    const LAS unsigned char* bp = vT + (chb + r) * 272 + 16 * h;
#pragma unroll 2
                    for (int ss = 0; ss < 2 * tt + 2; ++ss) acc = MFMA32(*(const bf16x8*)(wp + 16 * ss), *(const LAS bf16x8*)(bp + 32 * ss), acc);
#pragma unroll
                    for (int i = 0; i < 16; ++i) { const int t = 32 * tt + crow(i, h); const size_t tok = (size_t)(tok0 + t);
                        const float uu = bf2f(Z1[tok * Z1W + 768 + chg]);
                        AP[tok * D + 512 + chg] = (bf16)f2bf(uu * (acc[i] + b_sp[g * 128 + t])); }
                }
            }
        }
    }
    __syncthreads();
}

constexpr int NPHASES = 14;
__global__ void __launch_bounds__(NTHREADS, 2) fwd(Args a) {
    extern __shared__ __attribute__((aligned(16))) unsigned char lds_raw[];
    Frame F;
    F.lds = (LAS unsigned char*)lds_raw;
    F.tid = threadIdx.x; F.lane = F.tid & 63; F.wave = __builtin_amdgcn_readfirstlane(F.tid >> 6);
    F.G = gridDim.x; { const int bx = blockIdx.x; F.vcu = (F.G % 8 == 0) ? (bx % 8) * (F.G / 8) + bx / 8 : bx; }
    F.gw = F.vcu * NWAVES + F.wave; F.NGW = F.G * NWAVES;
    for (int u = F.tid; u < (LDS_BYTES - LDS_CTL) / 4; u += NTHREADS) ((LAS unsigned*)(F.lds + LDS_CTL))[u] = 0u;
    __syncthreads();
    unsigned* ctl = (unsigned*)(a.ws + WS_CTL);
    const bool one = (a.ph_hi - a.ph_lo) > 1;
    XcdBarrier bar; bar.bar = ctl + CW_BAR; bar.x = 0; bar.st = nullptr;
    if (one) bar = xcd_barrier_post(ctl + CW_BAR, (volatile LAS unsigned*)(F.lds + LDS_CTL) + LC_BAR);
    unsigned char* ws = a.ws;
#define IN(k) (a.ph_lo <= (k) && (k) < a.ph_hi)
#define SEAM(k) do { if (IN(k) && IN((k) + 1)) xcd_barrier(bar); } while (0)
    if (IN(0)) { phase_prologue(F, a); } SEAM(0);
    volatile LAS int* Lc = (volatile LAS int*)(F.lds + LDS_CTL);
#if FAST_G1
    if (IN(1)) { FEpiZ E{(bf16*)(ws + WS_Z1), (bf16*)(ws + WS_Z2)}; pg8::StaticOrder S; S.init(T, NZ, F.G, (int)blockIdx.x);
        pg8::gemm_phase<FEpiZ, pg8::StaticOrder, false>(F.lds, (const bf16*)a.out, D, (const bf16*)(ws + WS_WIN), D, D, S, E, nullptr, Lc); } SEAM(1);
#else
    if (IN(1)) { EpiZ E{(bf16*)(ws + WS_Z1), (bf16*)(ws + WS_Z2)}; ngemm_wave((const bf16*)a.out, D, (const bf16*)(ws + WS_WIN), D, T / 32, NZ / 32, D, F, E); } SEAM(1);
#endif
#if FAST_MIX
    if (IN(3)) { phase_mixers_fast(F, a); } SEAM(3);
#else
    if (IN(2)) { phase_lnstats(F, a); } SEAM(2);
    if (IN(3)) { phase_mixers_ref(F, a); } SEAM(3);
#endif
#if FAST_G4
    if (IN(4)) { FEpiProjA E{(const bf16*)(ws + WS_Z2), (bf16*)(ws + WS_TMP)}; pg8::StaticOrder S; S.init(T, D, F.G, (int)blockIdx.x);
        pg8::gemm_phase<FEpiProjA, pg8::StaticOrder, false>(F.lds, (const bf16*)(ws + WS_AP), D, (const bf16*)(ws + WS_WAB), D, 512, S, E, nullptr, Lc); } SEAM(4);
    if (IN(5)) { FEpiProjB E{(const bf16*)(ws + WS_Z2), (const bf16*)(ws + WS_TMP), (bf16*)(ws + WS_MRG)}; pg8::StaticOrder S; S.init(T, D, F.G, (int)blockIdx.x);
        pg8::gemm_phase<FEpiProjB, pg8::StaticOrder, false>(F.lds, (const bf16*)(ws + WS_AP) + 512, D, (const bf16*)(ws + WS_WAB) + 512, D, 512, S, E, nullptr, Lc); } SEAM(5);
    if (IN(6)) { FEpiResid E{a.in[0], a.out}; pg8::StaticOrder S; S.init(T, D, F.G, (int)blockIdx.x);
        pg8::gemm_phase<FEpiResid, pg8::StaticOrder, false>(F.lds, (const bf16*)(ws + WS_MRG), D, (const bf16*)(ws + WS_WOUT), D, D, S, E, nullptr, Lc); } SEAM(6);
#else
    if (IN(4)) { EpiProjA E{(const bf16*)(ws + WS_Z2), (bf16*)(ws + WS_TMP)}; ngemm_wave((const bf16*)(ws + WS_AP), D, (const bf16*)(ws + WS_WAB), D, T / 32, D / 32, 512, F, E); } SEAM(4);
    if (IN(5)) { EpiProjB E{(const bf16*)(ws + WS_Z2), (const bf16*)(ws + WS_TMP), (bf16*)(ws + WS_MRG)}; ngemm_wave((const bf16*)(ws + WS_AP) + 512, D, (const bf16*)(ws + WS_WAB) + 512, D, T / 32, D / 32, 512, F, E); } SEAM(5);
    if (IN(6)) { EpiResid E{a.in[0], a.out}; ngemm_wave((const bf16*)(ws + WS_MRG), D, (const bf16*)(ws + WS_WOUT), D, T / 32, D / 32, D, F, E); } SEAM(6);
#endif
    if (IN(7)) { phase_router2(F, a); } SEAM(7);
#if FAST_MOE
    if (IN(8)) { moe_layout(F, a); FEpiMoeUp E{a.in[16], a.in[18], (bf16*)(ws + WS_ACT), (const float*)(ws + WS_SRS2)}; pg8::MoeOrder S{Lc, 0, NE, 8, F.G, (int)blockIdx.x, 2048};
        pg8::gemm_phase<FEpiMoeUp, pg8::MoeOrder, true>(F.lds, (const bf16*)(ws + WS_H2), D, (const bf16*)(ws + WS_WGU), D, D, S, E, (const int*)(ws + WS_LIST), Lc); } SEAM(8);
    if (IN(9)) { moe_layout(F, a); FEpiMoeDown E{a.in[20], (bf16*)(ws + WS_Y0)}; pg8::MoeOrder S{Lc, 0, Lc[LC_SPLIT], 4, F.G, (int)blockIdx.x, 1024};
        pg8::gemm_phase<FEpiMoeDown, pg8::MoeOrder, false>(F.lds, (const bf16*)(ws + WS_ACT), FF, (const bf16*)(ws + WS_WD), FF, FF, S, E, nullptr, Lc); } SEAM(9);
    if (IN(10)) { moe_layout(F, a); const int srow = Lc[LC_START + Lc[LC_SPLIT]]; FEpiMoeDown E{a.in[20], (bf16*)(ws + WS_Y1) - (size_t)srow * D}; pg8::MoeOrder S{Lc, Lc[LC_SPLIT], NE, 4, F.G, (int)blockIdx.x, 1024};
        pg8::gemm_phase<FEpiMoeDown, pg8::MoeOrder, false>(F.lds, (const bf16*)(ws + WS_ACT), FF, (const bf16*)(ws + WS_WD), FF, FF, S, E, nullptr, Lc); } SEAM(10);
#else
    if (IN(8)) { phase_moe_up_ref(F, a); } SEAM(8);
    if (IN(9)) { phase_moe_down_ref(F, a, 0); } SEAM(9);
    if (IN(10)) { phase_moe_down_ref(F, a, 1); } SEAM(10);
#endif
#if FAST_G11
    if (IN(11)) { phase_combine(F, a); __syncthreads(); FEpiBf16 E{(bf16*)(ws + WS_PP), D}; pg8::StaticOrder S; S.init(T, D, F.G, (int)blockIdx.x);
        pg8::gemm_phase<FEpiBf16, pg8::StaticOrder, false>(F.lds, (const bf16*)(ws + WS_PB), PLE, (const bf16*)(ws + WS_WPP), PLE, PLE, S, E, nullptr, Lc); } SEAM(11);
    if (IN(12)) { FEpiPle E{(const bf16*)(ws + WS_PP), a.out}; pg8::StaticOrder S; S.init(T, D, F.G, (int)blockIdx.x);
        pg8::gemm_phase<FEpiPle, pg8::StaticOrder, false>(F.lds, (const bf16*)(ws + WS_HP), D, (const bf16*)(ws + WS_WPG), D, D, S, E, nullptr, Lc); } SEAM(12);
#else
    if (IN(11)) { phase_combine(F, a); EpiStoreBf16 E{(bf16*)(ws + WS_PP), D}; ngemm_wave((const bf16*)(ws + WS_PB), PLE, (const bf16*)(ws + WS_WPP), PLE, T / 32, D / 32, PLE, F, E); } SEAM(11);
    if (IN(12)) { EpiPle E{(const bf16*)(ws + WS_PP), a.out}; ngemm_wave((const bf16*)(ws + WS_HP), D, (const bf16*)(ws + WS_WPG), D, T / 32, D / 32, D, F, E); } SEAM(12);
#endif
    if (IN(13)) { phase_final(F, a); }
#undef IN
#undef SEAM
}

extern "C" void kernel_launch(void* const* d_in, const int* in_sizes, int n_in, void* d_out, int out_size, void* d_ws, size_t ws_size, hipStream_t stream) {
    static int grid = 0;
    if (grid == 0) {
        if (n_in != 25 || in_sizes[0] != T * D || out_size != T * D || ws_size < WS_END) { fprintf(stderr, "kernel_launch: unexpected shapes (n_in %d, ws %zu)\n", n_in, ws_size); grid = -1; return; }
        int dev = 0, cus = 0;
        if (hipGetDevice(&dev) != hipSuccess || hipDeviceGetAttribute(&cus, hipDeviceAttributeMultiprocessorCount, dev) != hipSuccess) { grid = -1; return; }
        if (hipFuncSetAttribute((const void*)fwd, hipFuncAttributeMaxDynamicSharedMemorySize, LDS_BYTES) != hipSuccess) { grid = -1; return; }
        (void)hipGetLastError();
        grid = cus;
    }
    if (grid < 0) return;
    (void)hipMemsetAsync((char*)d_ws + WS_CTL, 0, CTL_ZERO_BYTES, stream);
    Args a{};
    for (int i = 0; i < 25; ++i) a.in[i] = (const float*)d_in[i];
    a.out = (float*)d_out; a.ws = (unsigned char*)d_ws;
#if MK_ONE_LAUNCH
    a.ph_lo = 0; a.ph_hi = NPHASES;
    hipLaunchKernelGGL(fwd, dim3(grid), dim3(NTHREADS), LDS_BYTES, stream, a);
#else
    for (int p = 0; p < NPHASES; ++p) { a.ph_lo = p; a.ph_hi = p + 1; hipLaunchKernelGGL(fwd, dim3(grid), dim3(NTHREADS), LDS_BYTES, stream, a); }
#endif
}
```

```cpp
#include <hip/hip_runtime.h>
#include <cstdint>
#include <cstdio>

#define DEV __device__ __forceinline__
#define LAS __attribute__((address_space(3)))
typedef unsigned short bf16;
typedef short bf16x8 __attribute__((ext_vector_type(8)));
typedef float f32x4 __attribute__((ext_vector_type(4)));
typedef float f32x16 __attribute__((ext_vector_type(16)));
typedef unsigned u32x4 __attribute__((ext_vector_type(4)));
typedef unsigned u32x2 __attribute__((ext_vector_type(2)));

#ifndef FAST_GEMM
#define FAST_GEMM 1
#endif
#ifndef FAST_G1
#define FAST_G1 FAST_GEMM
#endif
#ifndef FAST_G4
#define FAST_G4 FAST_GEMM
#endif
#ifndef FAST_G11
#define FAST_G11 FAST_GEMM
#endif
#ifndef FAST_MIX
#define FAST_MIX 1
#endif
#ifndef FP8_MOE
#define FP8_MOE 1
#endif
#ifndef FAST_MOE
#define FAST_MOE 1
#endif
#ifndef MK_ONE_LAUNCH
#define MK_ONE_LAUNCH 1
#endif

constexpr int NB = 16, SEQ = 2048, T = NB * SEQ, D = 1024;
constexpr int NZ = 3840, Z1W = 1792, Z2W = 2048;
constexpr int NE = 32, FF = 1024, PLE = 256;
constexpr float LOG2E = 1.4426950408889634f;
constexpr float QSCALE = 0.125f * LOG2E;
constexpr float RMS_EPS = 1e-6f, LN_EPS = 1e-5f;
constexpr int NWAVES = 8, NTHREADS = 512;
constexpr int LDS_BYTES = 147456;
constexpr int LDS_CTL = 146432;
constexpr int LC_CNT = 0, LC_START = 32, LC_SPLIT = 65, LC_TOTAL = 66, LC_BAR = 100;

constexpr size_t MiB = 1u << 20;
constexpr size_t WS_CTL = 0, CTL_ZERO_BYTES = 1 * MiB;
constexpr size_t WS_STATS = 1 * MiB;
constexpr size_t WS_WIN = 2 * MiB, WS_WAB = 10 * MiB, WS_WOUT = 12 * MiB, WS_WPG = 14 * MiB, WS_WPP = 16 * MiB, WS_WSP = 16 * MiB + 512 * 1024;
constexpr size_t WS_LIST = 18 * MiB, WS_INFO = 22 * MiB;
constexpr size_t WS_WD = 24 * MiB, WS_WGU = 88 * MiB;
constexpr size_t WS_H2 = 216 * MiB, WS_AP = 216 * MiB;
constexpr size_t WS_ACT = 280 * MiB, WS_Z2 = 280 * MiB, WS_Z1 = 408 * MiB, WS_TMP = 408 * MiB, WS_MRG = 472 * MiB;
constexpr size_t WS_Y0 = 88 * MiB, WS_Y1 = 280 * MiB, WS_PP = 24 * MiB, WS_HP = 416 * MiB, WS_PB = 552 * MiB, WS_END = 572 * MiB;
constexpr size_t WS_RSTD = 1 * MiB + 512 * 1024;
constexpr size_t WS_WRH = 17 * MiB, WS_WRL = 17 * MiB + 64 * 1024;
constexpr size_t WS_SRS2 = 568 * MiB;
constexpr size_t WS_WD8 = 24 * MiB, WS_WGU8 = 56 * MiB, WS_H2Q = 120 * MiB, WS_ACT8 = 152 * MiB, WS_Y = 288 * MiB, WS_SRS8 = 560 * MiB;
constexpr size_t WS_PB8 = 120 * MiB, WS_HP8 = 56 * MiB, WS_PP8 = 152 * MiB;
constexpr float W8_SCALE = 64.0f, W8_INV = 1.0f / 64.0f;
constexpr int Y0_CAP_ROWS = 98304;
constexpr int CW_TMO = 0, CW_GCOUNT = 64, CW_BAR = 4096;

struct Args { const float* in[25]; float* out; unsigned char* ws; int ph_lo, ph_hi; };

DEV unsigned f2bf(float f) { unsigned u = __builtin_bit_cast(unsigned, f); return (u + 0x7fffu + ((u >> 16) & 1u)) >> 16; }
DEV unsigned pk2(float lo, float hi) { return f2bf(lo) | (f2bf(hi) << 16); }
DEV unsigned pk4_fp8(float a, float b, float c, float d) { int w = __builtin_amdgcn_cvt_pk_fp8_f32(a, b, 0, false); w = __builtin_amdgcn_cvt_pk_fp8_f32(c, d, w, true); return (unsigned)w; }
DEV float bf2f(unsigned b) { return __builtin_bit_cast(float, b << 16); }
DEV float bflo(unsigned w) { return __builtin_bit_cast(float, w << 16); }
DEV float bfhi(unsigned w) { return __builtin_bit_cast(float, w & 0xffff0000u); }
DEV float fexp2(float x) { return __builtin_amdgcn_exp2f(x); }
DEV float frcp(float x) { return __builtin_amdgcn_rcpf(x); }
DEV float sigmoidf_(float x) { return frcp(1.0f + fexp2(-x * LOG2E)); }
DEV float gelu_tanh(float x) { const float u = 1.5957691216057308f * (x + 0.044715f * x * x * x); return x * frcp(1.0f + fexp2(-u * LOG2E)); }
DEV float swiglu(float a, float b) { a = fminf(a, 7.0f); b = fminf(fmaxf(b, -7.0f), 7.0f); return (b + 1.0f) * (a * sigmoidf_(1.702f * a)); }
DEV float wave_sum(float v) {
#pragma unroll
    for (int o = 1; o < 64; o <<= 1) v += __shfl_xor(v, o);
    return v;
}
DEV float wave_max(float v) {
#pragma unroll
    for (int o = 1; o < 64; o <<= 1) v = fmaxf(v, __shfl_xor(v, o));
    return v;
}
DEV int crow(int reg, int h) { return (reg & 3) + 8 * (reg >> 2) + 4 * h; }

struct Frame { LAS unsigned char* lds; int tid, lane, wave, vcu, G, gw, NGW; };

#define XB_TMO      128
#define XB_XCNT(j)  (256  + 64 * (j))
#define XB_XSUB(j)  (1280 + 64 * (j))
#define XB_XGEN(j)  (2304 + 64 * (j))
#define XB_TOP      3328
#define XB_TOPGEN   3392
#define XCD_BAR_WORDS 3456
#define XB_SPIN_CAP (1u << 18)
DEV unsigned xb_ld(unsigned* p)              { return __hip_atomic_load(p, __ATOMIC_RELAXED, __HIP_MEMORY_SCOPE_AGENT); }
DEV unsigned xb_add(unsigned* p, unsigned v) { return __hip_atomic_fetch_add(p, v, __ATOMIC_RELAXED, __HIP_MEMORY_SCOPE_AGENT); }
DEV unsigned xb_xcc_id() { return (unsigned)__builtin_amdgcn_s_getreg((3 << 11) | 20) & 0xFu; }
#define XB_SPIN(cond, bar) do { unsigned _sp = 0; while (cond) { __builtin_amdgcn_s_sleep(1); \
    if ((++_sp & 255u) == 0u) { if (xb_ld(&(bar)[XB_TMO])) break; if (_sp > XB_SPIN_CAP) { atomicAdd(&(bar)[XB_TMO], 1u); break; } } } } while (0)
struct XcdBarrier { unsigned* bar; unsigned x; volatile LAS unsigned* st; };
DEV XcdBarrier xcd_barrier_post(unsigned* bar, volatile LAS unsigned* st) {
    XcdBarrier b; b.bar = bar; b.x = xb_xcc_id(); b.st = st;
    if (threadIdx.x == 0) (void)xb_add(&bar[XB_XCNT(b.x)], 1u);
    return b;
}
DEV void xcd_barrier_complete(unsigned* bar, unsigned x, unsigned& nloc, unsigned& nx) {
    const unsigned G = gridDim.x * gridDim.y * gridDim.z;
    unsigned sum, cnt, mine, sp = 0u;
    for (;;) {
        sum = 0u; cnt = 0u; mine = 0u;
#pragma unroll
        for (unsigned j = 0; j < 16; ++j) { const unsigned c = xb_ld(&bar[XB_XCNT(j)]); sum += c; cnt += (c > 0u) ? 1u : 0u; mine = (j == x) ? c : mine; }
        if (sum == G) break;
        __builtin_amdgcn_s_sleep(1);
        if ((++sp & 255u) == 0u) { if (xb_ld(&bar[XB_TMO])) break; if (sp > XB_SPIN_CAP) { atomicAdd(&bar[XB_TMO], 1u); break; } }
    }
    nloc = mine > 0u ? mine : 1u; nx = cnt > 0u ? cnt : 1u;
}
DEV void xcd_barrier(const XcdBarrier& b) {
    asm volatile("s_waitcnt vmcnt(0)" ::: "memory");
    __syncthreads();
    if (threadIdx.x == 0) {
        unsigned* bar = b.bar;
        __builtin_amdgcn_s_waitcnt(0);
        unsigned nloc = b.st[0], nx = b.st[1];
        if (nloc == 0u) { xcd_barrier_complete(bar, b.x, nloc, nx); b.st[0] = nloc; b.st[1] = nx; }
        const unsigned old = xb_add(&bar[XB_XSUB(b.x)], 1u);
        const unsigned gen = old / nloc;
        if (old + 1u == (gen + 1u) * nloc) {
            __builtin_amdgcn_fence(__ATOMIC_RELEASE, "agent");
            asm volatile("s_waitcnt vmcnt(0)" ::: "memory");
            const unsigned og = xb_add(&bar[XB_TOP], 1u);
            const unsigned tg = og / nx;
            if (og + 1u == (tg + 1u) * nx) xb_add(&bar[XB_TOPGEN], 1u);
            else XB_SPIN(xb_ld(&bar[XB_TOPGEN]) == tg, bar);
            __builtin_amdgcn_fence(__ATOMIC_ACQUIRE, "agent");
            xb_add(&bar[XB_XGEN(b.x)], 1u);
            asm volatile("s_waitcnt vmcnt(0)" ::: "memory");
        } else {
            XB_SPIN(xb_ld(&bar[XB_XGEN(b.x)]) == gen, bar);
            __builtin_amdgcn_fence(__ATOMIC_ACQUIRE, "agent");
            asm volatile("s_waitcnt vmcnt(0)" ::: "memory");
        }
    }
    __syncthreads();
}

template <class Epi>
DEV void ngemm_wave(const bf16* A, int lda, const bf16* Bt, int ldb, int mtiles, int ntiles, int K, const Frame& F, const Epi& epi) {
    const int r = F.lane & 31, h = F.lane >> 5;
    const int total = mtiles * ntiles;
    for (int t = F.gw; t < total; t += F.NGW) {
        const int tm = t / ntiles, tn = t % ntiles;
        const bf16* ap = A + (size_t)(tm * 32 + r) * lda + 8 * h;
        const bf16* bp = Bt + (size_t)(tn * 32 + r) * ldb + 8 * h;
        f32x16 acc;
#pragma unroll
        for (int i = 0; i < 16; ++i) acc[i] = 0.f;
#pragma unroll 8
        for (int k0 = 0; k0 < K; k0 += 16) {
            const bf16x8 a = *(const bf16x8*)(ap + k0), b = *(const bf16x8*)(bp + k0);
            acc = __builtin_amdgcn_mfma_f32_32x32x16_bf16(a, b, acc, 0, 0, 0);
        }
#pragma unroll
        for (int i = 0; i < 16; ++i) epi(tm * 32 + crow(i, h), tn * 32 + r, acc[i]);
    }
}

DEV int maprow(int mode, int n0) { return mode == 0 ? n0 : (256 * (n0 >> 7) + (n0 & 127) + (mode == 2 ? 128 : 0)); }
DEV void transpose_item(const float* W, int K, int N, bf16* WT, int ldt, int koff, int mode, LAS float* scr, int item, int lane) {
    const int nblk = N / 32, kb = item / nblk, nb = item % nblk, k0 = 64 * kb, n0 = 32 * nb;
#pragma unroll 8
    for (int i = 0; i < 32; ++i) { const int kk = 2 * i + (lane >> 5); scr[kk * 33 + (lane & 31)] = W[(size_t)(k0 + kk) * N + n0 + (lane & 31)]; }
    asm volatile("s_waitcnt lgkmcnt(0)" ::: "memory");
    const int c = lane & 7; const int rbase = maprow(mode, n0);
#pragma unroll
    for (int j = 0; j < 4; ++j) { const int n = (lane >> 3) + 8 * j; const LAS float* s = scr + (8 * c) * 33 + n;
        u32x4 o; o.x = pk2(s[0 * 33], s[1 * 33]); o.y = pk2(s[2 * 33], s[3 * 33]); o.z = pk2(s[4 * 33], s[5 * 33]); o.w = pk2(s[6 * 33], s[7 * 33]);
        *(u32x4*)(WT + (size_t)(rbase + n) * ldt + koff + k0 + 8 * c) = o; }
    asm volatile("s_waitcnt lgkmcnt(0)" ::: "memory");
}
DEV void rms_row_to_bf16(const float* xrow, const float* g, bf16* orow, int lane) {
    const f32x4* xr = (const f32x4*)xrow + lane; const f32x4* gr = (const f32x4*)g + lane;
    f32x4 v[4]; float s = 0.f;
#pragma unroll
    for (int j = 0; j < 4; ++j) { v[j] = xr[64 * j]; s += (v[j].x * v[j].x + v[j].y * v[j].y) + (v[j].z * v[j].z + v[j].w * v[j].w); }
    const float rstd = 1.0f / sqrtf(wave_sum(s) * (1.f / D) + RMS_EPS);
    unsigned long long* o8 = (unsigned long long*)orow + lane;
#pragma unroll
    for (int j = 0; j < 4; ++j) { const f32x4 gg = gr[64 * j];
        o8[64 * j] = (unsigned long long)pk2(v[j].x * rstd * gg.x, v[j].y * rstd * gg.y) | ((unsigned long long)pk2(v[j].z * rstd * gg.z, v[j].w * rstd * gg.w) << 32); }
}
DEV void transpose_item_fp8(const float* W, int K, int N, unsigned char* WT, int ldt, int mode, LAS float* scr, int item, int lane) {
    const int nblk = N / 32, kb = item / nblk, nb = item % nblk, k0 = 64 * kb, n0 = 32 * nb;
#pragma unroll 8
    for (int i = 0; i < 32; ++i) { const int kk = 2 * i + (lane >> 5); scr[kk * 33 + (lane & 31)] = W[(size_t)(k0 + kk) * N + n0 + (lane & 31)]; }
    asm volatile("s_waitcnt lgkmcnt(0)" ::: "memory");
    const int c = lane & 7; const int rbase = maprow(mode, n0);
#pragma unroll
    for (int j = 0; j < 4; ++j) { const int n = (lane >> 3) + 8 * j; const LAS float* sp = scr + (8 * c) * 33 + n;
        u32x2 o; o.x = pk4_fp8(sp[0 * 33] * W8_SCALE, sp[1 * 33] * W8_SCALE, sp[2 * 33] * W8_SCALE, sp[3 * 33] * W8_SCALE); o.y = pk4_fp8(sp[4 * 33] * W8_SCALE, sp[5 * 33] * W8_SCALE, sp[6 * 33] * W8_SCALE, sp[7 * 33] * W8_SCALE);
        *(u32x2*)(WT + (size_t)(rbase + n) * ldt + k0 + 8 * c) = o; }
    asm volatile("s_waitcnt lgkmcnt(0)" ::: "memory");
}
DEV void phase_prologue(Frame& F, const Args& a) {
    unsigned char* ws = a.ws;
    LAS float* scr = (LAS float*)(F.lds + F.wave * 8448);
    bf16* Win_t = (bf16*)(ws + WS_WIN); bf16* Wab_t = (bf16*)(ws + WS_WAB); bf16* Wout_t = (bf16*)(ws + WS_WOUT); bf16* Wpg_t = (bf16*)(ws + WS_WPG);
    bf16* Wpp_t = (bf16*)(ws + WS_WPP); bf16* Wsp = (bf16*)(ws + WS_WSP); bf16* Wd_t = (bf16*)(ws + WS_WD); bf16* Wgu_t = (bf16*)(ws + WS_WGU);
    constexpr int I0 = 16 * 120, I1 = 8 * 32, I2 = 8 * 32, I3 = 16 * 32, I4 = 16 * 32, I5 = 4 * 32, IE = 512, NITEMS = I0 + I1 + I2 + I3 + I4 + I5 + NE * 3 * IE;
    for (int it = F.gw; it < NITEMS; it += F.NGW) {
        int r = it;
        if (r < I0) { transpose_item(a.in[3], D, NZ, Win_t, D, 0, 0, scr, r, F.lane); continue; } r -= I0;
        if (r < I1) { transpose_item(a.in[9], 512, D, Wab_t, D, 0, 0, scr, r, F.lane); continue; } r -= I1;
        if (r < I2) { transpose_item(a.in[10], 512, D, Wab_t, D, 512, 0, scr, r, F.lane); continue; } r -= I2;
        if (r < I3) { transpose_item(a.in[11], D, D, Wout_t, D, 0, 0, scr, r, F.lane); continue; } r -= I3;
        if (r < I4) { transpose_item(a.in[22], D, D, Wpg_t, D, 0, 0, scr, r, F.lane); continue; } r -= I4;
        if (r < I5) { transpose_item(a.in[23], PLE, D, Wpp_t, PLE, 0, 0, scr, r, F.lane); continue; } r -= I5;
        const int e = r / (3 * IE), q = r % (3 * IE), kind = q / IE, item = q % IE;
#if FP8_MOE
        unsigned char* Wgu8 = ws + WS_WGU8; unsigned char* Wd8 = ws + WS_WD8;
        if (kind == 0) transpose_item_fp8(a.in[15] + (size_t)e * D * FF, D, FF, Wgu8 + (size_t)e * 2048 * D, D, 1, scr, item, F.lane);
        else if (kind == 1) transpose_item_fp8(a.in[17] + (size_t)e * D * FF, D, FF, Wgu8 + (size_t)e * 2048 * D, D, 2, scr, item, F.lane);
        else transpose_item_fp8(a.in[19] + (size_t)e * FF * D, FF, D, Wd8 + (size_t)e * D * FF, FF, 0, scr, item, F.lane);
#else
        if (kind == 0) transpose_item(a.in[15] + (size_t)e * D * FF, D, FF, Wgu_t + (size_t)e * 2048 * D, D, 0, 1, scr, item, F.lane);
        else if (kind == 1) transpose_item(a.in[17] + (size_t)e * D * FF, D, FF, Wgu_t + (size_t)e * 2048 * D, D, 0, 2, scr, item, F.lane);
        else transpose_item(a.in[19] + (size_t)e * FF * D, FF, D, Wd_t + (size_t)e * D * FF, FF, 0, 0, scr, item, F.lane);
#endif
    }
    { bf16* wh = (bf16*)(ws + WS_WRH); bf16* wl = (bf16*)(ws + WS_WRL);
      for (int i = F.vcu * NTHREADS + F.tid; i < D * NE; i += F.G * NTHREADS) { const int d = i >> 5, e = i & 31; const float w = a.in[13][i]; const unsigned hb = f2bf(w);
          wh[e * D + d] = (bf16)hb; wl[e * D + d] = (bf16)f2bf(w - bf2f(hb)); } }
    for (int i = F.vcu * NTHREADS + F.tid; i < 4 * 128 * 128; i += F.G * NTHREADS) { const int s = i & 127, t = (i >> 7) & 127; Wsp[i] = (bf16)f2bf(s <= t ? a.in[7][i] : 0.f); }
    bf16* Hb = (bf16*)a.out; bf16* PB = (bf16*)(ws + WS_PB);
    for (int m = F.gw; m < T; m += F.NGW) {
        rms_row_to_bf16(a.in[0] + (size_t)m * D, a.in[2], Hb + (size_t)m * D, F.lane);
#if !FP8_MOE
        const f32x4 pv = *((const f32x4*)(a.in[1] + (size_t)m * PLE) + F.lane);
        *((u32x2*)(PB + (size_t)m * PLE) + F.lane) = (u32x2){pk2(pv.x, pv.y), pk2(pv.z, pv.w)};
#endif
    }
}

struct EpiZ { bf16* Z1; bf16* Z2;
    DEV void operator()(int row, int col, float v) const {
        if (col < 512) Z1[(size_t)row * Z1W + col] = (bf16)f2bf(v * QSCALE);
        else if (col < 768) Z1[(size_t)row * Z1W + col] = (bf16)f2bf(v);
        else if (col < Z1W) Z1[(size_t)row * Z1W + col] = (bf16)f2bf(gelu_tanh(v));
        else Z2[(size_t)row * Z2W + (col - Z1W)] = (bf16)f2bf(sigmoidf_(v));
    } };

DEV void phase_lnstats(Frame& F, const Args& a) {
    const bf16* Z1 = (const bf16*)(a.ws + WS_Z1); float2* st = (float2*)(a.ws + WS_STATS);
    for (int m = F.gw; m < T; m += F.NGW) {
        const u32x4 w = *((const u32x4*)(Z1 + (size_t)m * Z1W + 1280) + F.lane);
        float v[8] = {bflo(w.x), bfhi(w.x), bflo(w.y), bfhi(w.y), bflo(w.z), bfhi(w.z), bflo(w.w), bfhi(w.w)};
        float s = 0.f;
#pragma unroll
        for (int j = 0; j < 8; ++j) s += v[j];
        const float mean = wave_sum(s) * (1.f / 512.f); float q = 0.f;
#pragma unroll
        for (int j = 0; j < 8; ++j) { const float d = v[j] - mean; q += d * d; }
        const float rstd = 1.0f / sqrtf(wave_sum(q) * (1.f / 512.f) + LN_EPS);
        if (F.lane == 0) st[m] = make_float2(mean, rstd);
    }
}

DEV void phase_mixers_ref(Frame& F, const Args& a) {
    const bf16* Z1 = (const bf16*)(a.ws + WS_Z1); bf16* AP = (bf16*)(a.ws + WS_AP);
    const float* sinks = a.in[4];
    const int gid = F.vcu * NTHREADS + F.tid, nthr = F.G * NTHREADS;
    for (int item = gid; item < T * 8; item += nthr) {
        const int hh = item / T, m = item % T, b = m / SEQ, t = m % SEQ, kvh = hh >> 2;
        const float slope2 = fexp2(-(float)(hh + 1)) * LOG2E, sink2 = sinks[hh] * LOG2E;
        float q[64], o[64];
        const u32x4* qp = (const u32x4*)(Z1 + (size_t)m * Z1W + hh * 64);
#pragma unroll
        for (int c = 0; c < 8; ++c) { const u32x4 w = qp[c]; q[8 * c] = bflo(w.x); q[8 * c + 1] = bfhi(w.x); q[8 * c + 2] = bflo(w.y); q[8 * c + 3] = bfhi(w.y); q[8 * c + 4] = bflo(w.z); q[8 * c + 5] = bfhi(w.z); q[8 * c + 6] = bflo(w.w); q[8 * c + 7] = bfhi(w.w); }
#pragma unroll
        for (int d = 0; d < 64; ++d) o[d] = 0.f;
        float mrun = sink2, l = 1.0f;
        const int s0 = t - 127 < 0 ? 0 : t - 127;
        for (int s = s0; s <= t; ++s) {
            const bf16* krow = Z1 + (size_t)(b * SEQ + s) * Z1W + 512 + kvh * 64; const bf16* vrow = krow + 128;
            float dot = 0.f;
#pragma unroll
            for (int c = 0; c < 8; ++c) { const u32x4 w = ((const u32x4*)krow)[c];
                dot += q[8 * c] * bflo(w.x) + q[8 * c + 1] * bfhi(w.x) + q[8 * c + 2] * bflo(w.y) + q[8 * c + 3] * bfhi(w.y) + q[8 * c + 4] * bflo(w.z) + q[8 * c + 5] * bfhi(w.z) + q[8 * c + 6] * bflo(w.w) + q[8 * c + 7] * bfhi(w.w); }
            const float sc = dot - slope2 * (float)(t - s);
            const float mnew = fmaxf(mrun, sc), alpha = fexp2(mrun - mnew), p = fexp2(sc - mnew);
            l = l * alpha + p; mrun = mnew;
#pragma unroll
            for (int c = 0; c < 8; ++c) { const u32x4 w = ((const u32x4*)vrow)[c];
                o[8 * c] = o[8 * c] * alpha + p * bflo(w.x); o[8 * c + 1] = o[8 * c + 1] * alpha + p * bfhi(w.x); o[8 * c + 2] = o[8 * c + 2] * alpha + p * bflo(w.y); o[8 * c + 3] = o[8 * c + 3] * alpha + p * bfhi(w.y);
                o[8 * c + 4] = o[8 * c + 4] * alpha + p * bflo(w.z); o[8 * c + 5] = o[8 * c + 5] * alpha + p * bfhi(w.z); o[8 * c + 6] = o[8 * c + 6] * alpha + p * bflo(w.w); o[8 * c + 7] = o[8 * c + 7] * alpha + p * bfhi(w.w); }
        }
        const float il = 1.0f / l;
        u32x4* op = (u32x4*)(AP + (size_t)m * D + hh * 64);
#pragma unroll
        for (int c = 0; c < 8; ++c) op[c] = (u32x4){pk2(o[8 * c] * il, o[8 * c + 1] * il), pk2(o[8 * c + 2] * il, o[8 * c + 3] * il), pk2(o[8 * c + 4] * il, o[8 * c + 5] * il), pk2(o[8 * c + 6] * il, o[8 * c + 7] * il)};
    }
    const bf16* Wsp = (const bf16*)(a.ws + WS_WSP); const float2* st = (const float2*)(a.ws + WS_STATS);
    const float* g_ln = a.in[5]; const float* b_ln = a.in[6]; const float* b_sp = a.in[8];
    for (int item = gid; item < T * 512; item += nthr) {
        const int m = item >> 9, c = item & 511, g = c >> 7, t = m & 127, m0 = m - t;
        const float gl = g_ln[c], bl = b_ln[c];
        const bf16* wrow = Wsp + ((size_t)g * 128 + t) * 128;
        float acc = 0.f;
        for (int s = 0; s <= t; ++s) {
            const float2 ms = st[m0 + s];
            const float vn = (bf2f(Z1[(size_t)(m0 + s) * Z1W + 1280 + c]) - ms.x) * ms.y * gl + bl;
            acc += bf2f(wrow[s]) * vn;
        }
        const float u = bf2f(Z1[(size_t)m * Z1W + 768 + c]);
        AP[(size_t)m * D + 512 + c] = (bf16)f2bf(u * (acc + b_sp[g * 128 + t]));
    }
}

struct EpiProjA { const bf16* Z2; bf16* TMP;
    DEV void operator()(int row, int col, float v) const { TMP[(size_t)row * D + col] = (bf16)f2bf(bf2f(Z2[(size_t)row * Z2W + col]) * v); } };
struct EpiProjB { const bf16* Z2; const bf16* TMP; bf16* MRG;
    DEV void operator()(int row, int col, float v) const { MRG[(size_t)row * D + col] = (bf16)f2bf(bf2f(TMP[(size_t)row * D + col]) + bf2f(Z2[(size_t)row * Z2W + 1024 + col]) * v); } };
struct EpiResid { const float* base; float* out;
    DEV void operator()(int row, int col, float v) const { out[(size_t)row * D + col] = base[(size_t)row * D + col] + v; } };

DEV void phase_router(Frame& F, const Args& a) {
    const float* x1 = a.out; const float* g_ffn = a.in[12]; const float* w_router = a.in[13]; const float* b_router = a.in[14];
    bf16* H2 = (bf16*)(a.ws + WS_H2); unsigned* gcount = (unsigned*)(a.ws + WS_CTL) + CW_GCOUNT; int* list = (int*)(a.ws + WS_LIST); u32x2* info = (u32x2*)(a.ws + WS_INFO);
    LAS float* wt = (LAS float*)F.lds;
    LAS unsigned* lcount = (LAS unsigned*)(F.lds + 131584);
    LAS unsigned* gbase = lcount + 32;
    LAS unsigned* rec = gbase + 32;
    const int lane = F.lane;
    for (int i = F.tid; i < D * NE; i += NTHREADS) { const int d = i >> 5, e = i & 31; wt[e * 1028 + d] = w_router[i]; }
    f32x4 gg[4];
#pragma unroll
    for (int j = 0; j < 4; ++j) gg[j] = *((const f32x4*)g_ffn + lane + 64 * j);
    const int my_e = lane >> 1; const float my_bias = b_router[my_e];
    for (int blk = F.vcu; blk < T / 128; blk += F.G) {
        if (F.tid < 32) lcount[F.tid] = 0u;
        __syncthreads();
        for (int rr = 0; rr < 16; ++rr) {
            const int rl = F.wave * 16 + rr, m = blk * 128 + rl;
            const f32x4* xr = (const f32x4*)(x1 + (size_t)m * D) + lane;
            f32x4 v[4]; float s = 0.f;
#pragma unroll
            for (int j = 0; j < 4; ++j) { v[j] = xr[64 * j]; s += (v[j].x * v[j].x + v[j].y * v[j].y) + (v[j].z * v[j].z + v[j].w * v[j].w); }
            const float rstd = 1.0f / sqrtf(wave_sum(s) * (1.f / D) + RMS_EPS);
#pragma unroll
            for (int j = 0; j < 4; ++j) v[j] = v[j] * rstd * gg[j];
            unsigned long long* o8 = (unsigned long long*)(H2 + (size_t)m * D) + lane;
#pragma unroll
            for (int j = 0; j < 4; ++j) o8[64 * j] = (unsigned long long)pk2(v[j].x, v[j].y) | ((unsigned long long)pk2(v[j].z, v[j].w) << 32);
            float part[32];
#pragma unroll
            for (int e = 0; e < 32; ++e) { float acc = 0.f;
#pragma unroll
                for (int j = 0; j < 4; ++j) { const f32x4 w = *(const LAS f32x4*)(wt + e * 1028 + 4 * lane + 256 * j); acc += (v[j].x * w.x + v[j].y * w.y) + (v[j].z * w.z + v[j].w * w.w); }
                part[e] = acc; }
#define TR_STEP(N, BIT, XM) { const bool hb = (lane >> BIT) & 1; _Pragma("unroll") for (int i = 0; i < N; ++i) { const float keep = hb ? part[i + N] : part[i]; const float send = hb ? part[i] : part[i + N]; part[i] = keep + __shfl_xor(send, XM); } }
            TR_STEP(16, 5, 32) TR_STEP(8, 4, 16) TR_STEP(4, 3, 8) TR_STEP(2, 2, 4) TR_STEP(1, 1, 2)
#undef TR_STEP
            float val = part[0] + __shfl_xor(part[0], 1) + my_bias;
            float topv[4]; int tope[4];
#pragma unroll
            for (int k = 0; k < 4; ++k) { const float mx = wave_max(val); const unsigned long long bal = __ballot(val == mx); const int src = __ffsll((long long)bal) - 1; const int ek = src >> 1;
                topv[k] = mx; tope[k] = ek; if (my_e == ek) val = -INFINITY; }
            const float e1 = __expf(topv[1] - topv[0]), e2 = __expf(topv[2] - topv[0]), e3 = __expf(topv[3] - topv[0]);
            const float inv = 1.0f / (1.0f + e1 + e2 + e3);
            if (lane < 4) {
                const int ek = lane == 0 ? tope[0] : lane == 1 ? tope[1] : lane == 2 ? tope[2] : tope[3];
                const float gk = (lane == 0 ? 1.0f : lane == 1 ? e1 : lane == 2 ? e2 : e3) * inv;
                const unsigned pos = atomicAdd((unsigned*)(lcount + ek), 1u);
                rec[(rl * 4 + lane) * 2] = (unsigned)ek | (pos << 8); rec[(rl * 4 + lane) * 2 + 1] = __builtin_bit_cast(unsigned, gk);
            }
        }
        __syncthreads();
        if (F.tid < 32) gbase[F.tid] = atomicAdd(gcount + F.tid, lcount[F.tid]);
        __syncthreads();
        { const int rl = F.tid >> 2, k = F.tid & 3, m = blk * 128 + rl; const unsigned w0 = rec[F.tid * 2], w1 = rec[F.tid * 2 + 1];
          const unsigned ek = w0 & 255u, gpos = gbase[ek] + (w0 >> 8);
          list[(size_t)ek * T + gpos] = m; info[(size_t)m * 4 + k] = (u32x2){ek | (gpos << 5), w1}; }
        __syncthreads();
    }
}


DEV void phase_router2(Frame& F, const Args& a) {
    const float* x1 = a.out; const float* g_ffn = a.in[12]; const float* b_router = a.in[14];
    bf16* H2 = (bf16*)(a.ws + WS_H2); unsigned* gcount = (unsigned*)(a.ws + WS_CTL) + CW_GCOUNT; int* list = (int*)(a.ws + WS_LIST); u32x2* info = (u32x2*)(a.ws + WS_INFO);
    float* rstd_g = (float*)(a.ws + WS_RSTD); float* srs = (float*)(a.ws + (FP8_MOE ? WS_SRS8 : WS_SRS2));
    LAS unsigned char* WRh = F.lds;
    LAS unsigned char* WRl = F.lds + 66048;
    LAS float* lg = (LAS float*)F.lds;
    LAS float* rs = (LAS float*)(F.lds + 132096);
    LAS unsigned* lcount = (LAS unsigned*)(F.lds + 132096 + 512);
    LAS unsigned* gbase = lcount + 32;
    LAS unsigned* rec = gbase + 32;
    const int lane = F.lane, wave = F.wave, fr = lane & 15, kq = lane >> 4;
    for (int blk = F.vcu; blk < T / 128; blk += F.G) {
        __syncthreads();
        { const bf16* wh = (const bf16*)(a.ws + WS_WRH); const bf16* wl = (const bf16*)(a.ws + WS_WRL);
          for (int i = F.tid; i < 32 * 128; i += NTHREADS) { const int e = i >> 7, c = i & 127;
              *(LAS u32x4*)(WRh + e * 2064 + c * 16) = *(const u32x4*)(wh + e * 1024 + c * 8); *(LAS u32x4*)(WRl + e * 2064 + c * 16) = *(const u32x4*)(wl + e * 1024 + c * 8); } }
        if (F.tid < 32) lcount[F.tid] = 0u;
        __syncthreads();
        const int row = blk * 128 + wave * 16 + fr;
        const float* xp = x1 + (size_t)row * D + 8 * kq; const float* gp = g_ffn + 8 * kq; bf16* hp = H2 + (size_t)row * D + 8 * kq; unsigned char* h8 = a.ws + WS_H2Q + (size_t)row * D + 8 * kq; (void)hp; (void)h8;
        f32x4 acc0 = (f32x4){0.f, 0.f, 0.f, 0.f}, acc1 = acc0; float ss = 0.f;
#pragma unroll 4
        for (int k0 = 0; k0 < D; k0 += 32) {
            const f32x4 xa = *(const f32x4*)(xp + k0), xb = *(const f32x4*)(xp + k0 + 4), ga = *(const f32x4*)(gp + k0), gb = *(const f32x4*)(gp + k0 + 4);
            ss += (xa.x * xa.x + xa.y * xa.y) + (xa.z * xa.z + xa.w * xa.w) + (xb.x * xb.x + xb.y * xb.y) + (xb.z * xb.z + xb.w * xb.w);
            const f32x4 pa = xa * ga, pb = xb * gb;
            u32x4 hw; hw.x = pk2(pa.x, pa.y); hw.y = pk2(pa.z, pa.w); hw.z = pk2(pb.x, pb.y); hw.w = pk2(pb.z, pb.w);
#if FP8_MOE
            *(u32x2*)(h8 + k0) = (u32x2){pk4_fp8(pa.x, pa.y, pa.z, pa.w), pk4_fp8(pb.x, pb.y, pb.z, pb.w)};
#else
            *(u32x4*)(hp + k0) = hw;
#endif
            u32x4 lw; lw.x = pk2(pa.x - bflo(hw.x), pa.y - bfhi(hw.x)); lw.y = pk2(pa.z - bflo(hw.y), pa.w - bfhi(hw.y)); lw.z = pk2(pb.x - bflo(hw.z), pb.y - bfhi(hw.z)); lw.w = pk2(pb.z - bflo(hw.w), pb.w - bfhi(hw.w));
            const bf16x8 ah = __builtin_bit_cast(bf16x8, hw), al = __builtin_bit_cast(bf16x8, lw);
            const LAS unsigned char* bh = WRh + fr * 2064 + (k0 + 8 * kq) * 2; const LAS unsigned char* bl = WRl + fr * 2064 + (k0 + 8 * kq) * 2;
            const bf16x8 bh0 = *(const LAS bf16x8*)bh, bh1 = *(const LAS bf16x8*)(bh + 16 * 2064), bl0 = *(const LAS bf16x8*)bl, bl1 = *(const LAS bf16x8*)(bl + 16 * 2064);
            acc0 = __builtin_amdgcn_mfma_f32_16x16x32_bf16(ah, bh0, acc0, 0, 0, 0); acc1 = __builtin_amdgcn_mfma_f32_16x16x32_bf16(ah, bh1, acc1, 0, 0, 0);
            acc0 = __builtin_amdgcn_mfma_f32_16x16x32_bf16(ah, bl0, acc0, 0, 0, 0); acc1 = __builtin_amdgcn_mfma_f32_16x16x32_bf16(ah, bl1, acc1, 0, 0, 0);
            acc0 = __builtin_amdgcn_mfma_f32_16x16x32_bf16(al, bh0, acc0, 0, 0, 0); acc1 = __builtin_amdgcn_mfma_f32_16x16x32_bf16(al, bh1, acc1, 0, 0, 0);
        }
        ss += __shfl_xor(ss, 16); ss += __shfl_xor(ss, 32);
        const float rstd = 1.0f / sqrtf(ss * (1.f / D) + RMS_EPS);
        if (kq == 0) { rs[wave * 16 + fr] = rstd; rstd_g[row] = rstd; }
        __syncthreads();
        { const float b0 = b_router[fr], b1 = b_router[16 + fr];
#pragma unroll
          for (int i = 0; i < 4; ++i) { const int rl = wave * 16 + 4 * kq + i; const float r_ = rs[rl]; lg[rl * 33 + fr] = acc0[i] * r_ + b0; lg[rl * 33 + 16 + fr] = acc1[i] * r_ + b1; } }
        __syncthreads();
        if (F.tid < 128) {
            const int rl = F.tid; float v[32];
#pragma unroll
            for (int e = 0; e < 32; ++e) v[e] = lg[rl * 33 + e];
            float topv[4]; int tope[4];
#pragma unroll
            for (int k = 0; k < 4; ++k) { float mx = v[0]; int mi = 0;
#pragma unroll
                for (int e = 1; e < 32; ++e) { const bool gt = v[e] > mx; mx = gt ? v[e] : mx; mi = gt ? e : mi; }
                topv[k] = mx; tope[k] = mi;
#pragma unroll
                for (int e = 0; e < 32; ++e) v[e] = (e == mi) ? -INFINITY : v[e]; }
            const float e1 = __expf(topv[1] - topv[0]), e2 = __expf(topv[2] - topv[0]), e3 = __expf(topv[3] - topv[0]);
            const float inv = 1.0f / (1.0f + e1 + e2 + e3);
            const float gk[4] = {inv, e1 * inv, e2 * inv, e3 * inv};
#pragma unroll
            for (int k = 0; k < 4; ++k) { const unsigned pos = atomicAdd((unsigned*)(lcount + tope[k]), 1u);
                rec[(rl * 4 + k) * 2] = (unsigned)tope[k] | (pos << 8); rec[(rl * 4 + k) * 2 + 1] = __float_as_uint(gk[k]); }
        }
        __syncthreads();
        if (F.tid < 32) gbase[F.tid] = atomicAdd(gcount + F.tid, lcount[F.tid]);
        __syncthreads();
        { const int rl = F.tid >> 2, k = F.tid & 3, m = blk * 128 + rl; const unsigned w0 = rec[F.tid * 2], w1 = rec[F.tid * 2 + 1];
          const unsigned ek = w0 & 255u, gpos = gbase[ek] + (w0 >> 8);
          list[(size_t)ek * T + gpos] = m; srs[(size_t)ek * T + gpos] = rs[rl]; info[(size_t)m * 4 + k] = (u32x2){ek | (gpos << 5), w1}; }
    }
    __syncthreads();
}

DEV void moe_layout(Frame& F, const Args& a) {
    volatile LAS int* L = (volatile LAS int*)(F.lds + LDS_CTL);
    if (F.tid == 0) {
        unsigned* gcount = (unsigned*)(a.ws + WS_CTL) + CW_GCOUNT; int st = 0;
        for (int e = 0; e < NE; ++e) { const int c = (int)__hip_atomic_load(gcount + e, __ATOMIC_RELAXED, __HIP_MEMORY_SCOPE_AGENT); L[LC_CNT + e] = c; L[LC_START + e] = st; st += (c + 255) & ~255; }
        L[LC_START + NE] = st; L[LC_TOTAL] = st;
        int sp = 0; while (sp < NE && 2 * L[LC_START + sp] < st) ++sp;
        L[LC_SPLIT] = sp;
    }
    __syncthreads();
}

DEV void phase_moe_up_ref(Frame& F, const Args& a) {
    moe_layout(F, a);
    volatile LAS int* L = (volatile LAS int*)(F.lds + LDS_CTL);
    const bf16* H2 = (const bf16*)(a.ws + WS_H2); const bf16* Wgu_t = (const bf16*)(a.ws + WS_WGU); bf16* ACT = (bf16*)(a.ws + WS_ACT); const int* list = (const int*)(a.ws + WS_LIST);
    const float* b_gate = a.in[16]; const float* b_up = a.in[18];
    const int r = F.lane & 31, h = F.lane >> 5, total = L[LC_TOTAL];
    const int items = (total / 32) * 32;
    for (int it = F.gw; it < items; it += F.NGW) {
        const int rt = it >> 5, ft = it & 31, s0 = rt * 32, f0 = ft * 32;
        int e = 0; while (e < NE - 1 && s0 >= L[LC_START + e + 1]) ++e;
        const int local = s0 + r - L[LC_START + e];
        const int tok = local < L[LC_CNT + e] ? list[(size_t)e * T + local] : 0;
        const bf16* ap = H2 + (size_t)tok * D + 8 * h;
        const bf16* bg = Wgu_t + ((size_t)e * 2048 + 256 * (f0 >> 7) + (f0 & 127) + r) * D + 8 * h; const bf16* bu = bg + (size_t)128 * D;
        f32x16 acca, accb;
#pragma unroll
        for (int i = 0; i < 16; ++i) { acca[i] = 0.f; accb[i] = 0.f; }
#pragma unroll 4
        for (int k0 = 0; k0 < D; k0 += 16) { const bf16x8 av = *(const bf16x8*)(ap + k0);
            acca = __builtin_amdgcn_mfma_f32_32x32x16_bf16(av, *(const bf16x8*)(bg + k0), acca, 0, 0, 0);
            accb = __builtin_amdgcn_mfma_f32_32x32x16_bf16(av, *(const bf16x8*)(bu + k0), accb, 0, 0, 0); }
        const float bgv = b_gate[e * FF + f0 + r], buv = b_up[e * FF + f0 + r];
#pragma unroll
        for (int i = 0; i < 16; ++i) ACT[(size_t)(s0 + crow(i, h)) * FF + f0 + r] = (bf16)f2bf(swiglu(acca[i] + bgv, accb[i] + buv));
    }
}
DEV void phase_moe_down_ref(Frame& F, const Args& a, int half) {
    moe_layout(F, a);
    volatile LAS int* L = (volatile LAS int*)(F.lds + LDS_CTL);
    const bf16* ACT = (const bf16*)(a.ws + WS_ACT); const bf16* Wd_t = (const bf16*)(a.ws + WS_WD); const float* b_down = a.in[20];
    const int r = F.lane & 31, h = F.lane >> 5, total = L[LC_TOTAL], srow = L[LC_START + L[LC_SPLIT]];
    const int row_lo = half == 0 ? 0 : srow, row_hi = half == 0 ? srow : total;
    bf16* Y = half == 0 ? (bf16*)(a.ws + WS_Y0) : (bf16*)(a.ws + WS_Y1) - (size_t)srow * D;
    const int items = ((row_hi - row_lo) / 32) * 32;
    for (int it = F.gw; it < items; it += F.NGW) {
        const int rt = it >> 5, nt = it & 31, s0 = row_lo + rt * 32, n0 = nt * 32;
        int e = 0; while (e < NE - 1 && s0 >= L[LC_START + e + 1]) ++e;
        const bf16* ap = ACT + (size_t)(s0 + r) * FF + 8 * h;
        const bf16* bp = Wd_t + ((size_t)e * D + n0 + r) * FF + 8 * h;
        f32x16 acc;
#pragma unroll
        for (int i = 0; i < 16; ++i) acc[i] = 0.f;
#pragma unroll 8
        for (int k0 = 0; k0 < FF; k0 += 16) acc = __builtin_amdgcn_mfma_f32_32x32x16_bf16(*(const bf16x8*)(ap + k0), *(const bf16x8*)(bp + k0), acc, 0, 0, 0);
        const float bd = b_down[e * D + n0 + r];
#pragma unroll
        for (int i = 0; i < 16; ++i) Y[(size_t)(s0 + crow(i, h)) * D + n0 + r] = (bf16)f2bf(acc[i] + bd);
    }
}

DEV void phase_combine(Frame& F, const Args& a) {
    moe_layout(F, a);
    volatile LAS int* L = (volatile LAS int*)(F.lds + LDS_CTL);
    const int srow = L[LC_START + L[LC_SPLIT]];
#if FP8_MOE
    const bf16* Y0 = (const bf16*)(a.ws + WS_Y); const bf16* Y1 = Y0; bf16* HP = (bf16*)(a.ws + WS_HP8);
#else
    const bf16* Y0 = (const bf16*)(a.ws + WS_Y0); const bf16* Y1 = (const bf16*)(a.ws + WS_Y1) - (size_t)srow * D; bf16* HP = (bf16*)(a.ws + WS_HP);
#endif
    const u32x2* info = (const u32x2*)(a.ws + WS_INFO); const float* g_ple = a.in[21];
    const int lane = F.lane;
    for (int m = F.gw; m < T; m += F.NGW) {
        f32x4* xr = (f32x4*)(a.out + (size_t)m * D) + lane;
        f32x4 v[4];
#pragma unroll
        for (int j = 0; j < 4; ++j) v[j] = xr[64 * j];
#pragma unroll
        for (int k = 0; k < 4; ++k) { const u32x2 w = info[(size_t)m * 4 + k]; const int e = w.x & 31, gpos = (int)(w.x >> 5); const unsigned wy = w.y; const float g = __uint_as_float(wy);
            const int row = L[LC_START + e] + gpos; const bf16* yr = (row < srow ? Y0 : Y1) + (size_t)row * D;
#pragma unroll
            for (int j = 0; j < 4; ++j) { const u32x2 yw = *((const u32x2*)yr + lane + 64 * j);
                v[j].x += g * bflo(yw.x); v[j].y += g * bfhi(yw.x); v[j].z += g * bflo(yw.y); v[j].w += g * bfhi(yw.y); } }
        float s = 0.f;
#pragma unroll
        for (int j = 0; j < 4; ++j) { xr[64 * j] = v[j]; s += (v[j].x * v[j].x + v[j].y * v[j].y) + (v[j].z * v[j].z + v[j].w * v[j].w); }
        const float rstd = 1.0f / sqrtf(wave_sum(s) * (1.f / D) + RMS_EPS);
        unsigned long long* o8 = (unsigned long long*)(HP + (size_t)m * D) + lane;
#pragma unroll
        for (int j = 0; j < 4; ++j) { const f32x4 gg = *((const f32x4*)g_ple + lane + 64 * j);
            o8[64 * j] = (unsigned long long)pk2(v[j].x * rstd * gg.x, v[j].y * rstd * gg.y) | ((unsigned long long)pk2(v[j].z * rstd * gg.z, v[j].w * rstd * gg.w) << 32); }
    }
}
struct EpiStoreBf16 { bf16* O; int ldc;
    DEV void operator()(int row, int col, float v) const { O[(size_t)row * ldc + col] = (bf16)f2bf(v); } };
struct EpiPle { const bf16* PP; float* out;
    DEV void operator()(int row, int col, float v) const { const size_t i = (size_t)row * D + col; out[i] = out[i] + sigmoidf_(v) * bf2f(PP[i]); } };

DEV void phase_final(Frame& F, const Args& a) {
    const float* g = a.in[24]; const int lane = F.lane;
    for (int m = F.gw; m < T; m += F.NGW) {
        f32x4* xr = (f32x4*)(a.out + (size_t)m * D) + lane;
        f32x4 v[4]; float s = 0.f;
#pragma unroll
        for (int j = 0; j < 4; ++j) { v[j] = xr[64 * j]; s += (v[j].x * v[j].x + v[j].y * v[j].y) + (v[j].z * v[j].z + v[j].w * v[j].w); }
        const float rstd = 1.0f / sqrtf(wave_sum(s) * (1.f / D) + RMS_EPS);
#pragma unroll
        for (int j = 0; j < 4; ++j) xr[64 * j] = v[j] * rstd * *((const f32x4*)g + lane + 64 * j);
    }
}


namespace pg8 {
constexpr int BM = 256, BK = 64, HALF = 128, HTB = HALF * BK * 2, STAGE_BYTES = 8 * HTB;
DEV int lds_byte(int r, int c) { const int st = (r >> 4) * 2 + (c >> 5), rr = r & 15, cc = c & 31, ob = rr * 64 + cc * 2; return st * 1024 + (ob ^ (((ob >> 9) & 1) << 5)); }
DEV void stage_rc(int b, int& R, int& C) { const int st = b / 1024, sb = b % 1024, swz = sb ^ (((sb >> 9) & 1) << 5); R = (st >> 1) * 16 + swz / 64; C = (st & 1) * 32 + (swz % 64) / 2; }
DEV int perm32(int rho) { const int n = rho >> 4, i = rho & 15; return 8 * (i >> 2) + 4 * n + (i & 3); }
struct Unit { int pm, pn, e, mt; };
DEV unsigned cvt_pk_bf16(float lo, float hi) { unsigned r; asm volatile("v_cvt_pk_bf16_f32 %0, %1, %2" : "=v"(r) : "v"(lo), "v"(hi)); return r; }

typedef int i32x8 __attribute__((ext_vector_type(8)));
template <class Epi, class Sched, bool GATHER, bool FP8 = false>
DEV void gemm_phase(LAS unsigned char* lds, const bf16* A, int lda, const bf16* Bt, int ldb, int K, const Sched& S, const Epi& E, const int* list, volatile LAS int* L) {
    const int tid = threadIdx.x, wid = __builtin_amdgcn_readfirstlane(tid >> 6), lane = tid & 63, wr = wid >> 2, wc = wid & 3, fr = lane & 15, fq = lane >> 4;
    const int nt = K / BK;
    unsigned voffA[2], voffB[2]; int RA[2], CA[2];
#pragma unroll
    for (int i = 0; i < 2; ++i) { int R, C; stage_rc(tid * 16 + i * 8192, R, C); const int Rb = Epi::PERM ? ((R & ~31) + perm32(R & 31)) : R;
        voffA[i] = (unsigned)(R * lda + C) * 2u; voffB[i] = (unsigned)(Rb * ldb + C) * 2u; RA[i] = R; CA[i] = C; }
    const size_t kstep = (size_t)(BK * 2);
    const size_t hstepA = (size_t)HALF * lda * 2, hstepB = (size_t)HALF * ldb * 2;
    const unsigned ldsw = (unsigned)wid * 1024u;
    const int aoff = lds_byte(wr * 64 + fr, fq * 8), boff = lds_byte(wc * 32 + fr, fq * 8);
#define PG8_SA(b, h) (((b) * 2 + (h)) * HTB)
#define PG8_SB(b, h) ((4 + (b) * 2 + (h)) * HTB)
#define PG8_STAGE(bufoff, gbase, voff) do { _Pragma("unroll") for (int _i = 0; _i < 2; ++_i) \
        __builtin_amdgcn_global_load_lds((const unsigned*)((const char*)(gbase) + (voff)[_i]), (LAS unsigned*)(lds + (bufoff) + ldsw + _i * 8192), 16, 0, 0); } while (0)
    const int aoff8 = lds_byte(wr * 64 + fr, fq * 16), boff8 = lds_byte(wc * 32 + fr, fq * 16);
#define PG8_LD8(p) __builtin_bit_cast(i32x8, __builtin_shufflevector(*(const LAS u32x4*)(p), *(const LAS u32x4*)((p) + 16), 0, 1, 2, 3, 4, 5, 6, 7))
#define PG8_LDA(dst, b, h) do { if constexpr (FP8) { _Pragma("unroll") for (int m = 0; m < 4; ++m) dst##8[m] = PG8_LD8(lds + PG8_SA(b, h) + aoff8 + m * 2048); } \
        else { _Pragma("unroll") for (int m = 0; m < 4; ++m) _Pragma("unroll") for (int k = 0; k < 2; ++k) dst[m][k] = *(const LAS bf16x8*)(lds + PG8_SA(b, h) + aoff + m * 2048 + k * 1024); } } while (0)
#define PG8_LDB(dst, b, h) do { if constexpr (FP8) { _Pragma("unroll") for (int n = 0; n < 2; ++n) dst##8[n] = PG8_LD8(lds + PG8_SB(b, h) + boff8 + n * 2048); } \
        else { _Pragma("unroll") for (int n = 0; n < 2; ++n) _Pragma("unroll") for (int k = 0; k < 2; ++k) dst[n][k] = *(const LAS bf16x8*)(lds + PG8_SB(b, h) + boff + n * 2048 + k * 1024); } } while (0)
#define PG8_MMA(ai, bj, At, Bt_) do { __builtin_amdgcn_s_setprio(1); _Pragma("unroll") for (int m = 0; m < 4; ++m) _Pragma("unroll") for (int n = 0; n < 2; ++n) { \
        if constexpr (FP8) { asm volatile("v_mfma_scale_f32_16x16x128_f8f6f4 %0, %1, %2, %0, %3, %3 op_sel_hi:[0,0,0]" : "+v"(acc[ai][bj][m][n]) : "v"(Bt_##8[n]), "v"(At##8[m]), "v"(scale1)); } \
        else { _Pragma("unroll") for (int k = 0; k < 2; ++k) acc[ai][bj][m][n] = __builtin_amdgcn_mfma_f32_16x16x32_bf16(Bt_[n][k], At[m][k], acc[ai][bj][m][n], 0, 0, 0); } } \
        __builtin_amdgcn_s_setprio(0); } while (0)
#define PG8_WAIT_V(n) asm volatile("s_waitcnt vmcnt(" #n ")" ::: "memory")
#define PG8_WAIT_L(n) asm volatile("s_waitcnt lgkmcnt(" #n ")" ::: "memory")
#define PG8_BAR __builtin_amdgcn_s_barrier()
#define PG8_SCHED __builtin_amdgcn_sched_barrier(0)
    unsigned aoc[2][2], aon[2][2];
#define PG8_GATHER_OFFS(dst, u) do { _Pragma("unroll") for (int _h = 0; _h < 2; ++_h) _Pragma("unroll") for (int _i = 0; _i < 2; ++_i) { \
        const int _idx = (u).mt * 256 + _h * HALF + RA[_i]; const int _tok = _idx < L[LC_CNT + (u).e] ? list[(size_t)(u).e * T + _idx] : 0; \
        dst[_h][_i] = (unsigned)(_tok * lda + CA[_i]) * 2u; } } while (0)
    Unit cur, nxt; int ui = 0;
    if (!S.next(0, cur)) return;
    f32x4 acc[2][2][4][2];
#pragma unroll
    for (int a = 0; a < 2; ++a)
#pragma unroll
        for (int b = 0; b < 2; ++b)
#pragma unroll
            for (int m = 0; m < 4; ++m)
#pragma unroll
                for (int n = 0; n < 2; ++n) acc[a][b][m][n] = (f32x4){0.f, 0.f, 0.f, 0.f};
    bf16x8 At[4][2], B0[2][2], B1[2][2]; i32x8 At8[4], B08[2], B18[2]; unsigned scale1 = 0x7F7F7F7Fu; asm volatile("" : "+v"(scale1));
    const char* cA; const char* cB = (const char*)Bt + S.brow(cur) * (size_t)ldb * 2;
    if constexpr (GATHER) { cA = (const char*)A; PG8_GATHER_OFFS(aoc, cur); }
    else { cA = (const char*)A + (size_t)cur.pm * BM * lda * 2;
#pragma unroll
        for (int i = 0; i < 2; ++i) { aoc[0][i] = voffA[i]; aoc[1][i] = voffA[i] + (unsigned)hstepA; } }
    PG8_STAGE(PG8_SB(0, 0), cB, voffB); PG8_STAGE(PG8_SB(0, 1), cB + hstepB, voffB); PG8_STAGE(PG8_SA(0, 0), cA, aoc[0]); PG8_STAGE(PG8_SA(0, 1), cA, aoc[1]);
    if (wr == 1) PG8_BAR;
    PG8_WAIT_V(2); PG8_BAR;
    PG8_STAGE(PG8_SB(1, 0), cB + kstep, voffB); PG8_STAGE(PG8_SA(1, 0), cA + kstep, aoc[0]); PG8_STAGE(PG8_SB(1, 1), cB + hstepB + kstep, voffB);
    PG8_WAIT_V(6); PG8_BAR;
    for (;;) {
        const bool has_next = S.next(ui + 1, nxt);
        const char* nA; const char* nB = has_next ? (const char*)Bt + S.brow(nxt) * (size_t)ldb * 2 : cB;
        if constexpr (GATHER) { nA = cA; if (has_next) PG8_GATHER_OFFS(aon, nxt); else {
#pragma unroll
            for (int h = 0; h < 2; ++h)
#pragma unroll
                for (int i = 0; i < 2; ++i) aon[h][i] = aoc[h][i]; } }
        else { nA = has_next ? (const char*)A + (size_t)nxt.pm * BM * lda * 2 : cA; }
#pragma unroll 1
        for (int t = 0; t < nt; t += 2) {
            const bool last = (t == nt - 2);
            const char* a1 = cA + (size_t)(t + 1) * kstep;
            const char* a2 = last ? nA : cA + (size_t)(t + 2) * kstep; const char* b2 = last ? nB : cB + (size_t)(t + 2) * kstep;
            const char* a3 = a2 + kstep; const char* b3 = b2 + kstep;
            unsigned ao2[2][2];
#pragma unroll
            for (int h = 0; h < 2; ++h)
#pragma unroll
                for (int i = 0; i < 2; ++i) ao2[h][i] = GATHER ? (last ? aon[h][i] : aoc[h][i]) : aoc[h][i];
            PG8_LDB(B0, 0, 0); PG8_LDB(B1, 0, 1); PG8_SCHED; PG8_LDA(At, 0, 0); PG8_STAGE(PG8_SA(1, 1), a1, aoc[1]);
            PG8_WAIT_V(8); PG8_WAIT_L(0); PG8_BAR; PG8_MMA(0, 0, At, B0); PG8_MMA(0, 1, At, B1); PG8_BAR; PG8_SCHED;
            PG8_LDA(At, 0, 1); PG8_STAGE(PG8_SB(0, 0), b2, voffB); PG8_STAGE(PG8_SB(0, 1), b2 + hstepB, voffB); PG8_STAGE(PG8_SA(0, 0), a2, ao2[0]);
            PG8_WAIT_V(8); PG8_WAIT_L(0); PG8_BAR; PG8_MMA(1, 0, At, B0); PG8_MMA(1, 1, At, B1); PG8_BAR; PG8_SCHED;
            PG8_LDB(B0, 1, 0); PG8_LDB(B1, 1, 1); PG8_SCHED; PG8_LDA(At, 1, 0); PG8_STAGE(PG8_SA(0, 1), a2, ao2[1]);
            PG8_WAIT_V(8); PG8_WAIT_L(0); PG8_BAR; PG8_MMA(0, 0, At, B0); PG8_MMA(0, 1, At, B1); PG8_BAR; PG8_SCHED;
            PG8_LDA(At, 1, 1); PG8_STAGE(PG8_SB(1, 0), b3, voffB); PG8_STAGE(PG8_SB(1, 1), b3 + hstepB, voffB); PG8_STAGE(PG8_SA(1, 0), a3, ao2[0]);
            PG8_WAIT_V(8); PG8_WAIT_L(0); PG8_BAR; PG8_MMA(1, 0, At, B0); PG8_MMA(1, 1, At, B1); PG8_BAR; PG8_SCHED;
        }
        if constexpr (FP8) asm volatile("s_nop 15\n\ts_nop 15" ::: "memory");
        if (wr == 0) PG8_BAR;
        E(acc, cur, wr, wc, fr, fq);
        if (!has_next) break;
#pragma unroll
        for (int a = 0; a < 2; ++a)
#pragma unroll
            for (int b = 0; b < 2; ++b)
#pragma unroll
                for (int m = 0; m < 4; ++m)
#pragma unroll
                    for (int n = 0; n < 2; ++n) acc[a][b][m][n] = (f32x4){0.f, 0.f, 0.f, 0.f};
        cur = nxt; cA = nA; cB = nB; ++ui;
        if constexpr (GATHER) {
#pragma unroll
            for (int h = 0; h < 2; ++h)
#pragma unroll
                for (int i = 0; i < 2; ++i) aoc[h][i] = aon[h][i]; }
        if (wr == 1) PG8_BAR;
    }
    PG8_WAIT_V(0);
    PG8_BAR;
#undef PG8_SA
#undef PG8_SB
#undef PG8_STAGE
#undef PG8_LDA
#undef PG8_LDB
#undef PG8_MMA
#undef PG8_LD8
#undef PG8_WAIT_V
#undef PG8_WAIT_L
#undef PG8_BAR
#undef PG8_SCHED
#undef PG8_GATHER_OFFS
}

struct StaticOrder {
    int nM, nN, nwg, G, c;
    DEV void init(int M, int N, int G_, int c_) { nM = M / BM; nN = N / BM; nwg = nM * nN; G = G_; c = c_; }
    DEV bool next(int i, Unit& u) const {
        const long Lx = (long)i * G + c; if (Lx >= nwg) return false;
        int wgid = (int)Lx; { const int q = nwg / 8, r = nwg % 8, xcd = wgid % 8, off = wgid / 8; wgid = (xcd < r ? xcd * (q + 1) : r * (q + 1) + (xcd - r) * q) + off; }
        const int nig = 8 * nN, gid = wgid / nig, fm = gid * 8, gsz = (nM - fm) < 8 ? (nM - fm) : 8;
        u.pm = fm + ((wgid % nig) % gsz); u.pn = (wgid % nig) / gsz; u.e = 0; u.mt = 0; return true;
    }
    DEV size_t brow(const Unit& u) const { return (size_t)u.pn * BM; }
};
struct MoeOrder {
    volatile LAS int* L; int e_lo, e_hi, NT, G, c, brows;
    DEV bool next(int i, Unit& u) const {
        const int per = G >> 3; int U = (i * 8 + (c & 7)) * per + (c >> 3);
        int e = e_lo;
        for (; e < e_hi; ++e) { const int nu = (((L[LC_CNT + e] + 255) >> 8)) * NT; if (U < nu) break; U -= nu; }
        if (e >= e_hi) return false;
        const int GS = 32 / NT, nm = (L[LC_CNT + e] + 255) >> 8, g = U >> 5, q2 = U - (g << 5);
        const int gsz = (nm - GS * g) < GS ? (nm - GS * g) : GS;
        u.e = e; u.pn = q2 / gsz; u.mt = GS * g + q2 % gsz; u.pm = (L[LC_START + e] >> 8) + u.mt; return true;
    }
    DEV size_t brow(const Unit& u) const { return (size_t)u.e * brows + (size_t)u.pn * BM; }
};
}

using pg8::Unit;
DEV u32x4 pack8(const f32x4& v0, const f32x4& v1) { u32x4 w; w.x = pg8::cvt_pk_bf16(v0[0], v0[1]); w.y = pg8::cvt_pk_bf16(v0[2], v0[3]); w.z = pg8::cvt_pk_bf16(v1[0], v1[1]); w.w = pg8::cvt_pk_bf16(v1[2], v1[3]); return w; }
DEV f32x4 lo4(const u32x4& w) { return (f32x4){bflo(w.x), bfhi(w.x), bflo(w.y), bfhi(w.y)}; }
DEV f32x4 hi4(const u32x4& w) { return (f32x4){bflo(w.z), bfhi(w.z), bflo(w.w), bfhi(w.w)}; }
struct FEpiZ { static constexpr bool PERM = true; bf16* Z1; bf16* Z2;
    DEV void operator()(const f32x4 (&acc)[2][2][4][2], const Unit& u, int wr, int wc, int fr, int fq) const {
        const int row0 = u.pm * 256 + wr * 64 + fr, pn = u.pn;
        bf16* base; int ld, colt, kind;
        if (pn < 7) { base = Z1; ld = Z1W; colt = pn * 256; kind = pn < 2 ? 0 : (pn == 2 ? 1 : 2); } else { base = Z2; ld = Z2W; colt = (pn - 7) * 256; kind = 3; }
        const int col0 = colt + wc * 32 + 8 * fq;
#pragma unroll
        for (int ai = 0; ai < 2; ++ai)
#pragma unroll
            for (int m = 0; m < 4; ++m) { bf16* rowp = base + (size_t)(row0 + ai * 128 + m * 16) * ld + col0;
#pragma unroll
                for (int bj = 0; bj < 2; ++bj) { f32x4 v0 = acc[ai][bj][m][0], v1 = acc[ai][bj][m][1];
                    if (kind == 0) { v0 = v0 * QSCALE; v1 = v1 * QSCALE; }
                    else if (kind == 2) {
#pragma unroll
                        for (int j = 0; j < 4; ++j) { v0[j] = gelu_tanh(v0[j]); v1[j] = gelu_tanh(v1[j]); } }
                    else if (kind == 3) {
#pragma unroll
                        for (int j = 0; j < 4; ++j) { v0[j] = sigmoidf_(v0[j]); v1[j] = sigmoidf_(v1[j]); } }
                    *(u32x4*)(rowp + bj * 128) = pack8(v0, v1); } }
    } };
struct FEpiProjA { static constexpr bool PERM = true; const bf16* Z2; bf16* TMP;
    DEV void operator()(const f32x4 (&acc)[2][2][4][2], const Unit& u, int wr, int wc, int fr, int fq) const {
        const int row0 = u.pm * 256 + wr * 64 + fr, col0 = u.pn * 256 + wc * 32 + 8 * fq;
#pragma unroll
        for (int ai = 0; ai < 2; ++ai)
#pragma unroll
            for (int m = 0; m < 4; ++m) { const size_t r = (size_t)(row0 + ai * 128 + m * 16);
#pragma unroll
                for (int bj = 0; bj < 2; ++bj) { const u32x4 g = *(const u32x4*)(Z2 + r * Z2W + col0 + bj * 128);
                    *(u32x4*)(TMP + r * D + col0 + bj * 128) = pack8(acc[ai][bj][m][0] * lo4(g), acc[ai][bj][m][1] * hi4(g)); } }
    } };
struct FEpiProjB { static constexpr bool PERM = true; const bf16* Z2; const bf16* TMP; bf16* MRG;
    DEV void operator()(const f32x4 (&acc)[2][2][4][2], const Unit& u, int wr, int wc, int fr, int fq) const {
        const int row0 = u.pm * 256 + wr * 64 + fr, col0 = u.pn * 256 + wc * 32 + 8 * fq;
#pragma unroll
        for (int ai = 0; ai < 2; ++ai)
#pragma unroll
            for (int m = 0; m < 4; ++m) { const size_t r = (size_t)(row0 + ai * 128 + m * 16);
#pragma unroll
                for (int bj = 0; bj < 2; ++bj) { const u32x4 g = *(const u32x4*)(Z2 + r * Z2W + 1024 + col0 + bj * 128); const u32x4 t = *(const u32x4*)(TMP + r * D + col0 + bj * 128);
                    *(u32x4*)(MRG + r * D + col0 + bj * 128) = pack8(lo4(t) + acc[ai][bj][m][0] * lo4(g), hi4(t) + acc[ai][bj][m][1] * hi4(g)); } }
    } };
struct FEpiResid { static constexpr bool PERM = false; const float* base; float* out;
    DEV void operator()(const f32x4 (&acc)[2][2][4][2], const Unit& u, int wr, int wc, int fr, int fq) const {
        const int row0 = u.pm * 256 + wr * 64 + fr, col0 = u.pn * 256 + wc * 32 + 4 * fq;
#pragma unroll
        for (int ai = 0; ai < 2; ++ai)
#pragma unroll
            for (int m = 0; m < 4; ++m) { const size_t off = (size_t)(row0 + ai * 128 + m * 16) * D + col0;
#pragma unroll
                for (int bj = 0; bj < 2; ++bj)
#pragma unroll
                    for (int n = 0; n < 2; ++n) *(f32x4*)(out + off + bj * 128 + n * 16) = *(const f32x4*)(base + off + bj * 128 + n * 16) + acc[ai][bj][m][n]; }
    } };
struct FEpiMoeUp { static constexpr bool PERM = true; const float* b_gate; const float* b_up; bf16* ACT; const float* srs;
    DEV void operator()(const f32x4 (&acc)[2][2][4][2], const Unit& u, int wr, int wc, int fr, int fq) const {
        const int row0 = u.pm * 256 + wr * 64 + fr, f0 = u.pn * 128 + wc * 32 + 8 * fq;
        const f32x4 bg0 = *(const f32x4*)(b_gate + u.e * FF + f0), bg1 = *(const f32x4*)(b_gate + u.e * FF + f0 + 4), bu0 = *(const f32x4*)(b_up + u.e * FF + f0), bu1 = *(const f32x4*)(b_up + u.e * FF + f0 + 4);
#pragma unroll
        for (int ai = 0; ai < 2; ++ai)
#pragma unroll
            for (int m = 0; m < 4; ++m) { const float rr_ = srs[(size_t)u.e * T + u.mt * 256 + ai * 128 + wr * 64 + m * 16 + fr];
                f32x4 a0 = acc[ai][0][m][0] * rr_ + bg0, a1 = acc[ai][0][m][1] * rr_ + bg1, b0 = acc[ai][1][m][0] * rr_ + bu0, b1 = acc[ai][1][m][1] * rr_ + bu1;
#pragma unroll
                for (int j = 0; j < 4; ++j) { a0[j] = swiglu(a0[j], b0[j]); a1[j] = swiglu(a1[j], b1[j]); }
                *(u32x4*)(ACT + (size_t)(row0 + ai * 128 + m * 16) * FF + f0) = pack8(a0, a1); }
    } };
struct FEpiMoeUp8 { static constexpr bool PERM = true; const float* b_gate; const float* b_up; unsigned char* ACT; const float* srs;
    DEV void operator()(const f32x4 (&acc)[2][2][4][2], const Unit& u, int wr, int wc, int fr, int fq) const {
        const int row0 = u.pm * 256 + wr * 64 + fr, f0 = u.pn * 128 + wc * 32 + 8 * fq;
        const f32x4 bg0 = *(const f32x4*)(b_gate + u.e * FF + f0), bg1 = *(const f32x4*)(b_gate + u.e * FF + f0 + 4), bu0 = *(const f32x4*)(b_up + u.e * FF + f0), bu1 = *(const f32x4*)(b_up + u.e * FF + f0 + 4);
#pragma unroll
        for (int ai = 0; ai < 2; ++ai)
#pragma unroll
            for (int m = 0; m < 4; ++m) { const float rr_ = srs[(size_t)u.e * T + u.mt * 256 + ai * 128 + wr * 64 + m * 16 + fr] * W8_INV;
                f32x4 a0 = acc[ai][0][m][0] * rr_ + bg0, a1 = acc[ai][0][m][1] * rr_ + bg1, b0 = acc[ai][1][m][0] * rr_ + bu0, b1 = acc[ai][1][m][1] * rr_ + bu1;
#pragma unroll
                for (int j = 0; j < 4; ++j) { a0[j] = swiglu(a0[j], b0[j]); a1[j] = swiglu(a1[j], b1[j]); }
                *(u32x2*)(ACT + (size_t)(row0 + ai * 128 + m * 16) * FF + f0) = (u32x2){pk4_fp8(a0[0], a0[1], a0[2], a0[3]), pk4_fp8(a1[0], a1[1], a1[2], a1[3])}; }
    } };
struct FEpiMoeDown8 { static constexpr bool PERM = true; const float* b_down; bf16* Y;
    DEV void operator()(const f32x4 (&acc)[2][2][4][2], const Unit& u, int wr, int wc, int fr, int fq) const {
        const int row0 = u.pm * 256 + wr * 64 + fr, col0 = u.pn * 256 + wc * 32 + 8 * fq;
        f32x4 bv[2][2];
#pragma unroll
        for (int bj = 0; bj < 2; ++bj)
#pragma unroll
            for (int n = 0; n < 2; ++n) bv[bj][n] = *(const f32x4*)(b_down + u.e * D + col0 + bj * 128 + 4 * n);
#pragma unroll
        for (int ai = 0; ai < 2; ++ai)
#pragma unroll
            for (int m = 0; m < 4; ++m) { bf16* rowp = Y + (size_t)(row0 + ai * 128 + m * 16) * D + col0;
#pragma unroll
                for (int bj = 0; bj < 2; ++bj) *(u32x4*)(rowp + bj * 128) = pack8(acc[ai][bj][m][0] * W8_INV + bv[bj][0], acc[ai][bj][m][1] * W8_INV + bv[bj][1]); }
    } };
struct FEpiMoeDown { static constexpr bool PERM = true; const float* b_down; bf16* Y;
    DEV void operator()(const f32x4 (&acc)[2][2][4][2], const Unit& u, int wr, int wc, int fr, int fq) const {
        const int row0 = u.pm * 256 + wr * 64 + fr, col0 = u.pn * 256 + wc * 32 + 8 * fq;
        f32x4 bv[2][2];
#pragma unroll
        for (int bj = 0; bj < 2; ++bj)
#pragma unroll
            for (int n = 0; n < 2; ++n) bv[bj][n] = *(const f32x4*)(b_down + u.e * D + col0 + bj * 128 + 4 * n);
#pragma unroll
        for (int ai = 0; ai < 2; ++ai)
#pragma unroll
            for (int m = 0; m < 4; ++m) { bf16* rowp = Y + (size_t)(row0 + ai * 128 + m * 16) * D + col0;
#pragma unroll
                for (int bj = 0; bj < 2; ++bj) *(u32x4*)(rowp + bj * 128) = pack8(acc[ai][bj][m][0] + bv[bj][0], acc[ai][bj][m][1] + bv[bj][1]); }
    } };
struct FEpiBf16 { static constexpr bool PERM = true; bf16* O; int ldc;
    DEV void operator()(const f32x4 (&acc)[2][2][4][2], const Unit& u, int wr, int wc, int fr, int fq) const {
        const int row0 = u.pm * 256 + wr * 64 + fr, col0 = u.pn * 256 + wc * 32 + 8 * fq;
#pragma unroll
        for (int ai = 0; ai < 2; ++ai)
#pragma unroll
            for (int m = 0; m < 4; ++m) { bf16* rowp = O + (size_t)(row0 + ai * 128 + m * 16) * ldc + col0;
#pragma unroll
                for (int bj = 0; bj < 2; ++bj) *(u32x4*)(rowp + bj * 128) = pack8(acc[ai][bj][m][0], acc[ai][bj][m][1]); }
    } };
struct FEpiPle { static constexpr bool PERM = false; const bf16* PP; float* out;
    DEV void operator()(const f32x4 (&acc)[2][2][4][2], const Unit& u, int wr, int wc, int fr, int fq) const {
        const int row0 = u.pm * 256 + wr * 64 + fr, col0 = u.pn * 256 + wc * 32 + 4 * fq;
#pragma unroll
        for (int ai = 0; ai < 2; ++ai)
#pragma unroll
            for (int m = 0; m < 4; ++m) { const size_t off = (size_t)(row0 + ai * 128 + m * 16) * D + col0;
#pragma unroll
                for (int bj = 0; bj < 2; ++bj)
#pragma unroll
                    for (int n = 0; n < 2; ++n) { const size_t o = off + bj * 128 + n * 16; const u32x2 pw = *(const u32x2*)(PP + o); const f32x4 a = acc[ai][bj][m][n];
                        f32x4 r = *(const f32x4*)(out + o);
                        r[0] += sigmoidf_(a[0]) * bflo(pw.x); r[1] += sigmoidf_(a[1]) * bfhi(pw.x); r[2] += sigmoidf_(a[2]) * bflo(pw.y); r[3] += sigmoidf_(a[3]) * bfhi(pw.y);
                        *(f32x4*)(out + o) = r; }
                asm volatile("" ::: "memory"); }
    } };


#define MFMA32(a, b, c) __builtin_amdgcn_mfma_f32_32x32x16_bf16((a), (b), (c), 0, 0, 0)
DEV void phase_mixers_fast(Frame& F, const Args& a) {
    const bf16* Z1 = (const bf16*)(a.ws + WS_Z1); bf16* AP = (bf16*)(a.ws + WS_AP);
    const int tid = F.tid, lane = F.lane, r = lane & 31, h = lane >> 5, wave = F.wave;
    {
        LAS unsigned char* Kl = F.lds;
        LAS unsigned char* Vl = F.lds + 36864;
        LAS float* wsf = (LAS float*)(F.lds + 70144) + wave * 64;
        const float* sinks = a.in[4];
        for (int u = F.vcu; u < 512; u += F.G) {
            const int kvh = u & 1, bn = u >> 1, b = bn >> 4, n = bn & 15;
            const int tok0 = b * SEQ + n * 128, key0 = tok0 - 128;
            __syncthreads();
#pragma unroll
            for (int i = 0; i < 4; ++i) { const int idx = tid + 512 * i, key = idx >> 3, ch = idx & 7;
                u32x4 v = (u32x4){0u, 0u, 0u, 0u};
                if (n > 0 || key >= 128) v = *(const u32x4*)(Z1 + (size_t)(key0 + key) * Z1W + 512 + kvh * 64 + ch * 8);
                *(LAS u32x4*)(Kl + key * 144 + ch * 16) = v; }
#pragma unroll
            for (int i = 0; i < 2; ++i) { const int idx = tid + 512 * i, kp = idx >> 3, ch = idx & 7;
                u32x4 v0 = (u32x4){0u, 0u, 0u, 0u}, v1 = v0;
                if (n > 0 || kp >= 64) { const bf16* vp = Z1 + (size_t)(key0 + 2 * kp) * Z1W + 640 + kvh * 64 + ch * 8; v0 = *(const u32x4*)vp; v1 = *(const u32x4*)(vp + Z1W); }
                LAS unsigned char* dst = Vl + (ch * 8) * 520 + kp * 4;
                *(LAS unsigned*)(dst + 0 * 520) = (v0.x & 0xffffu) | (v1.x << 16); *(LAS unsigned*)(dst + 1 * 520) = (v0.x >> 16) | (v1.x & 0xffff0000u);
                *(LAS unsigned*)(dst + 2 * 520) = (v0.y & 0xffffu) | (v1.y << 16); *(LAS unsigned*)(dst + 3 * 520) = (v0.y >> 16) | (v1.y & 0xffff0000u);
                *(LAS unsigned*)(dst + 4 * 520) = (v0.z & 0xffffu) | (v1.z << 16); *(LAS unsigned*)(dst + 5 * 520) = (v0.z >> 16) | (v1.z & 0xffff0000u);
                *(LAS unsigned*)(dst + 6 * 520) = (v0.w & 0xffffu) | (v1.w << 16); *(LAS unsigned*)(dst + 7 * 520) = (v0.w >> 16) | (v1.w & 0xffff0000u); }
            __syncthreads();
            const int g = wave >> 1, qh = wave & 1, hh = kvh * 4 + g;
            const float slope2 = fexp2(-(float)(hh + 1)) * LOG2E, sink2 = sinks[hh] * LOG2E;
#pragma unroll 1
            for (int qs = 0; qs < 2; ++qs) {
                const int q0 = qh * 64 + qs * 32, kt0 = q0 >> 5, ql = q0 + r;
                bf16x8 qf[4];
#pragma unroll
                for (int ds = 0; ds < 4; ++ds) qf[ds] = *(const bf16x8*)(Z1 + (size_t)(tok0 + ql) * Z1W + hh * 64 + 16 * ds + 8 * h);
                f32x16 p[5];
#pragma unroll
                for (int t = 0; t < 5; ++t) {
#pragma unroll
                    for (int i = 0; i < 16; ++i) p[t][i] = 0.f;
                    const LAS unsigned char* kb = Kl + (32 * (kt0 + t) + r) * 144 + 16 * h;
#pragma unroll
                    for (int ds = 0; ds < 4; ++ds) p[t] = MFMA32(*(const LAS bf16x8*)(kb + 32 * ds), qf[ds], p[t]);
                }
                float mx = sink2;
#pragma unroll
                for (int t = 0; t < 5; ++t)
#pragma unroll
                    for (int i = 0; i < 16; ++i) { const int sk = 32 * (kt0 + t) + crow(i, h), dist = ql + 128 - sk;
                        const bool ok = ((unsigned)dist < 128u) && (n > 0 || sk >= 128);
                        const float v = ok ? p[t][i] - slope2 * (float)dist : -INFINITY; p[t][i] = v; mx = fmaxf(mx, v); }
                mx = fmaxf(mx, __shfl_xor(mx, 32));
                float ls = 0.f;
#pragma unroll
                for (int t = 0; t < 5; ++t)
#pragma unroll
                    for (int i = 0; i < 16; ++i) { const float e = fexp2(p[t][i] - mx); p[t][i] = e; ls += e; }
                ls += __shfl_xor(ls, 32); ls += fexp2(sink2 - mx);
                f32x16 o[2];
#pragma unroll
                for (int i = 0; i < 16; ++i) { o[0][i] = 0.f; o[1][i] = 0.f; }
#pragma unroll
                for (int t = 0; t < 5; ++t)
#pragma unroll
                    for (int s2 = 0; s2 < 2; ++s2) {
                        u32x4 pw; pw.x = pg8::cvt_pk_bf16(p[t][8 * s2 + 0], p[t][8 * s2 + 1]); pw.y = pg8::cvt_pk_bf16(p[t][8 * s2 + 2], p[t][8 * s2 + 3]);
                        pw.z = pg8::cvt_pk_bf16(p[t][8 * s2 + 4], p[t][8 * s2 + 5]); pw.w = pg8::cvt_pk_bf16(p[t][8 * s2 + 6], p[t][8 * s2 + 7]);
                        const bf16x8 pf = __builtin_bit_cast(bf16x8, pw);
#pragma unroll
                        for (int db = 0; db < 2; ++db) { const LAS unsigned char* vb = Vl + (db * 32 + r) * 520 + (32 * (kt0 + t) + 16 * s2 + 4 * h) * 2;
                            const u32x2 lo = *(const LAS u32x2*)vb, hi = *(const LAS u32x2*)(vb + 16);
                            u32x4 vw; vw.x = lo.x; vw.y = lo.y; vw.z = hi.x; vw.w = hi.y;
                            o[db] = MFMA32(pf, __builtin_bit_cast(bf16x8, vw), o[db]); }
                    }
                asm volatile("" ::: "memory");
                if (h == 0) wsf[r] = ls;
                asm volatile("s_waitcnt lgkmcnt(0)" ::: "memory");
                bf16* op = AP + (size_t)tok0 * D + hh * 64 + r;
#pragma unroll
                for (int i = 0; i < 16; ++i) { const int q = q0 + crow(i, h); const float il = frcp(wsf[crow(i, h)]);
                    op[(size_t)q * D] = (bf16)f2bf(o[0][i] * il); op[(size_t)q * D + 32] = (bf16)f2bf(o[1][i] * il); }
                asm volatile("s_waitcnt lgkmcnt(0)" ::: "memory");
            }
        }
    }
    {
        LAS unsigned char* vT = F.lds;
        LAS float* stl = (LAS float*)(F.lds + 69632);
        const bf16* Wsp = (const bf16*)(a.ws + WS_WSP); const float* g_ln = a.in[5]; const float* b_ln = a.in[6]; const float* b_sp = a.in[8];
        for (int u = F.vcu; u < 256; u += F.G) {
            const int tok0 = u * 128;
            __syncthreads();
            for (int rr = 0; rr < 16; ++rr) { const int t = wave * 16 + rr;
                const u32x4 w = *((const u32x4*)(Z1 + (size_t)(tok0 + t) * Z1W + 1280) + lane);
                float v[8] = {bflo(w.x), bfhi(w.x), bflo(w.y), bfhi(w.y), bflo(w.z), bfhi(w.z), bflo(w.w), bfhi(w.w)};
                float s = 0.f;
#pragma unroll
                for (int j = 0; j < 8; ++j) s += v[j];
                const float mean = wave_sum(s) * (1.f / 512.f); float q = 0.f;
#pragma unroll
                for (int j = 0; j < 8; ++j) { const float d = v[j] - mean; q += d * d; }
                const float rstd = 1.0f / sqrtf(wave_sum(q) * (1.f / 512.f) + LN_EPS);
                if (lane == 0) { stl[2 * t] = mean; stl[2 * t + 1] = rstd; } }
#pragma unroll 1
            for (int hf = 0; hf < 2; ++hf) {
                __syncthreads();
#pragma unroll
                for (int i = 0; i < 4; ++i) { const int c8 = wave * 4 + i, tp = lane, ch0 = 256 * hf + 8 * c8;
                    const bf16* vp = Z1 + (size_t)(tok0 + 2 * tp) * Z1W + 1280 + ch0;
                    const u32x4 w0 = *(const u32x4*)vp, w1 = *(const u32x4*)(vp + Z1W);
                    const float m0 = stl[4 * tp], r0 = stl[4 * tp + 1], m1 = stl[4 * tp + 2], r1 = stl[4 * tp + 3];
                    const f32x4 ga = *(const f32x4*)(g_ln + ch0), gb = *(const f32x4*)(g_ln + ch0 + 4), ba = *(const f32x4*)(b_ln + ch0), bb = *(const f32x4*)(b_ln + ch0 + 4);
                    LAS unsigned char* dst = vT + (8 * c8) * 272 + tp * 4;
#define VT_W(j, w0c, w1c, gg, bbv, SEL) *(LAS unsigned*)(dst + (j) * 272) = pg8::cvt_pk_bf16((SEL(w0c) - m0) * r0 * (gg) + (bbv), (SEL(w1c) - m1) * r1 * (gg) + (bbv))
                    VT_W(0, w0.x, w1.x, ga.x, ba.x, bflo); VT_W(1, w0.x, w1.x, ga.y, ba.y, bfhi); VT_W(2, w0.y, w1.y, ga.z, ba.z, bflo); VT_W(3, w0.y, w1.y, ga.w, ba.w, bfhi);
                    VT_W(4, w0.z, w1.z, gb.x, bb.x, bflo); VT_W(5, w0.z, w1.z, gb.y, bb.y, bfhi); VT_W(6, w0.w, w1.w, gb.z, bb.z, bflo); VT_W(7, w0.w, w1.w, gb.w, bb.w, bfhi);
#undef VT_W
                }
                __syncthreads();
                const int gl = wave >> 2, cq = wave & 3, g = 2 * hf + gl, chb = gl * 128 + cq * 32;
                const int chg = 256 * hf + chb + r;
#pragma unroll 1
                for (int tt = 0; tt < 4; ++tt) {
                    f32x16 acc;
#pragma unroll
                    for (int i = 0; i < 16; ++i) acc[i] = 0.f;
                    const bf16* wp = Wsp + ((size_t)g * 128 + 32 * tt + r) * 128 + 8 * h;
                    const LAS unsigned char* bp = vT + (chb + r) * 272 + 16 * h;
#pragma unroll 2
                    for (int ss = 0; ss < 2 * tt + 2; ++ss) acc = MFMA32(*(const bf16x8*)(wp + 16 * ss), *(const LAS bf16x8*)(bp + 32 * ss), acc);
#pragma unroll
                    for (int i = 0; i < 16; ++i) { const int t = 32 * tt + crow(i, h); const size_t tok = (size_t)(tok0 + t);
                        const float uu = bf2f(Z1[tok * Z1W + 768 + chg]);
                        AP[tok * D + 512 + chg] = (bf16)f2bf(uu * (acc[i] + b_sp[g * 128 + t])); }
                }
            }
        }
    }
    __syncthreads();
}

constexpr int NPHASES = 14;
__global__ void __launch_bounds__(NTHREADS, 2) fwd(Args a) {
    extern __shared__ __attribute__((aligned(16))) unsigned char lds_raw[];
    Frame F;
    F.lds = (LAS unsigned char*)lds_raw;
    F.tid = threadIdx.x; F.lane = F.tid & 63; F.wave = __builtin_amdgcn_readfirstlane(F.tid >> 6);
    F.G = gridDim.x; { const int bx = blockIdx.x; F.vcu = (F.G % 8 == 0) ? (bx % 8) * (F.G / 8) + bx / 8 : bx; }
    F.gw = F.vcu * NWAVES + F.wave; F.NGW = F.G * NWAVES;
    for (int u = F.tid; u < (LDS_BYTES - LDS_CTL) / 4; u += NTHREADS) ((LAS unsigned*)(F.lds + LDS_CTL))[u] = 0u;
    __syncthreads();
    unsigned* ctl = (unsigned*)(a.ws + WS_CTL);
    const bool one = (a.ph_hi - a.ph_lo) > 1;
    XcdBarrier bar; bar.bar = ctl + CW_BAR; bar.x = 0; bar.st = nullptr;
    if (one) bar = xcd_barrier_post(ctl + CW_BAR, (volatile LAS unsigned*)(F.lds + LDS_CTL) + LC_BAR);
    unsigned char* ws = a.ws;
#define IN(k) (a.ph_lo <= (k) && (k) < a.ph_hi)
#define SEAM(k) do { if (IN(k) && IN((k) + 1)) xcd_barrier(bar); } while (0)
    if (IN(0)) { phase_prologue(F, a); } SEAM(0);
    volatile LAS int* Lc = (volatile LAS int*)(F.lds + LDS_CTL);
#if FAST_G1
    if (IN(1)) { FEpiZ E{(bf16*)(ws + WS_Z1), (bf16*)(ws + WS_Z2)}; pg8::StaticOrder S; S.init(T, NZ, F.G, (int)blockIdx.x);
        pg8::gemm_phase<FEpiZ, pg8::StaticOrder, false>(F.lds, (const bf16*)a.out, D, (const bf16*)(ws + WS_WIN), D, D, S, E, nullptr, Lc); } SEAM(1);
#else
    if (IN(1)) { EpiZ E{(bf16*)(ws + WS_Z1), (bf16*)(ws + WS_Z2)}; ngemm_wave((const bf16*)a.out, D, (const bf16*)(ws + WS_WIN), D, T / 32, NZ / 32, D, F, E); } SEAM(1);
#endif
#if FAST_MIX
    if (IN(3)) { phase_mixers_fast(F, a); } SEAM(3);
#else
    if (IN(2)) { phase_lnstats(F, a); } SEAM(2);
    if (IN(3)) { phase_mixers_ref(F, a); } SEAM(3);
#endif
#if FAST_G4
    if (IN(4)) { FEpiProjA E{(const bf16*)(ws + WS_Z2), (bf16*)(ws + WS_TMP)}; pg8::StaticOrder S; S.init(T, D, F.G, (int)blockIdx.x);
        pg8::gemm_phase<FEpiProjA, pg8::StaticOrder, false>(F.lds, (const bf16*)(ws + WS_AP), D, (const bf16*)(ws + WS_WAB), D, 512, S, E, nullptr, Lc); } SEAM(4);
    if (IN(5)) { FEpiProjB E{(const bf16*)(ws + WS_Z2), (const bf16*)(ws + WS_TMP), (bf16*)(ws + WS_MRG)}; pg8::StaticOrder S; S.init(T, D, F.G, (int)blockIdx.x);
        pg8::gemm_phase<FEpiProjB, pg8::StaticOrder, false>(F.lds, (const bf16*)(ws + WS_AP) + 512, D, (const bf16*)(ws + WS_WAB) + 512, D, 512, S, E, nullptr, Lc); } SEAM(5);
    if (IN(6)) { FEpiResid E{a.in[0], a.out}; pg8::StaticOrder S; S.init(T, D, F.G, (int)blockIdx.x);
        pg8::gemm_phase<FEpiResid, pg8::StaticOrder, false>(F.lds, (const bf16*)(ws + WS_MRG), D, (const bf16*)(ws + WS_WOUT), D, D, S, E, nullptr, Lc); } SEAM(6);
#else
    if (IN(4)) { EpiProjA E{(const bf16*)(ws + WS_Z2), (bf16*)(ws + WS_TMP)}; ngemm_wave((const bf16*)(ws + WS_AP), D, (const bf16*)(ws + WS_WAB), D, T / 32, D / 32, 512, F, E); } SEAM(4);
    if (IN(5)) { EpiProjB E{(const bf16*)(ws + WS_Z2), (const bf16*)(ws + WS_TMP), (bf16*)(ws + WS_MRG)}; ngemm_wave((const bf16*)(ws + WS_AP) + 512, D, (const bf16*)(ws + WS_WAB) + 512, D, T / 32, D / 32, 512, F, E); } SEAM(5);
    if (IN(6)) { EpiResid E{a.in[0], a.out}; ngemm_wave((const bf16*)(ws + WS_MRG), D, (const bf16*)(ws + WS_WOUT), D, T / 32, D / 32, D, F, E); } SEAM(6);
#endif
    if (IN(7)) { phase_router2(F, a); } SEAM(7);
#if FAST_MOE && FP8_MOE
    if (IN(8)) { moe_layout(F, a); FEpiMoeUp8 E{a.in[16], a.in[18], ws + WS_ACT8, (const float*)(ws + WS_SRS8)}; pg8::MoeOrder S{Lc, 0, NE, 8, F.G, (int)blockIdx.x, 2048};
        pg8::gemm_phase<FEpiMoeUp8, pg8::MoeOrder, true, true>(F.lds, (const bf16*)(ws + WS_H2Q), D / 2, (const bf16*)(ws + WS_WGU8), D / 2, D / 2, S, E, (const int*)(ws + WS_LIST), Lc); } SEAM(8);
    if (IN(9)) { moe_layout(F, a);
        { bf16* PB = (bf16*)(ws + WS_PB8); for (int m = F.gw; m < T; m += F.NGW) { const f32x4 pv = *((const f32x4*)(a.in[1] + (size_t)m * PLE) + F.lane); *((u32x2*)(PB + (size_t)m * PLE) + F.lane) = (u32x2){pk2(pv.x, pv.y), pk2(pv.z, pv.w)}; } }
        FEpiMoeDown8 E{a.in[20], (bf16*)(ws + WS_Y)}; pg8::MoeOrder S{Lc, 0, NE, 4, F.G, (int)blockIdx.x, 1024};
        pg8::gemm_phase<FEpiMoeDown8, pg8::MoeOrder, false, true>(F.lds, (const bf16*)(ws + WS_ACT8), FF / 2, (const bf16*)(ws + WS_WD8), FF / 2, FF / 2, S, E, nullptr, Lc); } SEAM(9);
#elif FAST_MOE
    if (IN(8)) { moe_layout(F, a); FEpiMoeUp E{a.in[16], a.in[18], (bf16*)(ws + WS_ACT), (const float*)(ws + WS_SRS2)}; pg8::MoeOrder S{Lc, 0, NE, 8, F.G, (int)blockIdx.x, 2048};
        pg8::gemm_phase<FEpiMoeUp, pg8::MoeOrder, true>(F.lds, (const bf16*)(ws + WS_H2), D, (const bf16*)(ws + WS_WGU), D, D, S, E, (const int*)(ws + WS_LIST), Lc); } SEAM(8);
    if (IN(9)) { moe_layout(F, a); FEpiMoeDown E{a.in[20], (bf16*)(ws + WS_Y0)}; pg8::MoeOrder S{Lc, 0, Lc[LC_SPLIT], 4, F.G, (int)blockIdx.x, 1024};
        pg8::gemm_phase<FEpiMoeDown, pg8::MoeOrder, false>(F.lds, (const bf16*)(ws + WS_ACT), FF, (const bf16*)(ws + WS_WD), FF, FF, S, E, nullptr, Lc); } SEAM(9);
    if (IN(10)) { moe_layout(F, a); const int srow = Lc[LC_START + Lc[LC_SPLIT]]; FEpiMoeDown E{a.in[20], (bf16*)(ws + WS_Y1) - (size_t)srow * D}; pg8::MoeOrder S{Lc, Lc[LC_SPLIT], NE, 4, F.G, (int)blockIdx.x, 1024};
        pg8::gemm_phase<FEpiMoeDown, pg8::MoeOrder, false>(F.lds, (const bf16*)(ws + WS_ACT), FF, (const bf16*)(ws + WS_WD), FF, FF, S, E, nullptr, Lc); } SEAM(10);
#else
    if (IN(8)) { phase_moe_up_ref(F, a); } SEAM(8);
    if (IN(9)) { phase_moe_down_ref(F, a, 0); } SEAM(9);
    if (IN(10)) { phase_moe_down_ref(F, a, 1); } SEAM(10);
#endif
#if FAST_G11
    if (IN(11)) { phase_combine(F, a); __syncthreads(); FEpiBf16 E{(bf16*)(ws + (FP8_MOE ? WS_PP8 : WS_PP)), D}; pg8::StaticOrder S; S.init(T, D, F.G, (int)blockIdx.x);
        pg8::gemm_phase<FEpiBf16, pg8::StaticOrder, false>(F.lds, (const bf16*)(ws + (FP8_MOE ? WS_PB8 : WS_PB)), PLE, (const bf16*)(ws + WS_WPP), PLE, PLE, S, E, nullptr, Lc); } SEAM(11);
    if (IN(12)) { FEpiPle E{(const bf16*)(ws + (FP8_MOE ? WS_PP8 : WS_PP)), a.out}; pg8::StaticOrder S; S.init(T, D, F.G, (int)blockIdx.x);
        pg8::gemm_phase<FEpiPle, pg8::StaticOrder, false>(F.lds, (const bf16*)(ws + (FP8_MOE ? WS_HP8 : WS_HP)), D, (const bf16*)(ws + WS_WPG), D, D, S, E, nullptr, Lc); } SEAM(12);
#else
    if (IN(11)) { phase_combine(F, a); EpiStoreBf16 E{(bf16*)(ws + WS_PP), D}; ngemm_wave((const bf16*)(ws + WS_PB), PLE, (const bf16*)(ws + WS_WPP), PLE, T / 32, D / 32, PLE, F, E); } SEAM(11);
    if (IN(12)) { EpiPle E{(const bf16*)(ws + WS_PP), a.out}; ngemm_wave((const bf16*)(ws + WS_HP), D, (const bf16*)(ws + WS_WPG), D, T / 32, D / 32, D, F, E); } SEAM(12);
#endif
    if (IN(13)) { phase_final(F, a); }
#undef IN
#undef SEAM
}

extern "C" void kernel_launch(void* const* d_in, const int* in_sizes, int n_in, void* d_out, int out_size, void* d_ws, size_t ws_size, hipStream_t stream) {
    static int grid = 0;
    if (grid == 0) {
        if (n_in != 25 || in_sizes[0] != T * D || out_size != T * D || ws_size < WS_END) { fprintf(stderr, "kernel_launch: unexpected shapes (n_in %d, ws %zu)\n", n_in, ws_size); grid = -1; return; }
        int dev = 0, cus = 0;
        if (hipGetDevice(&dev) != hipSuccess || hipDeviceGetAttribute(&cus, hipDeviceAttributeMultiprocessorCount, dev) != hipSuccess) { grid = -1; return; }
        if (hipFuncSetAttribute((const void*)fwd, hipFuncAttributeMaxDynamicSharedMemorySize, LDS_BYTES) != hipSuccess) { grid = -1; return; }
        (void)hipGetLastError();
        grid = cus;
    }
    if (grid < 0) return;
    (void)hipMemsetAsync((char*)d_ws + WS_CTL, 0, CTL_ZERO_BYTES, stream);
    Args a{};
    for (int i = 0; i < 25; ++i) a.in[i] = (const float*)d_in[i];
    a.out = (float*)d_out; a.ws = (unsigned char*)d_ws;
#if MK_ONE_LAUNCH
    a.ph_lo = 0; a.ph_hi = NPHASES;
    hipLaunchKernelGGL(fwd, dim3(grid), dim3(NTHREADS), LDS_BYTES, stream, a);
#else
    for (int p = 0; p < NPHASES; ++p) { a.ph_lo = p; a.ph_hi = p + 1; hipLaunchKernelGGL(fwd, dim3(grid), dim3(NTHREADS), LDS_BYTES, stream, a); }
#endif
}
```

```cpp
#include <hip/hip_runtime.h>
#include <cstdint>
#include <cstdio>

#define DEV __device__ __forceinline__
#define LAS __attribute__((address_space(3)))
typedef unsigned short bf16;
typedef short bf16x8 __attribute__((ext_vector_type(8)));
typedef float f32x4 __attribute__((ext_vector_type(4)));
typedef float f32x16 __attribute__((ext_vector_type(16)));
typedef unsigned u32x4 __attribute__((ext_vector_type(4)));
typedef unsigned u32x2 __attribute__((ext_vector_type(2)));

#ifndef FAST_GEMM
#define FAST_GEMM 1
#endif
#ifndef FAST_G1
#define FAST_G1 FAST_GEMM
#endif
#ifndef FAST_G4
#define FAST_G4 FAST_GEMM
#endif
#ifndef FAST_G11
#define FAST_G11 FAST_GEMM
#endif
#ifndef FAST_MIX
#define FAST_MIX 1
#endif
#ifndef FP8_MOE
#define FP8_MOE 1
#endif
#ifndef FAST_MOE
#define FAST_MOE 1
#endif
#ifndef MK_ONE_LAUNCH
#define MK_ONE_LAUNCH 1
#endif

constexpr int NB = 16, SEQ = 2048, T = NB * SEQ, D = 1024;
constexpr int NZ = 3840, Z1W = 1792, Z2W = 2048;
constexpr int NE = 32, FF = 1024, PLE = 256;
constexpr float LOG2E = 1.4426950408889634f;
constexpr float QSCALE = 0.125f * LOG2E;
constexpr float RMS_EPS = 1e-6f, LN_EPS = 1e-5f;
constexpr int NWAVES = 8, NTHREADS = 512;
constexpr int LDS_BYTES = 147456;
constexpr int LDS_CTL = 146432;
constexpr int LC_CNT = 0, LC_START = 32, LC_SPLIT = 65, LC_TOTAL = 66, LC_BAR = 100;

constexpr size_t MiB = 1u << 20;
constexpr size_t WS_CTL = 0, CTL_ZERO_BYTES = 1 * MiB;
constexpr size_t WS_STATS = 1 * MiB;
constexpr size_t WS_WIN = 2 * MiB, WS_WAB = 10 * MiB, WS_WOUT = 12 * MiB, WS_WPG = 14 * MiB, WS_WPP = 16 * MiB, WS_WSP = 16 * MiB + 512 * 1024;
constexpr size_t WS_LIST = 18 * MiB, WS_INFO = 22 * MiB;
constexpr size_t WS_WD = 24 * MiB, WS_WGU = 88 * MiB;
constexpr size_t WS_H2 = 216 * MiB, WS_AP = 216 * MiB;
constexpr size_t WS_ACT = 280 * MiB, WS_Z2 = 280 * MiB, WS_Z1 = 408 * MiB, WS_TMP = 408 * MiB, WS_MRG = 472 * MiB;
constexpr size_t WS_Y0 = 88 * MiB, WS_Y1 = 280 * MiB, WS_PP = 24 * MiB, WS_HP = 416 * MiB, WS_PB = 552 * MiB, WS_END = 572 * MiB;
constexpr size_t WS_RSTD = 1 * MiB + 512 * 1024;
constexpr size_t WS_WRH = 17 * MiB, WS_WRL = 17 * MiB + 64 * 1024;
constexpr size_t WS_SRS2 = 568 * MiB;
constexpr size_t WS_WD8 = 24 * MiB, WS_WGU8 = 56 * MiB, WS_H2Q = 120 * MiB, WS_ACT8 = 152 * MiB, WS_Y = 288 * MiB, WS_SRS8 = 560 * MiB;
constexpr size_t WS_PB8 = 120 * MiB, WS_HP8 = 56 * MiB, WS_PP8 = 152 * MiB;
constexpr size_t WS_X2B = 216 * MiB, WS_X3B = 288 * MiB, WS_WPG8 = 14 * MiB;
constexpr float W8_SCALE = 64.0f, W8_INV = 1.0f / 64.0f;
constexpr int Y0_CAP_ROWS = 98304;
constexpr int CW_TMO = 0, CW_GCOUNT = 64, CW_BAR = 4096;

struct Args { const float* in[25]; float* out; unsigned char* ws; int ph_lo, ph_hi; };

DEV unsigned f2bf(float f) { unsigned u = __builtin_bit_cast(unsigned, f); return (u + 0x7fffu + ((u >> 16) & 1u)) >> 16; }
DEV unsigned pk2(float lo, float hi) { return f2bf(lo) | (f2bf(hi) << 16); }
DEV unsigned pk4_fp8(float a, float b, float c, float d) { int w = __builtin_amdgcn_cvt_pk_fp8_f32(a, b, 0, false); w = __builtin_amdgcn_cvt_pk_fp8_f32(c, d, w, true); return (unsigned)w; }
DEV unsigned pg8_cvt(float lo, float hi) { unsigned r; asm volatile("v_cvt_pk_bf16_f32 %0, %1, %2" : "=v"(r) : "v"(lo), "v"(hi)); return r; }
DEV float bf2f(unsigned b) { return __builtin_bit_cast(float, b << 16); }
DEV float bflo(unsigned w) { return __builtin_bit_cast(float, w << 16); }
DEV float bfhi(unsigned w) { return __builtin_bit_cast(float, w & 0xffff0000u); }
DEV float fexp2(float x) { return __builtin_amdgcn_exp2f(x); }
DEV float frcp(float x) { return __builtin_amdgcn_rcpf(x); }
DEV float sigmoidf_(float x) { return frcp(1.0f + fexp2(-x * LOG2E)); }
DEV float gelu_tanh(float x) { const float u = 1.5957691216057308f * (x + 0.044715f * x * x * x); return x * frcp(1.0f + fexp2(-u * LOG2E)); }
DEV float swiglu(float a, float b) { a = fminf(a, 7.0f); b = fminf(fmaxf(b, -7.0f), 7.0f); return (b + 1.0f) * (a * sigmoidf_(1.702f * a)); }
DEV float wave_sum(float v) {
#pragma unroll
    for (int o = 1; o < 64; o <<= 1) v += __shfl_xor(v, o);
    return v;
}
DEV float wave_max(float v) {
#pragma unroll
    for (int o = 1; o < 64; o <<= 1) v = fmaxf(v, __shfl_xor(v, o));
    return v;
}
DEV int crow(int reg, int h) { return (reg & 3) + 8 * (reg >> 2) + 4 * h; }

struct Frame { LAS unsigned char* lds; int tid, lane, wave, vcu, G, gw, NGW; };

#define XB_TMO      128
#define XB_XCNT(j)  (256  + 64 * (j))
#define XB_XSUB(j)  (1280 + 64 * (j))
#define XB_XGEN(j)  (2304 + 64 * (j))
#define XB_TOP      3328
#define XB_TOPGEN   3392
#define XCD_BAR_WORDS 3456
#define XB_SPIN_CAP (1u << 18)
DEV unsigned xb_ld(unsigned* p)              { return __hip_atomic_load(p, __ATOMIC_RELAXED, __HIP_MEMORY_SCOPE_AGENT); }
DEV unsigned xb_add(unsigned* p, unsigned v) { return __hip_atomic_fetch_add(p, v, __ATOMIC_RELAXED, __HIP_MEMORY_SCOPE_AGENT); }
DEV unsigned xb_xcc_id() { return (unsigned)__builtin_amdgcn_s_getreg((3 << 11) | 20) & 0xFu; }
#define XB_SPIN(cond, bar) do { unsigned _sp = 0; while (cond) { __builtin_amdgcn_s_sleep(1); \
    if ((++_sp & 255u) == 0u) { if (xb_ld(&(bar)[XB_TMO])) break; if (_sp > XB_SPIN_CAP) { atomicAdd(&(bar)[XB_TMO], 1u); break; } } } } while (0)
struct XcdBarrier { unsigned* bar; unsigned x; volatile LAS unsigned* st; };
DEV XcdBarrier xcd_barrier_post(unsigned* bar, volatile LAS unsigned* st) {
    XcdBarrier b; b.bar = bar; b.x = xb_xcc_id(); b.st = st;
    if (threadIdx.x == 0) (void)xb_add(&bar[XB_XCNT(b.x)], 1u);
    return b;
}
DEV void xcd_barrier_complete(unsigned* bar, unsigned x, unsigned& nloc, unsigned& nx) {
    const unsigned G = gridDim.x * gridDim.y * gridDim.z;
    unsigned sum, cnt, mine, sp = 0u;
    for (;;) {
        sum = 0u; cnt = 0u; mine = 0u;
#pragma unroll
        for (unsigned j = 0; j < 16; ++j) { const unsigned c = xb_ld(&bar[XB_XCNT(j)]); sum += c; cnt += (c > 0u) ? 1u : 0u; mine = (j == x) ? c : mine; }
        if (sum == G) break;
        __builtin_amdgcn_s_sleep(1);
        if ((++sp & 255u) == 0u) { if (xb_ld(&bar[XB_TMO])) break; if (sp > XB_SPIN_CAP) { atomicAdd(&bar[XB_TMO], 1u); break; } }
    }
    nloc = mine > 0u ? mine : 1u; nx = cnt > 0u ? cnt : 1u;
}
DEV void xcd_barrier(const XcdBarrier& b) {
    asm volatile("s_waitcnt vmcnt(0)" ::: "memory");
    __syncthreads();
    if (threadIdx.x == 0) {
        unsigned* bar = b.bar;
        __builtin_amdgcn_s_waitcnt(0);
        unsigned nloc = b.st[0], nx = b.st[1];
        if (nloc == 0u) { xcd_barrier_complete(bar, b.x, nloc, nx); b.st[0] = nloc; b.st[1] = nx; }
        const unsigned old = xb_add(&bar[XB_XSUB(b.x)], 1u);
        const unsigned gen = old / nloc;
        if (old + 1u == (gen + 1u) * nloc) {
            __builtin_amdgcn_fence(__ATOMIC_RELEASE, "agent");
            asm volatile("s_waitcnt vmcnt(0)" ::: "memory");
            const unsigned og = xb_add(&bar[XB_TOP], 1u);
            const unsigned tg = og / nx;
            if (og + 1u == (tg + 1u) * nx) xb_add(&bar[XB_TOPGEN], 1u);
            else XB_SPIN(xb_ld(&bar[XB_TOPGEN]) == tg, bar);
            __builtin_amdgcn_fence(__ATOMIC_ACQUIRE, "agent");
            xb_add(&bar[XB_XGEN(b.x)], 1u);
            asm volatile("s_waitcnt vmcnt(0)" ::: "memory");
        } else {
            XB_SPIN(xb_ld(&bar[XB_XGEN(b.x)]) == gen, bar);
            __builtin_amdgcn_fence(__ATOMIC_ACQUIRE, "agent");
            asm volatile("s_waitcnt vmcnt(0)" ::: "memory");
        }
    }
    __syncthreads();
}

template <class Epi>
DEV void ngemm_wave(const bf16* A, int lda, const bf16* Bt, int ldb, int mtiles, int ntiles, int K, const Frame& F, const Epi& epi) {
    const int r = F.lane & 31, h = F.lane >> 5;
    const int total = mtiles * ntiles;
    for (int t = F.gw; t < total; t += F.NGW) {
        const int tm = t / ntiles, tn = t % ntiles;
        const bf16* ap = A + (size_t)(tm * 32 + r) * lda + 8 * h;
        const bf16* bp = Bt + (size_t)(tn * 32 + r) * ldb + 8 * h;
        f32x16 acc;
#pragma unroll
        for (int i = 0; i < 16; ++i) acc[i] = 0.f;
#pragma unroll 8
        for (int k0 = 0; k0 < K; k0 += 16) {
            const bf16x8 a = *(const bf16x8*)(ap + k0), b = *(const bf16x8*)(bp + k0);
            acc = __builtin_amdgcn_mfma_f32_32x32x16_bf16(a, b, acc, 0, 0, 0);
        }
#pragma unroll
        for (int i = 0; i < 16; ++i) epi(tm * 32 + crow(i, h), tn * 32 + r, acc[i]);
    }
}

DEV int maprow(int mode, int n0) { return mode == 0 ? n0 : (256 * (n0 >> 7) + (n0 & 127) + (mode == 2 ? 128 : 0)); }
DEV void transpose_item(const float* W, int K, int N, bf16* WT, int ldt, int koff, int mode, LAS float* scr, int item, int lane) {
    const int nblk = N / 32, kb = item / nblk, nb = item % nblk, k0 = 64 * kb, n0 = 32 * nb;
#pragma unroll 8
    for (int i = 0; i < 32; ++i) { const int kk = 2 * i + (lane >> 5); scr[kk * 33 + (lane & 31)] = W[(size_t)(k0 + kk) * N + n0 + (lane & 31)]; }
    asm volatile("s_waitcnt lgkmcnt(0)" ::: "memory");
    const int c = lane & 7; const int rbase = maprow(mode, n0);
#pragma unroll
    for (int j = 0; j < 4; ++j) { const int n = (lane >> 3) + 8 * j; const LAS float* s = scr + (8 * c) * 33 + n;
        u32x4 o; o.x = pk2(s[0 * 33], s[1 * 33]); o.y = pk2(s[2 * 33], s[3 * 33]); o.z = pk2(s[4 * 33], s[5 * 33]); o.w = pk2(s[6 * 33], s[7 * 33]);
        *(u32x4*)(WT + (size_t)(rbase + n) * ldt + koff + k0 + 8 * c) = o; }
    asm volatile("s_waitcnt lgkmcnt(0)" ::: "memory");
}
DEV void rms_row_to_bf16(const float* xrow, const float* g, bf16* orow, int lane) {
    const f32x4* xr = (const f32x4*)xrow + lane; const f32x4* gr = (const f32x4*)g + lane;
    f32x4 v[4]; float s = 0.f;
#pragma unroll
    for (int j = 0; j < 4; ++j) { v[j] = xr[64 * j]; s += (v[j].x * v[j].x + v[j].y * v[j].y) + (v[j].z * v[j].z + v[j].w * v[j].w); }
    const float rstd = 1.0f / sqrtf(wave_sum(s) * (1.f / D) + RMS_EPS);
    unsigned long long* o8 = (unsigned long long*)orow + lane;
#pragma unroll
    for (int j = 0; j < 4; ++j) { const f32x4 gg = gr[64 * j];
        o8[64 * j] = (unsigned long long)pk2(v[j].x * rstd * gg.x, v[j].y * rstd * gg.y) | ((unsigned long long)pk2(v[j].z * rstd * gg.z, v[j].w * rstd * gg.w) << 32); }
}
DEV void transpose_item_fp8(const float* W, int K, int N, unsigned char* WT, int ldt, int mode, LAS float* scr, int item, int lane) {
    const int nblk = N / 32, kb = item / nblk, nb = item % nblk, k0 = 64 * kb, n0 = 32 * nb;
#pragma unroll 8
    for (int i = 0; i < 32; ++i) { const int kk = 2 * i + (lane >> 5); scr[kk * 33 + (lane & 31)] = W[(size_t)(k0 + kk) * N + n0 + (lane & 31)]; }
    asm volatile("s_waitcnt lgkmcnt(0)" ::: "memory");
    const int c = lane & 7; const int rbase = maprow(mode, n0);
#pragma unroll
    for (int j = 0; j < 4; ++j) { const int n = (lane >> 3) + 8 * j; const LAS float* sp = scr + (8 * c) * 33 + n;
        u32x2 o; o.x = pk4_fp8(sp[0 * 33] * W8_SCALE, sp[1 * 33] * W8_SCALE, sp[2 * 33] * W8_SCALE, sp[3 * 33] * W8_SCALE); o.y = pk4_fp8(sp[4 * 33] * W8_SCALE, sp[5 * 33] * W8_SCALE, sp[6 * 33] * W8_SCALE, sp[7 * 33] * W8_SCALE);
        *(u32x2*)(WT + (size_t)(rbase + n) * ldt + k0 + 8 * c) = o; }
    asm volatile("s_waitcnt lgkmcnt(0)" ::: "memory");
}
DEV void phase_prologue(Frame& F, const Args& a) {
    unsigned char* ws = a.ws;
    LAS float* scr = (LAS float*)(F.lds + F.wave * 8448);
    bf16* Win_t = (bf16*)(ws + WS_WIN); bf16* Wab_t = (bf16*)(ws + WS_WAB); bf16* Wout_t = (bf16*)(ws + WS_WOUT); bf16* Wpg_t = (bf16*)(ws + WS_WPG);
    bf16* Wpp_t = (bf16*)(ws + WS_WPP); bf16* Wsp = (bf16*)(ws + WS_WSP); bf16* Wd_t = (bf16*)(ws + WS_WD); bf16* Wgu_t = (bf16*)(ws + WS_WGU);
    constexpr int I0 = 16 * 120, I1 = 8 * 32, I2 = 8 * 32, I3 = 16 * 32, I4 = 16 * 32, I5 = 4 * 32, IE = 512, NITEMS = I0 + I1 + I2 + I3 + I4 + I5 + NE * 3 * IE;
    for (int it = F.gw; it < NITEMS; it += F.NGW) {
        int r = it;
        if (r < I0) { transpose_item(a.in[3], D, NZ, Win_t, D, 0, 0, scr, r, F.lane); continue; } r -= I0;
        if (r < I1) { transpose_item(a.in[9], 512, D, Wab_t, D, 0, 0, scr, r, F.lane); continue; } r -= I1;
        if (r < I2) { transpose_item(a.in[10], 512, D, Wab_t, D, 512, 0, scr, r, F.lane); continue; } r -= I2;
        if (r < I3) { transpose_item(a.in[11], D, D, Wout_t, D, 0, 0, scr, r, F.lane); continue; } r -= I3;
#if FP8_MOE
        if (r < I4) { transpose_item_fp8(a.in[22], D, D, ws + WS_WPG8, D, 0, scr, r, F.lane); continue; } r -= I4;
#else
        if (r < I4) { transpose_item(a.in[22], D, D, Wpg_t, D, 0, 0, scr, r, F.lane); continue; } r -= I4;
#endif
        if (r < I5) { transpose_item(a.in[23], PLE, D, Wpp_t, PLE, 0, 0, scr, r, F.lane); continue; } r -= I5;
        const int e = r / (3 * IE), q = r % (3 * IE), kind = q / IE, item = q % IE;
#if FP8_MOE
        unsigned char* Wgu8 = ws + WS_WGU8; unsigned char* Wd8 = ws + WS_WD8;
        if (kind == 0) transpose_item_fp8(a.in[15] + (size_t)e * D * FF, D, FF, Wgu8 + (size_t)e * 2048 * D, D, 1, scr, item, F.lane);
        else if (kind == 1) transpose_item_fp8(a.in[17] + (size_t)e * D * FF, D, FF, Wgu8 + (size_t)e * 2048 * D, D, 2, scr, item, F.lane);
        else transpose_item_fp8(a.in[19] + (size_t)e * FF * D, FF, D, Wd8 + (size_t)e * D * FF, FF, 0, scr, item, F.lane);
#else
        if (kind == 0) transpose_item(a.in[15] + (size_t)e * D * FF, D, FF, Wgu_t + (size_t)e * 2048 * D, D, 0, 1, scr, item, F.lane);
        else if (kind == 1) transpose_item(a.in[17] + (size_t)e * D * FF, D, FF, Wgu_t + (size_t)e * 2048 * D, D, 0, 2, scr, item, F.lane);
        else transpose_item(a.in[19] + (size_t)e * FF * D, FF, D, Wd_t + (size_t)e * D * FF, FF, 0, 0, scr, item, F.lane);
#endif
    }
    { bf16* wh = (bf16*)(ws + WS_WRH); bf16* wl = (bf16*)(ws + WS_WRL);
      for (int i = F.vcu * NTHREADS + F.tid; i < D * NE; i += F.G * NTHREADS) { const int d = i >> 5, e = i & 31; const float w = a.in[13][i]; const unsigned hb = f2bf(w);
          wh[e * D + d] = (bf16)hb; wl[e * D + d] = (bf16)f2bf(w - bf2f(hb)); } }
    for (int i = F.vcu * NTHREADS + F.tid; i < 4 * 128 * 128; i += F.G * NTHREADS) { const int s = i & 127, t = (i >> 7) & 127; Wsp[i] = (bf16)f2bf(s <= t ? a.in[7][i] : 0.f); }
    bf16* Hb = (bf16*)a.out; bf16* PB = (bf16*)(ws + WS_PB);
    for (int m = F.gw; m < T; m += F.NGW) {
        rms_row_to_bf16(a.in[0] + (size_t)m * D, a.in[2], Hb + (size_t)m * D, F.lane);
#if !FP8_MOE
        const f32x4 pv = *((const f32x4*)(a.in[1] + (size_t)m * PLE) + F.lane);
        *((u32x2*)(PB + (size_t)m * PLE) + F.lane) = (u32x2){pk2(pv.x, pv.y), pk2(pv.z, pv.w)};
#endif
    }
}

struct EpiZ { bf16* Z1; bf16* Z2;
    DEV void operator()(int row, int col, float v) const {
        if (col < 512) Z1[(size_t)row * Z1W + col] = (bf16)f2bf(v * QSCALE);
        else if (col < 768) Z1[(size_t)row * Z1W + col] = (bf16)f2bf(v);
        else if (col < Z1W) Z1[(size_t)row * Z1W + col] = (bf16)f2bf(gelu_tanh(v));
        else Z2[(size_t)row * Z2W + (col - Z1W)] = (bf16)f2bf(sigmoidf_(v));
    } };

DEV void phase_lnstats(Frame& F, const Args& a) {
    const bf16* Z1 = (const bf16*)(a.ws + WS_Z1); float2* st = (float2*)(a.ws + WS_STATS);
    for (int m = F.gw; m < T; m += F.NGW) {
        const u32x4 w = *((const u32x4*)(Z1 + (size_t)m * Z1W + 1280) + F.lane);
        float v[8] = {bflo(w.x), bfhi(w.x), bflo(w.y), bfhi(w.y), bflo(w.z), bfhi(w.z), bflo(w.w), bfhi(w.w)};
        float s = 0.f;
#pragma unroll
        for (int j = 0; j < 8; ++j) s += v[j];
        const float mean = wave_sum(s) * (1.f / 512.f); float q = 0.f;
#pragma unroll
        for (int j = 0; j < 8; ++j) { const float d = v[j] - mean; q += d * d; }
        const float rstd = 1.0f / sqrtf(wave_sum(q) * (1.f / 512.f) + LN_EPS);
        if (F.lane == 0) st[m] = make_float2(mean, rstd);
    }
}

DEV void phase_mixers_ref(Frame& F, const Args& a) {
    const bf16* Z1 = (const bf16*)(a.ws + WS_Z1); bf16* AP = (bf16*)(a.ws + WS_AP);
    const float* sinks = a.in[4];
    const int gid = F.vcu * NTHREADS + F.tid, nthr = F.G * NTHREADS;
    for (int item = gid; item < T * 8; item += nthr) {
        const int hh = item / T, m = item % T, b = m / SEQ, t = m % SEQ, kvh = hh >> 2;
        const float slope2 = fexp2(-(float)(hh + 1)) * LOG2E, sink2 = sinks[hh] * LOG2E;
        float q[64], o[64];
        const u32x4* qp = (const u32x4*)(Z1 + (size_t)m * Z1W + hh * 64);
#pragma unroll
        for (int c = 0; c < 8; ++c) { const u32x4 w = qp[c]; q[8 * c] = bflo(w.x); q[8 * c + 1] = bfhi(w.x); q[8 * c + 2] = bflo(w.y); q[8 * c + 3] = bfhi(w.y); q[8 * c + 4] = bflo(w.z); q[8 * c + 5] = bfhi(w.z); q[8 * c + 6] = bflo(w.w); q[8 * c + 7] = bfhi(w.w); }
#pragma unroll
        for (int d = 0; d < 64; ++d) o[d] = 0.f;
        float mrun = sink2, l = 1.0f;
        const int s0 = t - 127 < 0 ? 0 : t - 127;
        for (int s = s0; s <= t; ++s) {
            const bf16* krow = Z1 + (size_t)(b * SEQ + s) * Z1W + 512 + kvh * 64; const bf16* vrow = krow + 128;
            float dot = 0.f;
#pragma unroll
            for (int c = 0; c < 8; ++c) { const u32x4 w = ((const u32x4*)krow)[c];
                dot += q[8 * c] * bflo(w.x) + q[8 * c + 1] * bfhi(w.x) + q[8 * c + 2] * bflo(w.y) + q[8 * c + 3] * bfhi(w.y) + q[8 * c + 4] * bflo(w.z) + q[8 * c + 5] * bfhi(w.z) + q[8 * c + 6] * bflo(w.w) + q[8 * c + 7] * bfhi(w.w); }
            const float sc = dot - slope2 * (float)(t - s);
            const float mnew = fmaxf(mrun, sc), alpha = fexp2(mrun - mnew), p = fexp2(sc - mnew);
            l = l * alpha + p; mrun = mnew;
#pragma unroll
            for (int c = 0; c < 8; ++c) { const u32x4 w = ((const u32x4*)vrow)[c];
                o[8 * c] = o[8 * c] * alpha + p * bflo(w.x); o[8 * c + 1] = o[8 * c + 1] * alpha + p * bfhi(w.x); o[8 * c + 2] = o[8 * c + 2] * alpha + p * bflo(w.y); o[8 * c + 3] = o[8 * c + 3] * alpha + p * bfhi(w.y);
                o[8 * c + 4] = o[8 * c + 4] * alpha + p * bflo(w.z); o[8 * c + 5] = o[8 * c + 5] * alpha + p * bfhi(w.z); o[8 * c + 6] = o[8 * c + 6] * alpha + p * bflo(w.w); o[8 * c + 7] = o[8 * c + 7] * alpha + p * bfhi(w.w); }
        }
        const float il = 1.0f / l;
        u32x4* op = (u32x4*)(AP + (size_t)m * D + hh * 64);
#pragma unroll
        for (int c = 0; c < 8; ++c) op[c] = (u32x4){pk2(o[8 * c] * il, o[8 * c + 1] * il), pk2(o[8 * c + 2] * il, o[8 * c + 3] * il), pk2(o[8 * c + 4] * il, o[8 * c + 5] * il), pk2(o[8 * c + 6] * il, o[8 * c + 7] * il)};
    }
    const bf16* Wsp = (const bf16*)(a.ws + WS_WSP); const float2* st = (const float2*)(a.ws + WS_STATS);
    const float* g_ln = a.in[5]; const float* b_ln = a.in[6]; const float* b_sp = a.in[8];
    for (int item = gid; item < T * 512; item += nthr) {
        const int m = item >> 9, c = item & 511, g = c >> 7, t = m & 127, m0 = m - t;
        const float gl = g_ln[c], bl = b_ln[c];
        const bf16* wrow = Wsp + ((size_t)g * 128 + t) * 128;
        float acc = 0.f;
        for (int s = 0; s <= t; ++s) {
            const float2 ms = st[m0 + s];
            const float vn = (bf2f(Z1[(size_t)(m0 + s) * Z1W + 1280 + c]) - ms.x) * ms.y * gl + bl;
            acc += bf2f(wrow[s]) * vn;
        }
        const float u = bf2f(Z1[(size_t)m * Z1W + 768 + c]);
        AP[(size_t)m * D + 512 + c] = (bf16)f2bf(u * (acc + b_sp[g * 128 + t]));
    }
}

struct EpiProjA { const bf16* Z2; bf16* TMP;
    DEV void operator()(int row, int col, float v) const { TMP[(size_t)row * D + col] = (bf16)f2bf(bf2f(Z2[(size_t)row * Z2W + col]) * v); } };
struct EpiProjB { const bf16* Z2; const bf16* TMP; bf16* MRG;
    DEV void operator()(int row, int col, float v) const { MRG[(size_t)row * D + col] = (bf16)f2bf(bf2f(TMP[(size_t)row * D + col]) + bf2f(Z2[(size_t)row * Z2W + 1024 + col]) * v); } };
struct EpiResid { const float* base; float* out;
    DEV void operator()(int row, int col, float v) const { out[(size_t)row * D + col] = base[(size_t)row * D + col] + v; } };

DEV void phase_router(Frame& F, const Args& a) {
    const float* x1 = a.out; const float* g_ffn = a.in[12]; const float* w_router = a.in[13]; const float* b_router = a.in[14];
    bf16* H2 = (bf16*)(a.ws + WS_H2); unsigned* gcount = (unsigned*)(a.ws + WS_CTL) + CW_GCOUNT; int* list = (int*)(a.ws + WS_LIST); u32x2* info = (u32x2*)(a.ws + WS_INFO);
    LAS float* wt = (LAS float*)F.lds;
    LAS unsigned* lcount = (LAS unsigned*)(F.lds + 131584);
    LAS unsigned* gbase = lcount + 32;
    LAS unsigned* rec = gbase + 32;
    const int lane = F.lane;
    for (int i = F.tid; i < D * NE; i += NTHREADS) { const int d = i >> 5, e = i & 31; wt[e * 1028 + d] = w_router[i]; }
    f32x4 gg[4];
#pragma unroll
    for (int j = 0; j < 4; ++j) gg[j] = *((const f32x4*)g_ffn + lane + 64 * j);
    const int my_e = lane >> 1; const float my_bias = b_router[my_e];
    for (int blk = F.vcu; blk < T / 128; blk += F.G) {
        if (F.tid < 32) lcount[F.tid] = 0u;
        __syncthreads();
        for (int rr = 0; rr < 16; ++rr) {
            const int rl = F.wave * 16 + rr, m = blk * 128 + rl;
            const f32x4* xr = (const f32x4*)(x1 + (size_t)m * D) + lane;
            f32x4 v[4]; float s = 0.f;
#pragma unroll
            for (int j = 0; j < 4; ++j) { v[j] = xr[64 * j]; s += (v[j].x * v[j].x + v[j].y * v[j].y) + (v[j].z * v[j].z + v[j].w * v[j].w); }
            const float rstd = 1.0f / sqrtf(wave_sum(s) * (1.f / D) + RMS_EPS);
#pragma unroll
            for (int j = 0; j < 4; ++j) v[j] = v[j] * rstd * gg[j];
            unsigned long long* o8 = (unsigned long long*)(H2 + (size_t)m * D) + lane;
#pragma unroll
            for (int j = 0; j < 4; ++j) o8[64 * j] = (unsigned long long)pk2(v[j].x, v[j].y) | ((unsigned long long)pk2(v[j].z, v[j].w) << 32);
            float part[32];
#pragma unroll
            for (int e = 0; e < 32; ++e) { float acc = 0.f;
#pragma unroll
                for (int j = 0; j < 4; ++j) { const f32x4 w = *(const LAS f32x4*)(wt + e * 1028 + 4 * lane + 256 * j); acc += (v[j].x * w.x + v[j].y * w.y) + (v[j].z * w.z + v[j].w * w.w); }
                part[e] = acc; }
#define TR_STEP(N, BIT, XM) { const bool hb = (lane >> BIT) & 1; _Pragma("unroll") for (int i = 0; i < N; ++i) { const float keep = hb ? part[i + N] : part[i]; const float send = hb ? part[i] : part[i + N]; part[i] = keep + __shfl_xor(send, XM); } }
            TR_STEP(16, 5, 32) TR_STEP(8, 4, 16) TR_STEP(4, 3, 8) TR_STEP(2, 2, 4) TR_STEP(1, 1, 2)
#undef TR_STEP
            float val = part[0] + __shfl_xor(part[0], 1) + my_bias;
            float topv[4]; int tope[4];
#pragma unroll
            for (int k = 0; k < 4; ++k) { const float mx = wave_max(val); const unsigned long long bal = __ballot(val == mx); const int src = __ffsll((long long)bal) - 1; const int ek = src >> 1;
                topv[k] = mx; tope[k] = ek; if (my_e == ek) val = -INFINITY; }
            const float e1 = __expf(topv[1] - topv[0]), e2 = __expf(topv[2] - topv[0]), e3 = __expf(topv[3] - topv[0]);
            const float inv = 1.0f / (1.0f + e1 + e2 + e3);
            if (lane < 4) {
                const int ek = lane == 0 ? tope[0] : lane == 1 ? tope[1] : lane == 2 ? tope[2] : tope[3];
                const float gk = (lane == 0 ? 1.0f : lane == 1 ? e1 : lane == 2 ? e2 : e3) * inv;
                const unsigned pos = atomicAdd((unsigned*)(lcount + ek), 1u);
                rec[(rl * 4 + lane) * 2] = (unsigned)ek | (pos << 8); rec[(rl * 4 + lane) * 2 + 1] = __builtin_bit_cast(unsigned, gk);
            }
        }
        __syncthreads();
        if (F.tid < 32) gbase[F.tid] = atomicAdd(gcount + F.tid, lcount[F.tid]);
        __syncthreads();
        { const int rl = F.tid >> 2, k = F.tid & 3, m = blk * 128 + rl; const unsigned w0 = rec[F.tid * 2], w1 = rec[F.tid * 2 + 1];
          const unsigned ek = w0 & 255u, gpos = gbase[ek] + (w0 >> 8);
          list[(size_t)ek * T + gpos] = m; info[(size_t)m * 4 + k] = (u32x2){ek | (gpos << 5), w1}; }
        __syncthreads();
    }
}


DEV void phase_router2(Frame& F, const Args& a) {
    const float* x1 = a.out; const float* g_ffn = a.in[12]; const float* b_router = a.in[14];
    bf16* H2 = (bf16*)(a.ws + WS_H2); unsigned* gcount = (unsigned*)(a.ws + WS_CTL) + CW_GCOUNT; int* list = (int*)(a.ws + WS_LIST); u32x2* info = (u32x2*)(a.ws + WS_INFO);
    float* rstd_g = (float*)(a.ws + WS_RSTD); float* srs = (float*)(a.ws + (FP8_MOE ? WS_SRS8 : WS_SRS2));
    LAS unsigned char* WRh = F.lds;
    LAS unsigned char* WRl = F.lds + 66048;
    LAS float* lg = (LAS float*)F.lds;
    LAS float* rs = (LAS float*)(F.lds + 132096);
    LAS unsigned* lcount = (LAS unsigned*)(F.lds + 132096 + 512);
    LAS unsigned* gbase = lcount + 32;
    LAS unsigned* rec = gbase + 32;
    const int lane = F.lane, wave = F.wave, fr = lane & 15, kq = lane >> 4;
    for (int blk = F.vcu; blk < T / 128; blk += F.G) {
        __syncthreads();
        { const bf16* wh = (const bf16*)(a.ws + WS_WRH); const bf16* wl = (const bf16*)(a.ws + WS_WRL);
          for (int i = F.tid; i < 32 * 128; i += NTHREADS) { const int e = i >> 7, c = i & 127;
              *(LAS u32x4*)(WRh + e * 2064 + c * 16) = *(const u32x4*)(wh + e * 1024 + c * 8); *(LAS u32x4*)(WRl + e * 2064 + c * 16) = *(const u32x4*)(wl + e * 1024 + c * 8); } }
        if (F.tid < 32) lcount[F.tid] = 0u;
        __syncthreads();
        const int row = blk * 128 + wave * 16 + fr;
        const float* xp = x1 + (size_t)row * D + 8 * kq; const float* gp = g_ffn + 8 * kq; bf16* hp = H2 + (size_t)row * D + 8 * kq; unsigned char* h8 = a.ws + WS_H2Q + (size_t)row * D + 8 * kq; (void)hp; (void)h8;
        f32x4 acc0 = (f32x4){0.f, 0.f, 0.f, 0.f}, acc1 = acc0; float ss = 0.f;
#pragma unroll 4
        for (int k0 = 0; k0 < D; k0 += 32) {
            const f32x4 xa = *(const f32x4*)(xp + k0), xb = *(const f32x4*)(xp + k0 + 4), ga = *(const f32x4*)(gp + k0), gb = *(const f32x4*)(gp + k0 + 4);
            ss += (xa.x * xa.x + xa.y * xa.y) + (xa.z * xa.z + xa.w * xa.w) + (xb.x * xb.x + xb.y * xb.y) + (xb.z * xb.z + xb.w * xb.w);
            const f32x4 pa = xa * ga, pb = xb * gb;
            u32x4 hw; hw.x = pk2(pa.x, pa.y); hw.y = pk2(pa.z, pa.w); hw.z = pk2(pb.x, pb.y); hw.w = pk2(pb.z, pb.w);
#if FP8_MOE
            *(u32x2*)(h8 + k0) = (u32x2){pk4_fp8(pa.x, pa.y, pa.z, pa.w), pk4_fp8(pb.x, pb.y, pb.z, pb.w)};
#else
            *(u32x4*)(hp + k0) = hw;
#endif
            u32x4 lw; lw.x = pk2(pa.x - bflo(hw.x), pa.y - bfhi(hw.x)); lw.y = pk2(pa.z - bflo(hw.y), pa.w - bfhi(hw.y)); lw.z = pk2(pb.x - bflo(hw.z), pb.y - bfhi(hw.z)); lw.w = pk2(pb.z - bflo(hw.w), pb.w - bfhi(hw.w));
            const bf16x8 ah = __builtin_bit_cast(bf16x8, hw), al = __builtin_bit_cast(bf16x8, lw);
            const LAS unsigned char* bh = WRh + fr * 2064 + (k0 + 8 * kq) * 2; const LAS unsigned char* bl = WRl + fr * 2064 + (k0 + 8 * kq) * 2;
            const bf16x8 bh0 = *(const LAS bf16x8*)bh, bh1 = *(const LAS bf16x8*)(bh + 16 * 2064), bl0 = *(const LAS bf16x8*)bl, bl1 = *(const LAS bf16x8*)(bl + 16 * 2064);
            acc0 = __builtin_amdgcn_mfma_f32_16x16x32_bf16(ah, bh0, acc0, 0, 0, 0); acc1 = __builtin_amdgcn_mfma_f32_16x16x32_bf16(ah, bh1, acc1, 0, 0, 0);
            acc0 = __builtin_amdgcn_mfma_f32_16x16x32_bf16(ah, bl0, acc0, 0, 0, 0); acc1 = __builtin_amdgcn_mfma_f32_16x16x32_bf16(ah, bl1, acc1, 0, 0, 0);
            acc0 = __builtin_amdgcn_mfma_f32_16x16x32_bf16(al, bh0, acc0, 0, 0, 0); acc1 = __builtin_amdgcn_mfma_f32_16x16x32_bf16(al, bh1, acc1, 0, 0, 0);
        }
        ss += __shfl_xor(ss, 16); ss += __shfl_xor(ss, 32);
        const float rstd = 1.0f / sqrtf(ss * (1.f / D) + RMS_EPS);
        if (kq == 0) { rs[wave * 16 + fr] = rstd; rstd_g[row] = rstd; }
        __syncthreads();
        { const float b0 = b_router[fr], b1 = b_router[16 + fr];
#pragma unroll
          for (int i = 0; i < 4; ++i) { const int rl = wave * 16 + 4 * kq + i; const float r_ = rs[rl]; lg[rl * 33 + fr] = acc0[i] * r_ + b0; lg[rl * 33 + 16 + fr] = acc1[i] * r_ + b1; } }
        __syncthreads();
        if (F.tid < 128) {
            const int rl = F.tid; float v[32];
#pragma unroll
            for (int e = 0; e < 32; ++e) v[e] = lg[rl * 33 + e];
            float topv[4]; int tope[4];
#pragma unroll
            for (int k = 0; k < 4; ++k) { float mx = v[0]; int mi = 0;
#pragma unroll
                for (int e = 1; e < 32; ++e) { const bool gt = v[e] > mx; mx = gt ? v[e] : mx; mi = gt ? e : mi; }
                topv[k] = mx; tope[k] = mi;
#pragma unroll
                for (int e = 0; e < 32; ++e) v[e] = (e == mi) ? -INFINITY : v[e]; }
            const float e1 = __expf(topv[1] - topv[0]), e2 = __expf(topv[2] - topv[0]), e3 = __expf(topv[3] - topv[0]);
            const float inv = 1.0f / (1.0f + e1 + e2 + e3);
            const float gk[4] = {inv, e1 * inv, e2 * inv, e3 * inv};
#pragma unroll
            for (int k = 0; k < 4; ++k) { const unsigned pos = atomicAdd((unsigned*)(lcount + tope[k]), 1u);
                rec[(rl * 4 + k) * 2] = (unsigned)tope[k] | (pos << 8); rec[(rl * 4 + k) * 2 + 1] = __float_as_uint(gk[k]); }
        }
        __syncthreads();
        if (F.tid < 32) gbase[F.tid] = atomicAdd(gcount + F.tid, lcount[F.tid]);
        __syncthreads();
        { const int rl = F.tid >> 2, k = F.tid & 3, m = blk * 128 + rl; const unsigned w0 = rec[F.tid * 2], w1 = rec[F.tid * 2 + 1];
          const unsigned ek = w0 & 255u, gpos = gbase[ek] + (w0 >> 8);
          list[(size_t)ek * T + gpos] = m; srs[(size_t)ek * T + gpos] = rs[rl]; info[(size_t)m * 4 + k] = (u32x2){ek | (gpos << 5), w1}; }
    }
    __syncthreads();
}

DEV void moe_layout(Frame& F, const Args& a) {
    volatile LAS int* L = (volatile LAS int*)(F.lds + LDS_CTL);
    if (F.tid == 0) {
        unsigned* gcount = (unsigned*)(a.ws + WS_CTL) + CW_GCOUNT; int st = 0;
        for (int e = 0; e < NE; ++e) { const int c = (int)__hip_atomic_load(gcount + e, __ATOMIC_RELAXED, __HIP_MEMORY_SCOPE_AGENT); L[LC_CNT + e] = c; L[LC_START + e] = st; st += (c + 255) & ~255; }
        L[LC_START + NE] = st; L[LC_TOTAL] = st;
        int sp = 0; while (sp < NE && 2 * L[LC_START + sp] < st) ++sp;
        L[LC_SPLIT] = sp;
    }
    __syncthreads();
}

DEV void phase_moe_up_ref(Frame& F, const Args& a) {
    moe_layout(F, a);
    volatile LAS int* L = (volatile LAS int*)(F.lds + LDS_CTL);
    const bf16* H2 = (const bf16*)(a.ws + WS_H2); const bf16* Wgu_t = (const bf16*)(a.ws + WS_WGU); bf16* ACT = (bf16*)(a.ws + WS_ACT); const int* list = (const int*)(a.ws + WS_LIST);
    const float* b_gate = a.in[16]; const float* b_up = a.in[18];
    const int r = F.lane & 31, h = F.lane >> 5, total = L[LC_TOTAL];
    const int items = (total / 32) * 32;
    for (int it = F.gw; it < items; it += F.NGW) {
        const int rt = it >> 5, ft = it & 31, s0 = rt * 32, f0 = ft * 32;
        int e = 0; while (e < NE - 1 && s0 >= L[LC_START + e + 1]) ++e;
        const int local = s0 + r - L[LC_START + e];
        const int tok = local < L[LC_CNT + e] ? list[(size_t)e * T + local] : 0;
        const bf16* ap = H2 + (size_t)tok * D + 8 * h;
        const bf16* bg = Wgu_t + ((size_t)e * 2048 + 256 * (f0 >> 7) + (f0 & 127) + r) * D + 8 * h; const bf16* bu = bg + (size_t)128 * D;
        f32x16 acca, accb;
#pragma unroll
        for (int i = 0; i < 16; ++i) { acca[i] = 0.f; accb[i] = 0.f; }
#pragma unroll 4
        for (int k0 = 0; k0 < D; k0 += 16) { const bf16x8 av = *(const bf16x8*)(ap + k0);
            acca = __builtin_amdgcn_mfma_f32_32x32x16_bf16(av, *(const bf16x8*)(bg + k0), acca, 0, 0, 0);
            accb = __builtin_amdgcn_mfma_f32_32x32x16_bf16(av, *(const bf16x8*)(bu + k0), accb, 0, 0, 0); }
        const float bgv = b_gate[e * FF + f0 + r], buv = b_up[e * FF + f0 + r];
#pragma unroll
        for (int i = 0; i < 16; ++i) ACT[(size_t)(s0 + crow(i, h)) * FF + f0 + r] = (bf16)f2bf(swiglu(acca[i] + bgv, accb[i] + buv));
    }
}
DEV void phase_moe_down_ref(Frame& F, const Args& a, int half) {
    moe_layout(F, a);
    volatile LAS int* L = (volatile LAS int*)(F.lds + LDS_CTL);
    const bf16* ACT = (const bf16*)(a.ws + WS_ACT); const bf16* Wd_t = (const bf16*)(a.ws + WS_WD); const float* b_down = a.in[20];
    const int r = F.lane & 31, h = F.lane >> 5, total = L[LC_TOTAL], srow = L[LC_START + L[LC_SPLIT]];
    const int row_lo = half == 0 ? 0 : srow, row_hi = half == 0 ? srow : total;
    bf16* Y = half == 0 ? (bf16*)(a.ws + WS_Y0) : (bf16*)(a.ws + WS_Y1) - (size_t)srow * D;
    const int items = ((row_hi - row_lo) / 32) * 32;
    for (int it = F.gw; it < items; it += F.NGW) {
        const int rt = it >> 5, nt = it & 31, s0 = row_lo + rt * 32, n0 = nt * 32;
        int e = 0; while (e < NE - 1 && s0 >= L[LC_START + e + 1]) ++e;
        const bf16* ap = ACT + (size_t)(s0 + r) * FF + 8 * h;
        const bf16* bp = Wd_t + ((size_t)e * D + n0 + r) * FF + 8 * h;
        f32x16 acc;
#pragma unroll
        for (int i = 0; i < 16; ++i) acc[i] = 0.f;
#pragma unroll 8
        for (int k0 = 0; k0 < FF; k0 += 16) acc = __builtin_amdgcn_mfma_f32_32x32x16_bf16(*(const bf16x8*)(ap + k0), *(const bf16x8*)(bp + k0), acc, 0, 0, 0);
        const float bd = b_down[e * D + n0 + r];
#pragma unroll
        for (int i = 0; i < 16; ++i) Y[(size_t)(s0 + crow(i, h)) * D + n0 + r] = (bf16)f2bf(acc[i] + bd);
    }
}

DEV void phase_combine(Frame& F, const Args& a) {
    moe_layout(F, a);
    volatile LAS int* L = (volatile LAS int*)(F.lds + LDS_CTL);
    const int srow = L[LC_START + L[LC_SPLIT]];
#if FP8_MOE
    const bf16* Y0 = (const bf16*)(a.ws + WS_Y); const bf16* Y1 = Y0; bf16* HP = (bf16*)(a.ws + WS_HP8);
#else
    const bf16* Y0 = (const bf16*)(a.ws + WS_Y0); const bf16* Y1 = (const bf16*)(a.ws + WS_Y1) - (size_t)srow * D; bf16* HP = (bf16*)(a.ws + WS_HP);
#endif
    const u32x2* info = (const u32x2*)(a.ws + WS_INFO); const float* g_ple = a.in[21];
    const int lane = F.lane;
    for (int m = F.gw; m < T; m += F.NGW) {
        f32x4* xr = (f32x4*)(a.out + (size_t)m * D) + lane;
        f32x4 v[4];
#pragma unroll
        for (int j = 0; j < 4; ++j) v[j] = xr[64 * j];
#pragma unroll
        for (int k = 0; k < 4; ++k) { const u32x2 w = info[(size_t)m * 4 + k]; const int e = w.x & 31, gpos = (int)(w.x >> 5); const unsigned wy = w.y; const float g = __uint_as_float(wy);
            const int row = L[LC_START + e] + gpos; const bf16* yr = (row < srow ? Y0 : Y1) + (size_t)row * D;
#pragma unroll
            for (int j = 0; j < 4; ++j) { const u32x2 yw = *((const u32x2*)yr + lane + 64 * j);
                v[j].x += g * bflo(yw.x); v[j].y += g * bfhi(yw.x); v[j].z += g * bflo(yw.y); v[j].w += g * bfhi(yw.y); } }
        float s = 0.f;
#if FP8_MOE
        u32x2* x2b = (u32x2*)((bf16*)(a.ws + WS_X2B) + (size_t)m * D) + lane;
#pragma unroll
        for (int j = 0; j < 4; ++j) { x2b[64 * j] = (u32x2){pg8_cvt(v[j].x, v[j].y), pg8_cvt(v[j].z, v[j].w)}; s += (v[j].x * v[j].x + v[j].y * v[j].y) + (v[j].z * v[j].z + v[j].w * v[j].w); }
        const float rstd = 1.0f / sqrtf(wave_sum(s) * (1.f / D) + RMS_EPS);
        unsigned* o4 = (unsigned*)((unsigned char*)HP + (size_t)m * D) + lane;
#pragma unroll
        for (int j = 0; j < 4; ++j) { const f32x4 gg = *((const f32x4*)g_ple + lane + 64 * j);
            o4[64 * j] = pk4_fp8(v[j].x * rstd * gg.x, v[j].y * rstd * gg.y, v[j].z * rstd * gg.z, v[j].w * rstd * gg.w); }
#else
#pragma unroll
        for (int j = 0; j < 4; ++j) { xr[64 * j] = v[j]; s += (v[j].x * v[j].x + v[j].y * v[j].y) + (v[j].z * v[j].z + v[j].w * v[j].w); }
        const float rstd = 1.0f / sqrtf(wave_sum(s) * (1.f / D) + RMS_EPS);
        unsigned long long* o8 = (unsigned long long*)(HP + (size_t)m * D) + lane;
#pragma unroll
        for (int j = 0; j < 4; ++j) { const f32x4 gg = *((const f32x4*)g_ple + lane + 64 * j);
            o8[64 * j] = (unsigned long long)pk2(v[j].x * rstd * gg.x, v[j].y * rstd * gg.y) | ((unsigned long long)pk2(v[j].z * rstd * gg.z, v[j].w * rstd * gg.w) << 32); }
#endif
    }
}
struct EpiStoreBf16 { bf16* O; int ldc;
    DEV void operator()(int row, int col, float v) const { O[(size_t)row * ldc + col] = (bf16)f2bf(v); } };
struct EpiPle { const bf16* PP; float* out;
    DEV void operator()(int row, int col, float v) const { const size_t i = (size_t)row * D + col; out[i] = out[i] + sigmoidf_(v) * bf2f(PP[i]); } };

DEV void phase_final(Frame& F, const Args& a) {
    const float* g = a.in[24]; const int lane = F.lane;
    for (int m = F.gw; m < T; m += F.NGW) {
        f32x4* xr = (f32x4*)(a.out + (size_t)m * D) + lane;
        f32x4 v[4]; float s = 0.f;
#if FP8_MOE
        const u32x2* x3b = (const u32x2*)((const bf16*)(a.ws + WS_X3B) + (size_t)m * D) + lane;
#pragma unroll
        for (int j = 0; j < 4; ++j) { const u32x2 w = x3b[64 * j]; v[j] = (f32x4){bflo(w.x), bfhi(w.x), bflo(w.y), bfhi(w.y)}; s += (v[j].x * v[j].x + v[j].y * v[j].y) + (v[j].z * v[j].z + v[j].w * v[j].w); }
#else
#pragma unroll
        for (int j = 0; j < 4; ++j) { v[j] = xr[64 * j]; s += (v[j].x * v[j].x + v[j].y * v[j].y) + (v[j].z * v[j].z + v[j].w * v[j].w); }
#endif
        const float rstd = 1.0f / sqrtf(wave_sum(s) * (1.f / D) + RMS_EPS);
#pragma unroll
        for (int j = 0; j < 4; ++j) xr[64 * j] = v[j] * rstd * *((const f32x4*)g + lane + 64 * j);
    }
}


namespace pg8 {
constexpr int BM = 256, BK = 64, HALF = 128, HTB = HALF * BK * 2, STAGE_BYTES = 8 * HTB;
DEV int lds_byte(int r, int c) { const int st = (r >> 4) * 2 + (c >> 5), rr = r & 15, cc = c & 31, ob = rr * 64 + cc * 2; return st * 1024 + (ob ^ (((ob >> 9) & 1) << 5)); }
DEV void stage_rc(int b, int& R, int& C) { const int st = b / 1024, sb = b % 1024, swz = sb ^ (((sb >> 9) & 1) << 5); R = (st >> 1) * 16 + swz / 64; C = (st & 1) * 32 + (swz % 64) / 2; }
DEV int perm32(int rho) { const int n = rho >> 4, i = rho & 15; return 8 * (i >> 2) + 4 * n + (i & 3); }
struct Unit { int pm, pn, e, mt; };
DEV unsigned cvt_pk_bf16(float lo, float hi) { unsigned r; asm volatile("v_cvt_pk_bf16_f32 %0, %1, %2" : "=v"(r) : "v"(lo), "v"(hi)); return r; }

typedef int i32x8 __attribute__((ext_vector_type(8)));
template <class Epi, class Sched, bool GATHER, bool FP8 = false>
DEV void gemm_phase(LAS unsigned char* lds, const bf16* A, int lda, const bf16* Bt, int ldb, int K, const Sched& S, const Epi& E, const int* list, volatile LAS int* L) {
    const int tid = threadIdx.x, wid = __builtin_amdgcn_readfirstlane(tid >> 6), lane = tid & 63, wr = wid >> 2, wc = wid & 3, fr = lane & 15, fq = lane >> 4;
    const int nt = K / BK;
    unsigned voffA[2], voffB[2]; int RA[2], CA[2];
#pragma unroll
    for (int i = 0; i < 2; ++i) { int R, C; stage_rc(tid * 16 + i * 8192, R, C); const int Rb = Epi::PERM ? ((R & ~31) + perm32(R & 31)) : R;
        voffA[i] = (unsigned)(R * lda + C) * 2u; voffB[i] = (unsigned)(Rb * ldb + C) * 2u; RA[i] = R; CA[i] = C; }
    const size_t kstep = (size_t)(BK * 2);
    const size_t hstepA = (size_t)HALF * lda * 2, hstepB = (size_t)HALF * ldb * 2;
    const unsigned ldsw = (unsigned)wid * 1024u;
    const int aoff = lds_byte(wr * 64 + fr, fq * 8), boff = lds_byte(wc * 32 + fr, fq * 8);
#define PG8_SA(b, h) (((b) * 2 + (h)) * HTB)
#define PG8_SB(b, h) ((4 + (b) * 2 + (h)) * HTB)
#define PG8_STAGE(bufoff, gbase, voff) do { _Pragma("unroll") for (int _i = 0; _i < 2; ++_i) \
        __builtin_amdgcn_global_load_lds((const unsigned*)((const char*)(gbase) + (voff)[_i]), (LAS unsigned*)(lds + (bufoff) + ldsw + _i * 8192), 16, 0, 0); } while (0)
    const int aoff8 = lds_byte(wr * 64 + fr, fq * 16), boff8 = lds_byte(wc * 32 + fr, fq * 16);
#define PG8_LD8(p) __builtin_bit_cast(i32x8, __builtin_shufflevector(*(const LAS u32x4*)(p), *(const LAS u32x4*)((p) + 16), 0, 1, 2, 3, 4, 5, 6, 7))
#define PG8_LDA(dst, b, h) do { if constexpr (FP8) { _Pragma("unroll") for (int m = 0; m < 4; ++m) dst##8[m] = PG8_LD8(lds + PG8_SA(b, h) + aoff8 + m * 2048); } \
        else { _Pragma("unroll") for (int m = 0; m < 4; ++m) _Pragma("unroll") for (int k = 0; k < 2; ++k) dst[m][k] = *(const LAS bf16x8*)(lds + PG8_SA(b, h) + aoff + m * 2048 + k * 1024); } } while (0)
#define PG8_LDB(dst, b, h) do { if constexpr (FP8) { _Pragma("unroll") for (int n = 0; n < 2; ++n) dst##8[n] = PG8_LD8(lds + PG8_SB(b, h) + boff8 + n * 2048); } \
        else { _Pragma("unroll") for (int n = 0; n < 2; ++n) _Pragma("unroll") for (int k = 0; k < 2; ++k) dst[n][k] = *(const LAS bf16x8*)(lds + PG8_SB(b, h) + boff + n * 2048 + k * 1024); } } while (0)
#define PG8_MMA(ai, bj, At, Bt_) do { __builtin_amdgcn_s_setprio(1); _Pragma("unroll") for (int m = 0; m < 4; ++m) _Pragma("unroll") for (int n = 0; n < 2; ++n) { \
        if constexpr (FP8) { asm volatile("v_mfma_scale_f32_16x16x128_f8f6f4 %0, %1, %2, %0, %3, %3 op_sel_hi:[0,0,0]" : "+v"(acc[ai][bj][m][n]) : "v"(Bt_##8[n]), "v"(At##8[m]), "v"(scale1)); } \
        else { _Pragma("unroll") for (int k = 0; k < 2; ++k) acc[ai][bj][m][n] = __builtin_amdgcn_mfma_f32_16x16x32_bf16(Bt_[n][k], At[m][k], acc[ai][bj][m][n], 0, 0, 0); } } \
        __builtin_amdgcn_s_setprio(0); } while (0)
#define PG8_WAIT_V(n) asm volatile("s_waitcnt vmcnt(" #n ")" ::: "memory")
#define PG8_WAIT_L(n) asm volatile("s_waitcnt lgkmcnt(" #n ")" ::: "memory")
#define PG8_BAR __builtin_amdgcn_s_barrier()
#define PG8_SCHED __builtin_amdgcn_sched_barrier(0)
    unsigned aoc[2][2], aon[2][2];
#define PG8_GATHER_OFFS(dst, u) do { _Pragma("unroll") for (int _h = 0; _h < 2; ++_h) _Pragma("unroll") for (int _i = 0; _i < 2; ++_i) { \
        const int _idx = (u).mt * 256 + _h * HALF + RA[_i]; const int _tok = _idx < L[LC_CNT + (u).e] ? list[(size_t)(u).e * T + _idx] : 0; \
        dst[_h][_i] = (unsigned)(_tok * lda + CA[_i]) * 2u; } } while (0)
    Unit cur, nxt; int ui = 0;
    if (!S.next(0, cur)) return;
    f32x4 acc[2][2][4][2];
#pragma unroll
    for (int a = 0; a < 2; ++a)
#pragma unroll
        for (int b = 0; b < 2; ++b)
#pragma unroll
            for (int m = 0; m < 4; ++m)
#pragma unroll
                for (int n = 0; n < 2; ++n) acc[a][b][m][n] = (f32x4){0.f, 0.f, 0.f, 0.f};
    bf16x8 At[4][2], B0[2][2], B1[2][2]; i32x8 At8[4], B08[2], B18[2]; unsigned scale1 = 0x7F7F7F7Fu; asm volatile("" : "+v"(scale1));
    const char* cA; const char* cB = (const char*)Bt + S.brow(cur) * (size_t)ldb * 2 + S.koff(cur);
    if constexpr (GATHER) { cA = (const char*)A; PG8_GATHER_OFFS(aoc, cur); }
    else { cA = (const char*)A + (size_t)cur.pm * BM * lda * 2 + S.koff(cur);
#pragma unroll
        for (int i = 0; i < 2; ++i) { aoc[0][i] = voffA[i]; aoc[1][i] = voffA[i] + (unsigned)hstepA; } }
    PG8_STAGE(PG8_SB(0, 0), cB, voffB); PG8_STAGE(PG8_SB(0, 1), cB + hstepB, voffB); PG8_STAGE(PG8_SA(0, 0), cA, aoc[0]); PG8_STAGE(PG8_SA(0, 1), cA, aoc[1]);
    if (wr == 1) PG8_BAR;
    PG8_WAIT_V(2); PG8_BAR;
    PG8_STAGE(PG8_SB(1, 0), cB + kstep, voffB); PG8_STAGE(PG8_SA(1, 0), cA + kstep, aoc[0]); PG8_STAGE(PG8_SB(1, 1), cB + hstepB + kstep, voffB);
    PG8_WAIT_V(6); PG8_BAR;
    for (;;) {
        const bool has_next = S.next(ui + 1, nxt);
        const char* nA; const char* nB = has_next ? (const char*)Bt + S.brow(nxt) * (size_t)ldb * 2 + S.koff(nxt) : cB;
        if constexpr (GATHER) { nA = cA; if (has_next) PG8_GATHER_OFFS(aon, nxt); else {
#pragma unroll
            for (int h = 0; h < 2; ++h)
#pragma unroll
                for (int i = 0; i < 2; ++i) aon[h][i] = aoc[h][i]; } }
        else { nA = has_next ? (const char*)A + (size_t)nxt.pm * BM * lda * 2 + S.koff(nxt) : cA; }
#pragma unroll 1
        for (int t = 0; t < nt; t += 2) {
            const bool last = (t == nt - 2);
            const char* a1 = cA + (size_t)(t + 1) * kstep;
            const char* a2 = last ? nA : cA + (size_t)(t + 2) * kstep; const char* b2 = last ? nB : cB + (size_t)(t + 2) * kstep;
            const char* a3 = a2 + kstep; const char* b3 = b2 + kstep;
            unsigned ao2[2][2];
#pragma unroll
            for (int h = 0; h < 2; ++h)
#pragma unroll
                for (int i = 0; i < 2; ++i) ao2[h][i] = GATHER ? (last ? aon[h][i] : aoc[h][i]) : aoc[h][i];
            PG8_LDB(B0, 0, 0); PG8_LDB(B1, 0, 1); PG8_SCHED; PG8_LDA(At, 0, 0); PG8_STAGE(PG8_SA(1, 1), a1, aoc[1]);
            PG8_WAIT_V(8); PG8_WAIT_L(0); PG8_BAR; PG8_MMA(0, 0, At, B0); PG8_MMA(0, 1, At, B1); PG8_BAR; PG8_SCHED;
            PG8_LDA(At, 0, 1); PG8_STAGE(PG8_SB(0, 0), b2, voffB); PG8_STAGE(PG8_SB(0, 1), b2 + hstepB, voffB); PG8_STAGE(PG8_SA(0, 0), a2, ao2[0]);
            PG8_WAIT_V(8); PG8_WAIT_L(0); PG8_BAR; PG8_MMA(1, 0, At, B0); PG8_MMA(1, 1, At, B1); PG8_BAR; PG8_SCHED;
            PG8_LDB(B0, 1, 0); PG8_LDB(B1, 1, 1); PG8_SCHED; PG8_LDA(At, 1, 0); PG8_STAGE(PG8_SA(0, 1), a2, ao2[1]);
            PG8_WAIT_V(8); PG8_WAIT_L(0); PG8_BAR; PG8_MMA(0, 0, At, B0); PG8_MMA(0, 1, At, B1); PG8_BAR; PG8_SCHED;
            PG8_LDA(At, 1, 1); PG8_STAGE(PG8_SB(1, 0), b3, voffB); PG8_STAGE(PG8_SB(1, 1), b3 + hstepB, voffB); PG8_STAGE(PG8_SA(1, 0), a3, ao2[0]);
            PG8_WAIT_V(8); PG8_WAIT_L(0); PG8_BAR; PG8_MMA(1, 0, At, B0); PG8_MMA(1, 1, At, B1); PG8_BAR; PG8_SCHED;
        }
        if constexpr (FP8) asm volatile("s_nop 15\n\ts_nop 15" ::: "memory");
        if (wr == 0) PG8_BAR;
        E(acc, cur, wr, wc, fr, fq);
        if (!has_next) break;
        if (!S.keep_acc(cur))
#pragma unroll
        for (int a = 0; a < 2; ++a)
#pragma unroll
            for (int b = 0; b < 2; ++b)
#pragma unroll
                for (int m = 0; m < 4; ++m)
#pragma unroll
                    for (int n = 0; n < 2; ++n) acc[a][b][m][n] = (f32x4){0.f, 0.f, 0.f, 0.f};
        cur = nxt; cA = nA; cB = nB; ++ui;
        if constexpr (GATHER) {
#pragma unroll
            for (int h = 0; h < 2; ++h)
#pragma unroll
                for (int i = 0; i < 2; ++i) aoc[h][i] = aon[h][i]; }
        if (wr == 1) PG8_BAR;
    }
    PG8_WAIT_V(0);
    PG8_BAR;
#undef PG8_SA
#undef PG8_SB
#undef PG8_STAGE
#undef PG8_LDA
#undef PG8_LDB
#undef PG8_MMA
#undef PG8_LD8
#undef PG8_WAIT_V
#undef PG8_WAIT_L
#undef PG8_BAR
#undef PG8_SCHED
#undef PG8_GATHER_OFFS
}

struct StaticOrder {
    int nM, nN, nwg, G, c;
    DEV void init(int M, int N, int G_, int c_) { nM = M / BM; nN = N / BM; nwg = nM * nN; G = G_; c = c_; }
    DEV bool next(int i, Unit& u) const {
        const long Lx = (long)i * G + c; if (Lx >= nwg) return false;
        int wgid = (int)Lx; { const int q = nwg / 8, r = nwg % 8, xcd = wgid % 8, off = wgid / 8; wgid = (xcd < r ? xcd * (q + 1) : r * (q + 1) + (xcd - r) * q) + off; }
        const int nig = 8 * nN, gid = wgid / nig, fm = gid * 8, gsz = (nM - fm) < 8 ? (nM - fm) : 8;
        u.pm = fm + ((wgid % nig) % gsz); u.pn = (wgid % nig) / gsz; u.e = 0; u.mt = 0; return true;
    }
    DEV size_t brow(const Unit& u) const { return (size_t)u.pn * BM; }
    DEV size_t koff(const Unit&) const { return 0; }
    DEV bool keep_acc(const Unit&) const { return false; }
};
struct SplitKOrder : StaticOrder {
    int khalf_bytes;
    DEV bool next(int i, Unit& u) const { if (!StaticOrder::next(i >> 1, u)) return false; u.mt = i & 1; return true; }
    DEV size_t koff(const Unit& u) const { return (size_t)u.mt * khalf_bytes; }
    DEV bool keep_acc(const Unit& u) const { return u.mt == 0; }
};
struct MoeOrder {
    volatile LAS int* L; int e_lo, e_hi, NT, G, c, brows;
    DEV bool next(int i, Unit& u) const {
        const int per = G >> 3; int U = (i * 8 + (c & 7)) * per + (c >> 3);
        int e = e_lo;
        for (; e < e_hi; ++e) { const int nu = (((L[LC_CNT + e] + 255) >> 8)) * NT; if (U < nu) break; U -= nu; }
        if (e >= e_hi) return false;
        const int GS = 32 / NT, nm = (L[LC_CNT + e] + 255) >> 8, g = U >> 5, q2 = U - (g << 5);
        const int gsz = (nm - GS * g) < GS ? (nm - GS * g) : GS;
        u.e = e; u.pn = q2 / gsz; u.mt = GS * g + q2 % gsz; u.pm = (L[LC_START + e] >> 8) + u.mt; return true;
    }
    DEV size_t brow(const Unit& u) const { return (size_t)u.e * brows + (size_t)u.pn * BM; }
    DEV size_t koff(const Unit&) const { return 0; }
    DEV bool keep_acc(const Unit&) const { return false; }
};
}

using pg8::Unit;
DEV u32x4 pack8(const f32x4& v0, const f32x4& v1) { u32x4 w; w.x = pg8::cvt_pk_bf16(v0[0], v0[1]); w.y = pg8::cvt_pk_bf16(v0[2], v0[3]); w.z = pg8::cvt_pk_bf16(v1[0], v1[1]); w.w = pg8::cvt_pk_bf16(v1[2], v1[3]); return w; }
DEV f32x4 lo4(const u32x4& w) { return (f32x4){bflo(w.x), bfhi(w.x), bflo(w.y), bfhi(w.y)}; }
DEV f32x4 hi4(const u32x4& w) { return (f32x4){bflo(w.z), bfhi(w.z), bflo(w.w), bfhi(w.w)}; }
struct FEpiZ { static constexpr bool PERM = true, MID = false; bf16* Z1; bf16* Z2;
    DEV void operator()(const f32x4 (&acc)[2][2][4][2], const Unit& u, int wr, int wc, int fr, int fq) const {
        const int row0 = u.pm * 256 + wr * 64 + fr, pn = u.pn;
        bf16* base; int ld, colt, kind;
        if (pn < 7) { base = Z1; ld = Z1W; colt = pn * 256; kind = pn < 2 ? 0 : (pn == 2 ? 1 : 2); } else { base = Z2; ld = Z2W; colt = (pn - 7) * 256; kind = 3; }
        const int col0 = colt + wc * 32 + 8 * fq;
#pragma unroll
        for (int ai = 0; ai < 2; ++ai)
#pragma unroll
            for (int m = 0; m < 4; ++m) { bf16* rowp = base + (size_t)(row0 + ai * 128 + m * 16) * ld + col0;
#pragma unroll
                for (int bj = 0; bj < 2; ++bj) { f32x4 v0 = acc[ai][bj][m][0], v1 = acc[ai][bj][m][1];
                    if (kind == 0) { v0 = v0 * QSCALE; v1 = v1 * QSCALE; }
                    else if (kind == 2) {
#pragma unroll
                        for (int j = 0; j < 4; ++j) { v0[j] = gelu_tanh(v0[j]); v1[j] = gelu_tanh(v1[j]); } }
                    else if (kind == 3) {
#pragma unroll
                        for (int j = 0; j < 4; ++j) { v0[j] = sigmoidf_(v0[j]); v1[j] = sigmoidf_(v1[j]); } }
                    *(u32x4*)(rowp + bj * 128) = pack8(v0, v1); } }
    } };
struct FEpiProjAB { static constexpr bool PERM = true, MID = true; const bf16* Z2; bf16* MRG;
    DEV void mid(f32x4 (&acc)[2][2][4][2], const Unit& u, int wr, int wc, int fr, int fq) const {
        const int row0 = u.pm * 256 + wr * 64 + fr, col0 = u.pn * 256 + wc * 32 + 8 * fq;
#pragma unroll
        for (int ai = 0; ai < 2; ++ai)
#pragma unroll
            for (int m = 0; m < 4; ++m) { const size_t r = (size_t)(row0 + ai * 128 + m * 16);
#pragma unroll
                for (int bj = 0; bj < 2; ++bj) { const u32x4 ga = *(const u32x4*)(Z2 + r * Z2W + col0 + bj * 128), gb = *(const u32x4*)(Z2 + r * Z2W + 1024 + col0 + bj * 128);
                    f32x4 q0 = lo4(gb), q1 = hi4(gb);
#pragma unroll
                    for (int j = 0; j < 4; ++j) { q0[j] = frcp(q0[j]); q1[j] = frcp(q1[j]); }
                    acc[ai][bj][m][0] = acc[ai][bj][m][0] * (lo4(ga) * q0); acc[ai][bj][m][1] = acc[ai][bj][m][1] * (hi4(ga) * q1);
                    asm volatile("" : "+v"(acc[ai][bj][m][0]), "+v"(acc[ai][bj][m][1]) :: "memory"); } }
    }
    DEV void operator()(f32x4 (&acc)[2][2][4][2], const Unit& u, int wr, int wc, int fr, int fq) const {
        if (u.mt == 0) { mid(acc, u, wr, wc, fr, fq); return; }
        const int row0 = u.pm * 256 + wr * 64 + fr, col0 = u.pn * 256 + wc * 32 + 8 * fq;
#pragma unroll
        for (int ai = 0; ai < 2; ++ai)
#pragma unroll
            for (int m = 0; m < 4; ++m) { const size_t r = (size_t)(row0 + ai * 128 + m * 16);
#pragma unroll
                for (int bj = 0; bj < 2; ++bj) { const u32x4 gb = *(const u32x4*)(Z2 + r * Z2W + 1024 + col0 + bj * 128);
                    *(u32x4*)(MRG + r * D + col0 + bj * 128) = pack8(acc[ai][bj][m][0] * lo4(gb), acc[ai][bj][m][1] * hi4(gb)); } }
    } };
struct FEpiProjA { static constexpr bool PERM = true, MID = false; const bf16* Z2; bf16* TMP;
    DEV void operator()(const f32x4 (&acc)[2][2][4][2], const Unit& u, int wr, int wc, int fr, int fq) const {
        const int row0 = u.pm * 256 + wr * 64 + fr, col0 = u.pn * 256 + wc * 32 + 8 * fq;
#pragma unroll
        for (int ai = 0; ai < 2; ++ai)
#pragma unroll
            for (int m = 0; m < 4; ++m) { const size_t r = (size_t)(row0 + ai * 128 + m * 16);
#pragma unroll
                for (int bj = 0; bj < 2; ++bj) { const u32x4 g = *(const u32x4*)(Z2 + r * Z2W + col0 + bj * 128);
                    *(u32x4*)(TMP + r * D + col0 + bj * 128) = pack8(acc[ai][bj][m][0] * lo4(g), acc[ai][bj][m][1] * hi4(g)); } }
    } };
struct FEpiProjB { static constexpr bool PERM = true, MID = false; const bf16* Z2; const bf16* TMP; bf16* MRG;
    DEV void operator()(const f32x4 (&acc)[2][2][4][2], const Unit& u, int wr, int wc, int fr, int fq) const {
        const int row0 = u.pm * 256 + wr * 64 + fr, col0 = u.pn * 256 + wc * 32 + 8 * fq;
#pragma unroll
        for (int ai = 0; ai < 2; ++ai)
#pragma unroll
            for (int m = 0; m < 4; ++m) { const size_t r = (size_t)(row0 + ai * 128 + m * 16);
#pragma unroll
                for (int bj = 0; bj < 2; ++bj) { const u32x4 g = *(const u32x4*)(Z2 + r * Z2W + 1024 + col0 + bj * 128); const u32x4 t = *(const u32x4*)(TMP + r * D + col0 + bj * 128);
                    *(u32x4*)(MRG + r * D + col0 + bj * 128) = pack8(lo4(t) + acc[ai][bj][m][0] * lo4(g), hi4(t) + acc[ai][bj][m][1] * hi4(g)); } }
    } };
struct FEpiResid { static constexpr bool PERM = false, MID = false; const float* base; float* out;
    DEV void operator()(const f32x4 (&acc)[2][2][4][2], const Unit& u, int wr, int wc, int fr, int fq) const {
        const int row0 = u.pm * 256 + wr * 64 + fr, col0 = u.pn * 256 + wc * 32 + 4 * fq;
#pragma unroll
        for (int ai = 0; ai < 2; ++ai)
#pragma unroll
            for (int m = 0; m < 4; ++m) { const size_t off = (size_t)(row0 + ai * 128 + m * 16) * D + col0;
#pragma unroll
                for (int bj = 0; bj < 2; ++bj)
#pragma unroll
                    for (int n = 0; n < 2; ++n) *(f32x4*)(out + off + bj * 128 + n * 16) = *(const f32x4*)(base + off + bj * 128 + n * 16) + acc[ai][bj][m][n]; }
    } };
struct FEpiMoeUp { static constexpr bool PERM = true, MID = false; const float* b_gate; const float* b_up; bf16* ACT; const float* srs;
    DEV void operator()(const f32x4 (&acc)[2][2][4][2], const Unit& u, int wr, int wc, int fr, int fq) const {
        const int row0 = u.pm * 256 + wr * 64 + fr, f0 = u.pn * 128 + wc * 32 + 8 * fq;
        const f32x4 bg0 = *(const f32x4*)(b_gate + u.e * FF + f0), bg1 = *(const f32x4*)(b_gate + u.e * FF + f0 + 4), bu0 = *(const f32x4*)(b_up + u.e * FF + f0), bu1 = *(const f32x4*)(b_up + u.e * FF + f0 + 4);
#pragma unroll
        for (int ai = 0; ai < 2; ++ai)
#pragma unroll
            for (int m = 0; m < 4; ++m) { const float rr_ = srs[(size_t)u.e * T + u.mt * 256 + ai * 128 + wr * 64 + m * 16 + fr];
                f32x4 a0 = acc[ai][0][m][0] * rr_ + bg0, a1 = acc[ai][0][m][1] * rr_ + bg1, b0 = acc[ai][1][m][0] * rr_ + bu0, b1 = acc[ai][1][m][1] * rr_ + bu1;
#pragma unroll
                for (int j = 0; j < 4; ++j) { a0[j] = swiglu(a0[j], b0[j]); a1[j] = swiglu(a1[j], b1[j]); }
                *(u32x4*)(ACT + (size_t)(row0 + ai * 128 + m * 16) * FF + f0) = pack8(a0, a1); }
    } };
struct FEpiMoeUp8 { static constexpr bool PERM = true, MID = false; const float* b_gate; const float* b_up; unsigned char* ACT; const float* srs;
    DEV void operator()(const f32x4 (&acc)[2][2][4][2], const Unit& u, int wr, int wc, int fr, int fq) const {
        const int row0 = u.pm * 256 + wr * 64 + fr, f0 = u.pn * 128 + wc * 32 + 8 * fq;
        const f32x4 bg0 = *(const f32x4*)(b_gate + u.e * FF + f0), bg1 = *(const f32x4*)(b_gate + u.e * FF + f0 + 4), bu0 = *(const f32x4*)(b_up + u.e * FF + f0), bu1 = *(const f32x4*)(b_up + u.e * FF + f0 + 4);
#pragma unroll
        for (int ai = 0; ai < 2; ++ai)
#pragma unroll
            for (int m = 0; m < 4; ++m) { const float rr_ = srs[(size_t)u.e * T + u.mt * 256 + ai * 128 + wr * 64 + m * 16 + fr] * W8_INV;
                f32x4 a0 = acc[ai][0][m][0] * rr_ + bg0, a1 = acc[ai][0][m][1] * rr_ + bg1, b0 = acc[ai][1][m][0] * rr_ + bu0, b1 = acc[ai][1][m][1] * rr_ + bu1;
#pragma unroll
                for (int j = 0; j < 4; ++j) { a0[j] = swiglu(a0[j], b0[j]); a1[j] = swiglu(a1[j], b1[j]); }
                *(u32x2*)(ACT + (size_t)(row0 + ai * 128 + m * 16) * FF + f0) = (u32x2){pk4_fp8(a0[0], a0[1], a0[2], a0[3]), pk4_fp8(a1[0], a1[1], a1[2], a1[3])}; }
    } };
struct FEpiMoeDown8 { static constexpr bool PERM = true, MID = false; const float* b_down; bf16* Y;
    DEV void operator()(const f32x4 (&acc)[2][2][4][2], const Unit& u, int wr, int wc, int fr, int fq) const {
        const int row0 = u.pm * 256 + wr * 64 + fr, col0 = u.pn * 256 + wc * 32 + 8 * fq;
        f32x4 bv[2][2];
#pragma unroll
        for (int bj = 0; bj < 2; ++bj)
#pragma unroll
            for (int n = 0; n < 2; ++n) bv[bj][n] = *(const f32x4*)(b_down + u.e * D + col0 + bj * 128 + 4 * n);
#pragma unroll
        for (int ai = 0; ai < 2; ++ai)
#pragma unroll
            for (int m = 0; m < 4; ++m) { bf16* rowp = Y + (size_t)(row0 + ai * 128 + m * 16) * D + col0;
#pragma unroll
                for (int bj = 0; bj < 2; ++bj) *(u32x4*)(rowp + bj * 128) = pack8(acc[ai][bj][m][0] * W8_INV + bv[bj][0], acc[ai][bj][m][1] * W8_INV + bv[bj][1]); }
    } };
struct FEpiMoeDown { static constexpr bool PERM = true, MID = false; const float* b_down; bf16* Y;
    DEV void operator()(const f32x4 (&acc)[2][2][4][2], const Unit& u, int wr, int wc, int fr, int fq) const {
        const int row0 = u.pm * 256 + wr * 64 + fr, col0 = u.pn * 256 + wc * 32 + 8 * fq;
        f32x4 bv[2][2];
#pragma unroll
        for (int bj = 0; bj < 2; ++bj)
#pragma unroll
            for (int n = 0; n < 2; ++n) bv[bj][n] = *(const f32x4*)(b_down + u.e * D + col0 + bj * 128 + 4 * n);
#pragma unroll
        for (int ai = 0; ai < 2; ++ai)
#pragma unroll
            for (int m = 0; m < 4; ++m) { bf16* rowp = Y + (size_t)(row0 + ai * 128 + m * 16) * D + col0;
#pragma unroll
                for (int bj = 0; bj < 2; ++bj) *(u32x4*)(rowp + bj * 128) = pack8(acc[ai][bj][m][0] + bv[bj][0], acc[ai][bj][m][1] + bv[bj][1]); }
    } };
struct FEpiBf16 { static constexpr bool PERM = true, MID = false; bf16* O; int ldc;
    DEV void operator()(const f32x4 (&acc)[2][2][4][2], const Unit& u, int wr, int wc, int fr, int fq) const {
        const int row0 = u.pm * 256 + wr * 64 + fr, col0 = u.pn * 256 + wc * 32 + 8 * fq;
#pragma unroll
        for (int ai = 0; ai < 2; ++ai)
#pragma unroll
            for (int m = 0; m < 4; ++m) { bf16* rowp = O + (size_t)(row0 + ai * 128 + m * 16) * ldc + col0;
#pragma unroll
                for (int bj = 0; bj < 2; ++bj) *(u32x4*)(rowp + bj * 128) = pack8(acc[ai][bj][m][0], acc[ai][bj][m][1]); }
    } };
struct FEpiPle8 { static constexpr bool PERM = true, MID = false; const bf16* PP; const bf16* X2; bf16* X3;
    DEV void operator()(const f32x4 (&acc)[2][2][4][2], const Unit& u, int wr, int wc, int fr, int fq) const {
        const int row0 = u.pm * 256 + wr * 64 + fr, col0 = u.pn * 256 + wc * 32 + 8 * fq;
#pragma unroll
        for (int ai = 0; ai < 2; ++ai)
#pragma unroll
            for (int m = 0; m < 4; ++m) { const size_t off = (size_t)(row0 + ai * 128 + m * 16) * D + col0;
#pragma unroll
                for (int bj = 0; bj < 2; ++bj) { const u32x4 pw = *(const u32x4*)(PP + off + bj * 128), xw = *(const u32x4*)(X2 + off + bj * 128);
                    f32x4 g0 = acc[ai][bj][m][0] * W8_INV, g1 = acc[ai][bj][m][1] * W8_INV;
#pragma unroll
                    for (int j = 0; j < 4; ++j) { g0[j] = sigmoidf_(g0[j]); g1[j] = sigmoidf_(g1[j]); }
                    *(u32x4*)(X3 + off + bj * 128) = pack8(lo4(xw) + g0 * lo4(pw), hi4(xw) + g1 * hi4(pw)); }
                asm volatile("" ::: "memory"); }
    } };
struct FEpiPle { static constexpr bool PERM = false, MID = false; const bf16* PP; float* out;
    DEV void operator()(const f32x4 (&acc)[2][2][4][2], const Unit& u, int wr, int wc, int fr, int fq) const {
        const int row0 = u.pm * 256 + wr * 64 + fr, col0 = u.pn * 256 + wc * 32 + 4 * fq;
#pragma unroll
        for (int ai = 0; ai < 2; ++ai)
#pragma unroll
            for (int m = 0; m < 4; ++m) { const size_t off = (size_t)(row0 + ai * 128 + m * 16) * D + col0;
#pragma unroll
                for (int bj = 0; bj < 2; ++bj)
#pragma unroll
                    for (int n = 0; n < 2; ++n) { const size_t o = off + bj * 128 + n * 16; const u32x2 pw = *(const u32x2*)(PP + o); const f32x4 a = acc[ai][bj][m][n];
                        f32x4 r = *(const f32x4*)(out + o);
                        r[0] += sigmoidf_(a[0]) * bflo(pw.x); r[1] += sigmoidf_(a[1]) * bfhi(pw.x); r[2] += sigmoidf_(a[2]) * bflo(pw.y); r[3] += sigmoidf_(a[3]) * bfhi(pw.y);
                        *(f32x4*)(out + o) = r; }
                asm volatile("" ::: "memory"); }
    } };


#define MFMA32(a, b, c) __builtin_amdgcn_mfma_f32_32x32x16_bf16((a), (b), (c), 0, 0, 0)
DEV void phase_mixers_fast(Frame& F, const Args& a) {
    const bf16* Z1 = (const bf16*)(a.ws + WS_Z1); bf16* AP = (bf16*)(a.ws + WS_AP);
    const int tid = F.tid, lane = F.lane, r = lane & 31, h = lane >> 5, wave = F.wave;
    {
        LAS unsigned char* Kl = F.lds;
        LAS unsigned char* Vl = F.lds + 36864;
        LAS float* wsf = (LAS float*)(F.lds + 70144) + wave * 64;
        const float* sinks = a.in[4];
        for (int u = F.vcu; u < 512; u += F.G) {
            const int kvh = u & 1, bn = u >> 1, b = bn >> 4, n = bn & 15;
            const int tok0 = b * SEQ + n * 128, key0 = tok0 - 128;
            __syncthreads();
#pragma unroll
            for (int i = 0; i < 4; ++i) { const int idx = tid + 512 * i, key = idx >> 3, ch = idx & 7;
                u32x4 v = (u32x4){0u, 0u, 0u, 0u};
                if (n > 0 || key >= 128) v = *(const u32x4*)(Z1 + (size_t)(key0 + key) * Z1W + 512 + kvh * 64 + ch * 8);
                *(LAS u32x4*)(Kl + key * 144 + ch * 16) = v; }
#pragma unroll
            for (int i = 0; i < 2; ++i) { const int idx = tid + 512 * i, kp = idx >> 3, ch = idx & 7;
                u32x4 v0 = (u32x4){0u, 0u, 0u, 0u}, v1 = v0;
                if (n > 0 || kp >= 64) { const bf16* vp = Z1 + (size_t)(key0 + 2 * kp) * Z1W + 640 + kvh * 64 + ch * 8; v0 = *(const u32x4*)vp; v1 = *(const u32x4*)(vp + Z1W); }
                LAS unsigned char* dst = Vl + (ch * 8) * 520 + kp * 4;
                *(LAS unsigned*)(dst + 0 * 520) = (v0.x & 0xffffu) | (v1.x << 16); *(LAS unsigned*)(dst + 1 * 520) = (v0.x >> 16) | (v1.x & 0xffff0000u);
                *(LAS unsigned*)(dst + 2 * 520) = (v0.y & 0xffffu) | (v1.y << 16); *(LAS unsigned*)(dst + 3 * 520) = (v0.y >> 16) | (v1.y & 0xffff0000u);
                *(LAS unsigned*)(dst + 4 * 520) = (v0.z & 0xffffu) | (v1.z << 16); *(LAS unsigned*)(dst + 5 * 520) = (v0.z >> 16) | (v1.z & 0xffff0000u);
                *(LAS unsigned*)(dst + 6 * 520) = (v0.w & 0xffffu) | (v1.w << 16); *(LAS unsigned*)(dst + 7 * 520) = (v0.w >> 16) | (v1.w & 0xffff0000u); }
            __syncthreads();
            const int g = wave >> 1, qh = wave & 1, hh = kvh * 4 + g;
            const float slope2 = fexp2(-(float)(hh + 1)) * LOG2E, sink2 = sinks[hh] * LOG2E;
#pragma unroll 1
            for (int qs = 0; qs < 2; ++qs) {
                const int q0 = qh * 64 + qs * 32, kt0 = q0 >> 5, ql = q0 + r;
                bf16x8 qf[4];
#pragma unroll
                for (int ds = 0; ds < 4; ++ds) qf[ds] = *(const bf16x8*)(Z1 + (size_t)(tok0 + ql) * Z1W + hh * 64 + 16 * ds + 8 * h);
                f32x16 p[5];
#pragma unroll
                for (int t = 0; t < 5; ++t) {
#pragma unroll
                    for (int i = 0; i < 16; ++i) p[t][i] = 0.f;
                    const LAS unsigned char* kb = Kl + (32 * (kt0 + t) + r) * 144 + 16 * h;
#pragma unroll
                    for (int ds = 0; ds < 4; ++ds) p[t] = MFMA32(*(const LAS bf16x8*)(kb + 32 * ds), qf[ds], p[t]);
                }
                float mx = sink2;
#pragma unroll
                for (int t = 0; t < 5; ++t)
#pragma unroll
                    for (int i = 0; i < 16; ++i) { const int sk = 32 * (kt0 + t) + crow(i, h), dist = ql + 128 - sk;
                        const bool ok = ((unsigned)dist < 128u) && (n > 0 || sk >= 128);
                        const float v = ok ? p[t][i] - slope2 * (float)dist : -INFINITY; p[t][i] = v; mx = fmaxf(mx, v); }
                mx = fmaxf(mx, __shfl_xor(mx, 32));
                float ls = 0.f;
#pragma unroll
                for (int t = 0; t < 5; ++t)
#pragma unroll
                    for (int i = 0; i < 16; ++i) { const float e = fexp2(p[t][i] - mx); p[t][i] = e; ls += e; }
                ls += __shfl_xor(ls, 32); ls += fexp2(sink2 - mx);
                f32x16 o[2];
#pragma unroll
                for (int i = 0; i < 16; ++i) { o[0][i] = 0.f; o[1][i] = 0.f; }
#pragma unroll
                for (int t = 0; t < 5; ++t)
#pragma unroll
                    for (int s2 = 0; s2 < 2; ++s2) {
                        u32x4 pw; pw.x = pg8::cvt_pk_bf16(p[t][8 * s2 + 0], p[t][8 * s2 + 1]); pw.y = pg8::cvt_pk_bf16(p[t][8 * s2 + 2], p[t][8 * s2 + 3]);
                        pw.z = pg8::cvt_pk_bf16(p[t][8 * s2 + 4], p[t][8 * s2 + 5]); pw.w = pg8::cvt_pk_bf16(p[t][8 * s2 + 6], p[t][8 * s2 + 7]);
                        const bf16x8 pf = __builtin_bit_cast(bf16x8, pw);
#pragma unroll
                        for (int db = 0; db < 2; ++db) { const LAS unsigned char* vb = Vl + (db * 32 + r) * 520 + (32 * (kt0 + t) + 16 * s2 + 4 * h) * 2;
                            const u32x2 lo = *(const LAS u32x2*)vb, hi = *(const LAS u32x2*)(vb + 16);
                            u32x4 vw; vw.x = lo.x; vw.y = lo.y; vw.z = hi.x; vw.w = hi.y;
                            o[db] = MFMA32(pf, __builtin_bit_cast(bf16x8, vw), o[db]); }
                    }
                asm volatile("" ::: "memory");
                if (h == 0) wsf[r] = ls;
                asm volatile("s_waitcnt lgkmcnt(0)" ::: "memory");
                bf16* op = AP + (size_t)tok0 * D + hh * 64 + r;
#pragma unroll
                for (int i = 0; i < 16; ++i) { const int q = q0 + crow(i, h); const float il = frcp(wsf[crow(i, h)]);
                    op[(size_t)q * D] = (bf16)f2bf(o[0][i] * il); op[(size_t)q * D + 32] = (bf16)f2bf(o[1][i] * il); }
                asm volatile("s_waitcnt lgkmcnt(0)" ::: "memory");
            }
        }
    }
    {
        LAS unsigned char* vT = F.lds;
        LAS float* stl = (LAS float*)(F.lds + 69632);
        const bf16* Wsp = (const bf16*)(a.ws + WS_WSP); const float* g_ln = a.in[5]; const float* b_ln = a.in[6]; const float* b_sp = a.in[8];
        for (int u = F.vcu; u < 256; u += F.G) {
            const int tok0 = u * 128;
            __syncthreads();
            { float part[32];
#pragma unroll
              for (int rr = 0; rr < 16; ++rr) { const u32x4 w = *((const u32x4*)(Z1 + (size_t)(tok0 + wave * 16 + rr) * Z1W + 1280) + lane);
                  const float v0 = bflo(w.x), v1 = bfhi(w.x), v2 = bflo(w.y), v3 = bfhi(w.y), v4 = bflo(w.z), v5 = bfhi(w.z), v6 = bflo(w.w), v7 = bfhi(w.w);
                  part[2 * rr] = ((v0 + v1) + (v2 + v3)) + ((v4 + v5) + (v6 + v7));
                  part[2 * rr + 1] = ((v0 * v0 + v1 * v1) + (v2 * v2 + v3 * v3)) + ((v4 * v4 + v5 * v5) + (v6 * v6 + v7 * v7)); }
#define TR_STEP(N, BIT, XM) { const bool hb = (lane >> BIT) & 1; _Pragma("unroll") for (int i = 0; i < N; ++i) { const float keep = hb ? part[i + N] : part[i]; const float send = hb ? part[i] : part[i + N]; part[i] = keep + __shfl_xor(send, XM); } }
              TR_STEP(16, 5, 32) TR_STEP(8, 4, 16) TR_STEP(4, 3, 8) TR_STEP(2, 2, 4) TR_STEP(1, 1, 2)
#undef TR_STEP
              const float tot = part[0] + __shfl_xor(part[0], 1);
              const float oth = __shfl_xor(tot, 2);
              if ((lane & 3) == 0) { const int t = wave * 16 + (lane >> 2); const float mean = tot * (1.f / 512.f); const float var = fmaxf(oth * (1.f / 512.f) - mean * mean, 0.f);
                  stl[2 * t] = mean; stl[2 * t + 1] = 1.0f / sqrtf(var + LN_EPS); } }
#pragma unroll 1
            for (int hf = 0; hf < 2; ++hf) {
                __syncthreads();
#pragma unroll
                for (int i = 0; i < 4; ++i) { const int c8 = wave * 4 + i, tp = lane, ch0 = 256 * hf + 8 * c8;
                    const bf16* vp = Z1 + (size_t)(tok0 + 2 * tp) * Z1W + 1280 + ch0;
                    const u32x4 w0 = *(const u32x4*)vp, w1 = *(const u32x4*)(vp + Z1W);
                    const float m0 = stl[4 * tp], r0 = stl[4 * tp + 1], m1 = stl[4 * tp + 2], r1 = stl[4 * tp + 3];
                    const f32x4 ga = *(const f32x4*)(g_ln + ch0), gb = *(const f32x4*)(g_ln + ch0 + 4), ba = *(const f32x4*)(b_ln + ch0), bb = *(const f32x4*)(b_ln + ch0 + 4);
                    LAS unsigned char* dst = vT + (8 * c8) * 272 + tp * 4;
#define VT_W(j, w0c, w1c, gg, bbv, SEL) *(LAS unsigned*)(dst + (j) * 272) = pg8::cvt_pk_bf16((SEL(w0c) - m0) * r0 * (gg) + (bbv), (SEL(w1c) - m1) * r1 * (gg) + (bbv))
                    VT_W(0, w0.x, w1.x, ga.x, ba.x, bflo); VT_W(1, w0.x, w1.x, ga.y, ba.y, bfhi); VT_W(2, w0.y, w1.y, ga.z, ba.z, bflo); VT_W(3, w0.y, w1.y, ga.w, ba.w, bfhi);
                    VT_W(4, w0.z, w1.z, gb.x, bb.x, bflo); VT_W(5, w0.z, w1.z, gb.y, bb.y, bfhi); VT_W(6, w0.w, w1.w, gb.z, bb.z, bflo); VT_W(7, w0.w, w1.w, gb.w, bb.w, bfhi);
#undef VT_W
                }
                __syncthreads();
                const int gl = wave >> 2, cq = wave & 3, g = 2 * hf + gl, chb = gl * 128 + cq * 32;
                const int chg = 256 * hf + chb + r;
#pragma unroll 1
                for (int tt = 0; tt < 4; ++tt) {
                    f32x16 acc;
#pragma unroll
                    for (int i = 0; i < 16; ++i) acc[i] = 0.f;
                    const bf16* wp = Wsp + ((size_t)g * 128 + 32 * tt + r) * 128 + 8 * h;
                    const LAS unsigned char* bp = vT + (chb + r) * 272 + 16 * h;
                    bf16x8 wf[8];
#pragma unroll
                    for (int ss = 0; ss < 8; ++ss) wf[ss] = *(const bf16x8*)(wp + 16 * ss);
                    float uu[16];
#pragma unroll
                    for (int i = 0; i < 16; ++i) uu[i] = bf2f(Z1[(size_t)(tok0 + 32 * tt + crow(i, h)) * Z1W + 768 + chg]);
#pragma unroll
                    for (int ss = 0; ss < 8; ++ss) if (ss < 2 * tt + 2) acc = MFMA32(wf[ss], *(const LAS bf16x8*)(bp + 32 * ss), acc);
#pragma unroll
                    for (int i = 0; i < 16; ++i) { const int t = 32 * tt + crow(i, h); const size_t tok = (size_t)(tok0 + t);
                        AP[tok * D + 512 + chg] = (bf16)f2bf(uu[i] * (acc[i] + b_sp[g * 128 + t])); }
                }
            }
        }
    }
    __syncthreads();
}

constexpr int NPHASES = 14;
__global__ void __launch_bounds__(NTHREADS, 2) fwd(Args a) {
    extern __shared__ __attribute__((aligned(16))) unsigned char lds_raw[];
    Frame F;
    F.lds = (LAS unsigned char*)lds_raw;
    F.tid = threadIdx.x; F.lane = F.tid & 63; F.wave = __builtin_amdgcn_readfirstlane(F.tid >> 6);
    F.G = gridDim.x; { const int bx = blockIdx.x; F.vcu = (F.G % 8 == 0) ? (bx % 8) * (F.G / 8) + bx / 8 : bx; }
    F.gw = F.vcu * NWAVES + F.wave; F.NGW = F.G * NWAVES;
    for (int u = F.tid; u < (LDS_BYTES - LDS_CTL) / 4; u += NTHREADS) ((LAS unsigned*)(F.lds + LDS_CTL))[u] = 0u;
    __syncthreads();
    unsigned* ctl = (unsigned*)(a.ws + WS_CTL);
    const bool one = (a.ph_hi - a.ph_lo) > 1;
    XcdBarrier bar; bar.bar = ctl + CW_BAR; bar.x = 0; bar.st = nullptr;
    if (one) bar = xcd_barrier_post(ctl + CW_BAR, (volatile LAS unsigned*)(F.lds + LDS_CTL) + LC_BAR);
    unsigned char* ws = a.ws;
#define IN(k) (a.ph_lo <= (k) && (k) < a.ph_hi)
#define SEAM(k) do { if (IN(k) && IN((k) + 1)) xcd_barrier(bar); } while (0)
    if (IN(0)) { phase_prologue(F, a); } SEAM(0);
    volatile LAS int* Lc = (volatile LAS int*)(F.lds + LDS_CTL);
#if FAST_G1
    if (IN(1)) { FEpiZ E{(bf16*)(ws + WS_Z1), (bf16*)(ws + WS_Z2)}; pg8::StaticOrder S; S.init(T, NZ, F.G, (int)blockIdx.x);
        pg8::gemm_phase<FEpiZ, pg8::StaticOrder, false>(F.lds, (const bf16*)a.out, D, (const bf16*)(ws + WS_WIN), D, D, S, E, nullptr, Lc); } SEAM(1);
#else
    if (IN(1)) { EpiZ E{(bf16*)(ws + WS_Z1), (bf16*)(ws + WS_Z2)}; ngemm_wave((const bf16*)a.out, D, (const bf16*)(ws + WS_WIN), D, T / 32, NZ / 32, D, F, E); } SEAM(1);
#endif
#if FAST_MIX
    if (IN(3)) { phase_mixers_fast(F, a); } SEAM(3);
#else
    if (IN(2)) { phase_lnstats(F, a); } SEAM(2);
    if (IN(3)) { phase_mixers_ref(F, a); } SEAM(3);
#endif
#if FAST_G4
    if (IN(4)) { FEpiProjAB E{(const bf16*)(ws + WS_Z2), (bf16*)(ws + WS_MRG)}; pg8::SplitKOrder S; S.init(T, D, F.G, (int)blockIdx.x); S.khalf_bytes = 1024;
        pg8::gemm_phase<FEpiProjAB, pg8::SplitKOrder, false>(F.lds, (const bf16*)(ws + WS_AP), D, (const bf16*)(ws + WS_WAB), D, 512, S, E, nullptr, Lc); } SEAM(4);
    if (IN(6)) { FEpiResid E{a.in[0], a.out}; pg8::StaticOrder S; S.init(T, D, F.G, (int)blockIdx.x);
        pg8::gemm_phase<FEpiResid, pg8::StaticOrder, false>(F.lds, (const bf16*)(ws + WS_MRG), D, (const bf16*)(ws + WS_WOUT), D, D, S, E, nullptr, Lc); } SEAM(6);
#else
    if (IN(4)) { EpiProjA E{(const bf16*)(ws + WS_Z2), (bf16*)(ws + WS_TMP)}; ngemm_wave((const bf16*)(ws + WS_AP), D, (const bf16*)(ws + WS_WAB), D, T / 32, D / 32, 512, F, E); } SEAM(4);
    if (IN(5)) { EpiProjB E{(const bf16*)(ws + WS_Z2), (const bf16*)(ws + WS_TMP), (bf16*)(ws + WS_MRG)}; ngemm_wave((const bf16*)(ws + WS_AP) + 512, D, (const bf16*)(ws + WS_WAB) + 512, D, T / 32, D / 32, 512, F, E); } SEAM(5);
    if (IN(6)) { EpiResid E{a.in[0], a.out}; ngemm_wave((const bf16*)(ws + WS_MRG), D, (const bf16*)(ws + WS_WOUT), D, T / 32, D / 32, D, F, E); } SEAM(6);
#endif
    if (IN(7)) { phase_router2(F, a); } SEAM(7);
#if FAST_MOE && FP8_MOE
    if (IN(8)) { moe_layout(F, a); FEpiMoeUp8 E{a.in[16], a.in[18], ws + WS_ACT8, (const float*)(ws + WS_SRS8)}; pg8::MoeOrder S{Lc, 0, NE, 8, F.G, (int)blockIdx.x, 2048};
        pg8::gemm_phase<FEpiMoeUp8, pg8::MoeOrder, true, true>(F.lds, (const bf16*)(ws + WS_H2Q), D / 2, (const bf16*)(ws + WS_WGU8), D / 2, D / 2, S, E, (const int*)(ws + WS_LIST), Lc); } SEAM(8);
    if (IN(9)) { moe_layout(F, a);
        { bf16* PB = (bf16*)(ws + WS_PB8); for (int m = F.gw; m < T; m += F.NGW) { const f32x4 pv = *((const f32x4*)(a.in[1] + (size_t)m * PLE) + F.lane); *((u32x2*)(PB + (size_t)m * PLE) + F.lane) = (u32x2){pk2(pv.x, pv.y), pk2(pv.z, pv.w)}; } }
        FEpiMoeDown8 E{a.in[20], (bf16*)(ws + WS_Y)}; pg8::MoeOrder S{Lc, 0, NE, 4, F.G, (int)blockIdx.x, 1024};
        pg8::gemm_phase<FEpiMoeDown8, pg8::MoeOrder, false, true>(F.lds, (const bf16*)(ws + WS_ACT8), FF / 2, (const bf16*)(ws + WS_WD8), FF / 2, FF / 2, S, E, nullptr, Lc); } SEAM(9);
#elif FAST_MOE
    if (IN(8)) { moe_layout(F, a); FEpiMoeUp E{a.in[16], a.in[18], (bf16*)(ws + WS_ACT), (const float*)(ws + WS_SRS2)}; pg8::MoeOrder S{Lc, 0, NE, 8, F.G, (int)blockIdx.x, 2048};
        pg8::gemm_phase<FEpiMoeUp, pg8::MoeOrder, true>(F.lds, (const bf16*)(ws + WS_H2), D, (const bf16*)(ws + WS_WGU), D, D, S, E, (const int*)(ws + WS_LIST), Lc); } SEAM(8);
    if (IN(9)) { moe_layout(F, a); FEpiMoeDown E{a.in[20], (bf16*)(ws + WS_Y0)}; pg8::MoeOrder S{Lc, 0, Lc[LC_SPLIT], 4, F.G, (int)blockIdx.x, 1024};
        pg8::gemm_phase<FEpiMoeDown, pg8::MoeOrder, false>(F.lds, (const bf16*)(ws + WS_ACT), FF, (const bf16*)(ws + WS_WD), FF, FF, S, E, nullptr, Lc); } SEAM(9);
    if (IN(10)) { moe_layout(F, a); const int srow = Lc[LC_START + Lc[LC_SPLIT]]; FEpiMoeDown E{a.in[20], (bf16*)(ws + WS_Y1) - (size_t)srow * D}; pg8::MoeOrder S{Lc, Lc[LC_SPLIT], NE, 4, F.G, (int)blockIdx.x, 1024};
        pg8::gemm_phase<FEpiMoeDown, pg8::MoeOrder, false>(F.lds, (const bf16*)(ws + WS_ACT), FF, (const bf16*)(ws + WS_WD), FF, FF, S, E, nullptr, Lc); } SEAM(10);
#else
    if (IN(8)) { phase_moe_up_ref(F, a); } SEAM(8);
    if (IN(9)) { phase_moe_down_ref(F, a, 0); } SEAM(9);
    if (IN(10)) { phase_moe_down_ref(F, a, 1); } SEAM(10);
#endif
#if FAST_G11
    if (IN(11)) { phase_combine(F, a); __syncthreads(); FEpiBf16 E{(bf16*)(ws + (FP8_MOE ? WS_PP8 : WS_PP)), D}; pg8::StaticOrder S; S.init(T, D, F.G, (int)blockIdx.x);
        pg8::gemm_phase<FEpiBf16, pg8::StaticOrder, false>(F.lds, (const bf16*)(ws + (FP8_MOE ? WS_PB8 : WS_PB)), PLE, (const bf16*)(ws + WS_WPP), PLE, PLE, S, E, nullptr, Lc); } SEAM(11);
#if FP8_MOE
    if (IN(12)) { FEpiPle8 E{(const bf16*)(ws + WS_PP8), (const bf16*)(ws + WS_X2B), (bf16*)(ws + WS_X3B)}; pg8::StaticOrder S; S.init(T, D, F.G, (int)blockIdx.x);
        pg8::gemm_phase<FEpiPle8, pg8::StaticOrder, false, true>(F.lds, (const bf16*)(ws + WS_HP8), D / 2, (const bf16*)(ws + WS_WPG8), D / 2, D / 2, S, E, nullptr, Lc); } SEAM(12);
#else
    if (IN(12)) { FEpiPle E{(const bf16*)(ws + (FP8_MOE ? WS_PP8 : WS_PP)), a.out}; pg8::StaticOrder S; S.init(T, D, F.G, (int)blockIdx.x);
        pg8::gemm_phase<FEpiPle, pg8::StaticOrder, false>(F.lds, (const bf16*)(ws + (FP8_MOE ? WS_HP8 : WS_HP)), D, (const bf16*)(ws + WS_WPG), D, D, S, E, nullptr, Lc); } SEAM(12);
#endif
#else
    if (IN(11)) { phase_combine(F, a); EpiStoreBf16 E{(bf16*)(ws + WS_PP), D}; ngemm_wave((const bf16*)(ws + WS_PB), PLE, (const bf16*)(ws + WS_WPP), PLE, T / 32, D / 32, PLE, F, E); } SEAM(11);
    if (IN(12)) { EpiPle E{(const bf16*)(ws + WS_PP), a.out}; ngemm_wave((const bf16*)(ws + WS_HP), D, (const bf16*)(ws + WS_WPG), D, T / 32, D / 32, D, F, E); } SEAM(12);
#endif
    if (IN(13)) { phase_final(F, a); }
#undef IN
#undef SEAM
}

extern "C" void kernel_launch(void* const* d_in, const int* in_sizes, int n_in, void* d_out, int out_size, void* d_ws, size_t ws_size, hipStream_t stream) {
    static int grid = 0;
    if (grid == 0) {
        if (n_in != 25 || in_sizes[0] != T * D || out_size != T * D || ws_size < WS_END) { fprintf(stderr, "kernel_launch: unexpected shapes (n_in %d, ws %zu)\n", n_in, ws_size); grid = -1; return; }
        int dev = 0, cus = 0;
        if (hipGetDevice(&dev) != hipSuccess || hipDeviceGetAttribute(&cus, hipDeviceAttributeMultiprocessorCount, dev) != hipSuccess) { grid = -1; return; }
        if (hipFuncSetAttribute((const void*)fwd, hipFuncAttributeMaxDynamicSharedMemorySize, LDS_BYTES) != hipSuccess) { grid = -1; return; }
        (void)hipGetLastError();
        grid = cus;
    }
    if (grid < 0) return;
    (void)hipMemsetAsync((char*)d_ws + WS_CTL, 0, CTL_ZERO_BYTES, stream);
    Args a{};
    for (int i = 0; i < 25; ++i) a.in[i] = (const float*)d_in[i];
    a.out = (float*)d_out; a.ws = (unsigned char*)d_ws;
#if MK_ONE_LAUNCH
    a.ph_lo = 0; a.ph_hi = NPHASES;
    hipLaunchKernelGGL(fwd, dim3(grid), dim3(NTHREADS), LDS_BYTES, stream, a);
#else
    for (int p = 0; p < NPHASES; ++p) { a.ph_lo = p; a.ph_hi = p + 1; hipLaunchKernelGGL(fwd, dim3(grid), dim3(NTHREADS), LDS_BYTES, stream, a); }
#endif
}
```

```cpp
#include <hip/hip_runtime.h>
#include <cstdint>
#include <cstdio>

#define DEV __device__ __forceinline__
#define LAS __attribute__((address_space(3)))
typedef unsigned short bf16;
typedef short bf16x8 __attribute__((ext_vector_type(8)));
typedef float f32x4 __attribute__((ext_vector_type(4)));
typedef float f32x16 __attribute__((ext_vector_type(16)));
typedef unsigned u32x4 __attribute__((ext_vector_type(4)));
typedef unsigned u32x2 __attribute__((ext_vector_type(2)));

#ifndef FAST_GEMM
#define FAST_GEMM 1
#endif
#ifndef FAST_G1
#define FAST_G1 FAST_GEMM
#endif
#ifndef FAST_G4
#define FAST_G4 FAST_GEMM
#endif
#ifndef FAST_G11
#define FAST_G11 FAST_GEMM
#endif
#ifndef FAST_MIX
#define FAST_MIX 1
#endif
#ifndef FP8_MOE
#define FP8_MOE 1
#endif
#ifndef FAST_MOE
#define FAST_MOE 1
#endif
#ifndef MK_ONE_LAUNCH
#define MK_ONE_LAUNCH 1
#endif

constexpr int NB = 16, SEQ = 2048, T = NB * SEQ, D = 1024;
constexpr int NZ = 3840, Z1W = 1792, Z2W = 2048;
constexpr int NE = 32, FF = 1024, PLE = 256;
constexpr float LOG2E = 1.4426950408889634f;
constexpr float QSCALE = 0.125f * LOG2E;
constexpr float RMS_EPS = 1e-6f, LN_EPS = 1e-5f;
constexpr int NWAVES = 8, NTHREADS = 512;
constexpr int LDS_BYTES = 147456;
constexpr int LDS_CTL = 146432;
constexpr int LC_CNT = 0, LC_START = 32, LC_SPLIT = 65, LC_TOTAL = 66, LC_BAR = 100;

constexpr size_t MiB = 1u << 20;
constexpr size_t WS_CTL = 0, CTL_ZERO_BYTES = 1 * MiB;
constexpr size_t WS_STATS = 1 * MiB;
constexpr size_t WS_WIN = 2 * MiB, WS_WAB = 10 * MiB, WS_WOUT = 12 * MiB, WS_WPG = 14 * MiB, WS_WPP = 16 * MiB, WS_WSP = 16 * MiB + 512 * 1024;
constexpr size_t WS_LIST = 18 * MiB, WS_INFO = 22 * MiB;
constexpr size_t WS_WD = 24 * MiB, WS_WGU = 88 * MiB;
constexpr size_t WS_H2 = 216 * MiB, WS_AP = 216 * MiB;
constexpr size_t WS_ACT = 280 * MiB, WS_Z2 = 280 * MiB, WS_Z1 = 408 * MiB, WS_TMP = 408 * MiB, WS_MRG = 472 * MiB;
constexpr size_t WS_Y0 = 88 * MiB, WS_Y1 = 280 * MiB, WS_PP = 24 * MiB, WS_HP = 416 * MiB, WS_PB = 552 * MiB, WS_END = 572 * MiB;
constexpr size_t WS_RSTD = 1 * MiB + 512 * 1024;
constexpr size_t WS_WRH = 17 * MiB, WS_WRL = 17 * MiB + 64 * 1024;
constexpr size_t WS_SRS2 = 568 * MiB;
constexpr size_t WS_WD8 = 24 * MiB, WS_WGU8 = 56 * MiB, WS_H2Q = 120 * MiB, WS_ACT8 = 152 * MiB, WS_Y = 288 * MiB, WS_SRS8 = 560 * MiB;
constexpr size_t WS_PB8 = 120 * MiB, WS_HP8 = 56 * MiB, WS_PP8 = 152 * MiB;
constexpr size_t WS_X2B = 216 * MiB, WS_X3B = 288 * MiB, WS_WPG8 = 14 * MiB;
constexpr float W8_SCALE = 64.0f, W8_INV = 1.0f / 64.0f;
constexpr int Y0_CAP_ROWS = 98304;
constexpr int CW_TMO = 0, CW_GCOUNT = 64, CW_BAR = 4096;

struct Args { const float* in[25]; float* out; unsigned char* ws; int ph_lo, ph_hi; };

DEV unsigned f2bf(float f) { unsigned u = __builtin_bit_cast(unsigned, f); return (u + 0x7fffu + ((u >> 16) & 1u)) >> 16; }
DEV unsigned pk2(float lo, float hi) { return f2bf(lo) | (f2bf(hi) << 16); }
DEV unsigned pk4_fp8(float a, float b, float c, float d) { int w = __builtin_amdgcn_cvt_pk_fp8_f32(a, b, 0, false); w = __builtin_amdgcn_cvt_pk_fp8_f32(c, d, w, true); return (unsigned)w; }
DEV unsigned pg8_cvt(float lo, float hi) { unsigned r; asm volatile("v_cvt_pk_bf16_f32 %0, %1, %2" : "=v"(r) : "v"(lo), "v"(hi)); return r; }
DEV float bf2f(unsigned b) { return __builtin_bit_cast(float, b << 16); }
DEV float bflo(unsigned w) { return __builtin_bit_cast(float, w << 16); }
DEV float bfhi(unsigned w) { return __builtin_bit_cast(float, w & 0xffff0000u); }
DEV f32x4 lo4(const u32x4& w) { return (f32x4){bflo(w.x), bfhi(w.x), bflo(w.y), bfhi(w.y)}; }
DEV f32x4 hi4(const u32x4& w) { return (f32x4){bflo(w.z), bfhi(w.z), bflo(w.w), bfhi(w.w)}; }
DEV float fexp2(float x) { return __builtin_amdgcn_exp2f(x); }
DEV float frcp(float x) { return __builtin_amdgcn_rcpf(x); }
DEV float sigmoidf_(float x) { return frcp(1.0f + fexp2(-x * LOG2E)); }
DEV float gelu_tanh(float x) { const float u = 1.5957691216057308f * (x + 0.044715f * x * x * x); return x * frcp(1.0f + fexp2(-u * LOG2E)); }
DEV float swiglu(float a, float b) { a = fminf(a, 7.0f); b = fminf(fmaxf(b, -7.0f), 7.0f); return (b + 1.0f) * (a * sigmoidf_(1.702f * a)); }
DEV float wave_sum(float v) {
#pragma unroll
    for (int o = 1; o < 64; o <<= 1) v += __shfl_xor(v, o);
    return v;
}
DEV float wave_max(float v) {
#pragma unroll
    for (int o = 1; o < 64; o <<= 1) v = fmaxf(v, __shfl_xor(v, o));
    return v;
}
DEV int crow(int reg, int h) { return (reg & 3) + 8 * (reg >> 2) + 4 * h; }

struct Frame { LAS unsigned char* lds; int tid, lane, wave, vcu, G, gw, NGW; };

#define XB_TMO      128
#define XB_XCNT(j)  (256  + 64 * (j))
#define XB_XSUB(j)  (1280 + 64 * (j))
#define XB_XGEN(j)  (2304 + 64 * (j))
#define XB_TOP      3328
#define XB_TOPGEN   3392
#define XCD_BAR_WORDS 3456
#define XB_SPIN_CAP (1u << 18)
DEV unsigned xb_ld(unsigned* p)              { return __hip_atomic_load(p, __ATOMIC_RELAXED, __HIP_MEMORY_SCOPE_AGENT); }
DEV unsigned xb_add(unsigned* p, unsigned v) { return __hip_atomic_fetch_add(p, v, __ATOMIC_RELAXED, __HIP_MEMORY_SCOPE_AGENT); }
DEV unsigned xb_xcc_id() { return (unsigned)__builtin_amdgcn_s_getreg((3 << 11) | 20) & 0xFu; }
#define XB_SPIN(cond, bar) do { unsigned _sp = 0; while (cond) { __builtin_amdgcn_s_sleep(1); \
    if ((++_sp & 255u) == 0u) { if (xb_ld(&(bar)[XB_TMO])) break; if (_sp > XB_SPIN_CAP) { atomicAdd(&(bar)[XB_TMO], 1u); break; } } } } while (0)
struct XcdBarrier { unsigned* bar; unsigned x; volatile LAS unsigned* st; };
DEV XcdBarrier xcd_barrier_post(unsigned* bar, volatile LAS unsigned* st) {
    XcdBarrier b; b.bar = bar; b.x = xb_xcc_id(); b.st = st;
    if (threadIdx.x == 0) (void)xb_add(&bar[XB_XCNT(b.x)], 1u);
    return b;
}
DEV void xcd_barrier_complete(unsigned* bar, unsigned x, unsigned& nloc, unsigned& nx) {
    const unsigned G = gridDim.x * gridDim.y * gridDim.z;
    unsigned sum, cnt, mine, sp = 0u;
    for (;;) {
        sum = 0u; cnt = 0u; mine = 0u;
#pragma unroll
        for (unsigned j = 0; j < 16; ++j) { const unsigned c = xb_ld(&bar[XB_XCNT(j)]); sum += c; cnt += (c > 0u) ? 1u : 0u; mine = (j == x) ? c : mine; }
        if (sum == G) break;
        __builtin_amdgcn_s_sleep(1);
        if ((++sp & 255u) == 0u) { if (xb_ld(&bar[XB_TMO])) break; if (sp > XB_SPIN_CAP) { atomicAdd(&bar[XB_TMO], 1u); break; } }
    }
    nloc = mine > 0u ? mine : 1u; nx = cnt > 0u ? cnt : 1u;
}
DEV void xcd_barrier(const XcdBarrier& b) {
    asm volatile("s_waitcnt vmcnt(0)" ::: "memory");
    __syncthreads();
    if (threadIdx.x == 0) {
        unsigned* bar = b.bar;
        __builtin_amdgcn_s_waitcnt(0);
        unsigned nloc = b.st[0], nx = b.st[1];
        if (nloc == 0u) { xcd_barrier_complete(bar, b.x, nloc, nx); b.st[0] = nloc; b.st[1] = nx; }
        const unsigned old = xb_add(&bar[XB_XSUB(b.x)], 1u);
        const unsigned gen = old / nloc;
        if (old + 1u == (gen + 1u) * nloc) {
            __builtin_amdgcn_fence(__ATOMIC_RELEASE, "agent");
            asm volatile("s_waitcnt vmcnt(0)" ::: "memory");
            const unsigned og = xb_add(&bar[XB_TOP], 1u);
            const unsigned tg = og / nx;
            if (og + 1u == (tg + 1u) * nx) xb_add(&bar[XB_TOPGEN], 1u);
            else XB_SPIN(xb_ld(&bar[XB_TOPGEN]) == tg, bar);
            __builtin_amdgcn_fence(__ATOMIC_ACQUIRE, "agent");
            xb_add(&bar[XB_XGEN(b.x)], 1u);
            asm volatile("s_waitcnt vmcnt(0)" ::: "memory");
        } else {
            XB_SPIN(xb_ld(&bar[XB_XGEN(b.x)]) == gen, bar);
            __builtin_amdgcn_fence(__ATOMIC_ACQUIRE, "agent");
            asm volatile("s_waitcnt vmcnt(0)" ::: "memory");
        }
    }
    __syncthreads();
}

template <class Epi>
DEV void ngemm_wave(const bf16* A, int lda, const bf16* Bt, int ldb, int mtiles, int ntiles, int K, const Frame& F, const Epi& epi) {
    const int r = F.lane & 31, h = F.lane >> 5;
    const int total = mtiles * ntiles;
    for (int t = F.gw; t < total; t += F.NGW) {
        const int tm = t / ntiles, tn = t % ntiles;
        const bf16* ap = A + (size_t)(tm * 32 + r) * lda + 8 * h;
        const bf16* bp = Bt + (size_t)(tn * 32 + r) * ldb + 8 * h;
        f32x16 acc;
#pragma unroll
        for (int i = 0; i < 16; ++i) acc[i] = 0.f;
#pragma unroll 8
        for (int k0 = 0; k0 < K; k0 += 16) {
            const bf16x8 a = *(const bf16x8*)(ap + k0), b = *(const bf16x8*)(bp + k0);
            acc = __builtin_amdgcn_mfma_f32_32x32x16_bf16(a, b, acc, 0, 0, 0);
        }
#pragma unroll
        for (int i = 0; i < 16; ++i) epi(tm * 32 + crow(i, h), tn * 32 + r, acc[i]);
    }
}

DEV int maprow(int mode, int n0) { return mode == 0 ? n0 : (256 * (n0 >> 7) + (n0 & 127) + (mode == 2 ? 128 : 0)); }
DEV void transpose_item(const float* W, int K, int N, bf16* WT, int ldt, int koff, int mode, LAS float* scr, int item, int lane) {
    const int nblk = N / 32, kb = item / nblk, nb = item % nblk, k0 = 64 * kb, n0 = 32 * nb;
#pragma unroll 8
    for (int i = 0; i < 32; ++i) { const int kk = 2 * i + (lane >> 5); scr[kk * 33 + (lane & 31)] = W[(size_t)(k0 + kk) * N + n0 + (lane & 31)]; }
    asm volatile("s_waitcnt lgkmcnt(0)" ::: "memory");
    const int c = lane & 7; const int rbase = maprow(mode, n0);
#pragma unroll
    for (int j = 0; j < 4; ++j) { const int n = (lane >> 3) + 8 * j; const LAS float* s = scr + (8 * c) * 33 + n;
        u32x4 o; o.x = pk2(s[0 * 33], s[1 * 33]); o.y = pk2(s[2 * 33], s[3 * 33]); o.z = pk2(s[4 * 33], s[5 * 33]); o.w = pk2(s[6 * 33], s[7 * 33]);
        *(u32x4*)(WT + (size_t)(rbase + n) * ldt + koff + k0 + 8 * c) = o; }
    asm volatile("s_waitcnt lgkmcnt(0)" ::: "memory");
}
DEV void rms_row_to_bf16(const float* xrow, const float* g, bf16* orow, int lane) {
    const f32x4* xr = (const f32x4*)xrow + lane; const f32x4* gr = (const f32x4*)g + lane;
    f32x4 v[4]; float s = 0.f;
#pragma unroll
    for (int j = 0; j < 4; ++j) { v[j] = xr[64 * j]; s += (v[j].x * v[j].x + v[j].y * v[j].y) + (v[j].z * v[j].z + v[j].w * v[j].w); }
    const float rstd = 1.0f / sqrtf(wave_sum(s) * (1.f / D) + RMS_EPS);
    unsigned long long* o8 = (unsigned long long*)orow + lane;
#pragma unroll
    for (int j = 0; j < 4; ++j) { const f32x4 gg = gr[64 * j];
        o8[64 * j] = (unsigned long long)pk2(v[j].x * rstd * gg.x, v[j].y * rstd * gg.y) | ((unsigned long long)pk2(v[j].z * rstd * gg.z, v[j].w * rstd * gg.w) << 32); }
}
DEV void transpose_item_fp8(const float* W, int K, int N, unsigned char* WT, int ldt, int mode, LAS float* scr, int item, int lane) {
    const int nblk = N / 32, kb = item / nblk, nb = item % nblk, k0 = 64 * kb, n0 = 32 * nb;
#pragma unroll 8
    for (int i = 0; i < 32; ++i) { const int kk = 2 * i + (lane >> 5); scr[kk * 33 + (lane & 31)] = W[(size_t)(k0 + kk) * N + n0 + (lane & 31)]; }
    asm volatile("s_waitcnt lgkmcnt(0)" ::: "memory");
    const int c = lane & 7; const int rbase = maprow(mode, n0);
#pragma unroll
    for (int j = 0; j < 4; ++j) { const int n = (lane >> 3) + 8 * j; const LAS float* sp = scr + (8 * c) * 33 + n;
        u32x2 o; o.x = pk4_fp8(sp[0 * 33] * W8_SCALE, sp[1 * 33] * W8_SCALE, sp[2 * 33] * W8_SCALE, sp[3 * 33] * W8_SCALE); o.y = pk4_fp8(sp[4 * 33] * W8_SCALE, sp[5 * 33] * W8_SCALE, sp[6 * 33] * W8_SCALE, sp[7 * 33] * W8_SCALE);
        *(u32x2*)(WT + (size_t)(rbase + n) * ldt + k0 + 8 * c) = o; }
    asm volatile("s_waitcnt lgkmcnt(0)" ::: "memory");
}
DEV void transpose_item64_fp8(const float* W, int K, int N, unsigned char* WT, int ldt, int mode, LAS float* scr, int item, int lane) {
    const int nblk = N / 64, kb = item / nblk, nb = item % nblk, k0 = 64 * kb, n0 = 64 * nb;
    const float* src = W + (size_t)(k0 + (lane >> 4)) * N + n0 + 4 * (lane & 15);
    f32x4 v[16];
#pragma unroll
    for (int i = 0; i < 16; ++i) v[i] = *(const f32x4*)(src + (size_t)(4 * i) * N);
#pragma unroll
    for (int i = 0; i < 16; ++i) *(LAS f32x4*)(scr + (4 * i + (lane >> 4)) * 68 + 4 * (lane & 15)) = v[i];
    asm volatile("s_waitcnt lgkmcnt(0)" ::: "memory");
    unsigned char* dst = WT + (size_t)(maprow(mode, n0) + lane) * ldt + k0;
#pragma unroll
    for (int c = 0; c < 4; ++c) { u32x4 o;
        o.x = pk4_fp8(scr[(16 * c + 0) * 68 + lane] * W8_SCALE, scr[(16 * c + 1) * 68 + lane] * W8_SCALE, scr[(16 * c + 2) * 68 + lane] * W8_SCALE, scr[(16 * c + 3) * 68 + lane] * W8_SCALE);
        o.y = pk4_fp8(scr[(16 * c + 4) * 68 + lane] * W8_SCALE, scr[(16 * c + 5) * 68 + lane] * W8_SCALE, scr[(16 * c + 6) * 68 + lane] * W8_SCALE, scr[(16 * c + 7) * 68 + lane] * W8_SCALE);
        o.z = pk4_fp8(scr[(16 * c + 8) * 68 + lane] * W8_SCALE, scr[(16 * c + 9) * 68 + lane] * W8_SCALE, scr[(16 * c + 10) * 68 + lane] * W8_SCALE, scr[(16 * c + 11) * 68 + lane] * W8_SCALE);
        o.w = pk4_fp8(scr[(16 * c + 12) * 68 + lane] * W8_SCALE, scr[(16 * c + 13) * 68 + lane] * W8_SCALE, scr[(16 * c + 14) * 68 + lane] * W8_SCALE, scr[(16 * c + 15) * 68 + lane] * W8_SCALE);
        *(u32x4*)(dst + 16 * c) = o; }
    asm volatile("s_waitcnt lgkmcnt(0)" ::: "memory");
}
DEV void phase_prologue(Frame& F, const Args& a) {
    unsigned char* ws = a.ws;
    LAS float* scr = (LAS float*)(F.lds + F.wave * 17408);
    bf16* Win_t = (bf16*)(ws + WS_WIN); bf16* Wab_t = (bf16*)(ws + WS_WAB); bf16* Wout_t = (bf16*)(ws + WS_WOUT); bf16* Wpg_t = (bf16*)(ws + WS_WPG);
    bf16* Wpp_t = (bf16*)(ws + WS_WPP); bf16* Wsp = (bf16*)(ws + WS_WSP); bf16* Wd_t = (bf16*)(ws + WS_WD); bf16* Wgu_t = (bf16*)(ws + WS_WGU);
    constexpr int I0 = 16 * 120, I1 = 8 * 32, I2 = 8 * 32, I3 = 16 * 32, I4 = 16 * 32, I5 = 4 * 32, IE = FP8_MOE ? 256 : 512, NITEMS = I0 + I1 + I2 + I3 + I4 + I5 + NE * 3 * IE;
    for (int it = F.gw; it < NITEMS; it += F.NGW) {
        int r = it;
        if (r < I0) { transpose_item(a.in[3], D, NZ, Win_t, D, 0, 0, scr, r, F.lane); continue; } r -= I0;
        if (r < I1) { transpose_item(a.in[9], 512, D, Wab_t, D, 0, 0, scr, r, F.lane); continue; } r -= I1;
        if (r < I2) { transpose_item(a.in[10], 512, D, Wab_t, D, 512, 0, scr, r, F.lane); continue; } r -= I2;
        if (r < I3) { transpose_item(a.in[11], D, D, Wout_t, D, 0, 0, scr, r, F.lane); continue; } r -= I3;
#if FP8_MOE
        if (r < I4) { transpose_item_fp8(a.in[22], D, D, ws + WS_WPG8, D, 0, scr, r, F.lane); continue; } r -= I4;
#else
        if (r < I4) { transpose_item(a.in[22], D, D, Wpg_t, D, 0, 0, scr, r, F.lane); continue; } r -= I4;
#endif
        if (r < I5) { transpose_item(a.in[23], PLE, D, Wpp_t, PLE, 0, 0, scr, r, F.lane); continue; } r -= I5;
        const int e = r / (3 * IE), q = r % (3 * IE), kind = q / IE, item = q % IE;
#if FP8_MOE
        unsigned char* Wgu8 = ws + WS_WGU8; unsigned char* Wd8 = ws + WS_WD8;
        if (kind == 0) transpose_item64_fp8(a.in[15] + (size_t)e * D * FF, D, FF, Wgu8 + (size_t)e * 2048 * D, D, 1, scr, item, F.lane);
        else if (kind == 1) transpose_item64_fp8(a.in[17] + (size_t)e * D * FF, D, FF, Wgu8 + (size_t)e * 2048 * D, D, 2, scr, item, F.lane);
        else transpose_item64_fp8(a.in[19] + (size_t)e * FF * D, FF, D, Wd8 + (size_t)e * D * FF, FF, 0, scr, item, F.lane);
#else
        if (kind == 0) transpose_item(a.in[15] + (size_t)e * D * FF, D, FF, Wgu_t + (size_t)e * 2048 * D, D, 0, 1, scr, item, F.lane);
        else if (kind == 1) transpose_item(a.in[17] + (size_t)e * D * FF, D, FF, Wgu_t + (size_t)e * 2048 * D, D, 0, 2, scr, item, F.lane);
        else transpose_item(a.in[19] + (size_t)e * FF * D, FF, D, Wd_t + (size_t)e * D * FF, FF, 0, 0, scr, item, F.lane);
#endif
    }
    { bf16* wh = (bf16*)(ws + WS_WRH); bf16* wl = (bf16*)(ws + WS_WRL);
      for (int i = F.vcu * NTHREADS + F.tid; i < D * NE; i += F.G * NTHREADS) { const int d = i >> 5, e = i & 31; const float w = a.in[13][i]; const unsigned hb = f2bf(w);
          wh[e * D + d] = (bf16)hb; wl[e * D + d] = (bf16)f2bf(w - bf2f(hb)); } }
    for (int i = F.vcu * NTHREADS + F.tid; i < 4 * 128 * 128; i += F.G * NTHREADS) { const int s = i & 127, t = (i >> 7) & 127; Wsp[i] = (bf16)f2bf(s <= t ? a.in[7][i] : 0.f); }
    bf16* Hb = (bf16*)a.out; bf16* PB = (bf16*)(ws + WS_PB);
    for (int m0 = F.gw; m0 < T; m0 += 2 * F.NGW) {
        f32x4 v[2][4];
#pragma unroll
        for (int q = 0; q < 2; ++q) { const f32x4* xr = (const f32x4*)(a.in[0] + (size_t)(m0 + q * F.NGW) * D) + F.lane;
#pragma unroll
            for (int j = 0; j < 4; ++j) v[q][j] = xr[64 * j]; }
#pragma unroll
        for (int q = 0; q < 2; ++q) { float ss = 0.f;
#pragma unroll
            for (int j = 0; j < 4; ++j) ss += (v[q][j].x * v[q][j].x + v[q][j].y * v[q][j].y) + (v[q][j].z * v[q][j].z + v[q][j].w * v[q][j].w);
            const float rstd = 1.0f / sqrtf(wave_sum(ss) * (1.f / D) + RMS_EPS);
            u32x2* o8 = (u32x2*)(Hb + (size_t)(m0 + q * F.NGW) * D) + F.lane;
#pragma unroll
            for (int j = 0; j < 4; ++j) { const f32x4 gg = *((const f32x4*)a.in[2] + F.lane + 64 * j);
                o8[64 * j] = (u32x2){pg8_cvt(v[q][j].x * rstd * gg.x, v[q][j].y * rstd * gg.y), pg8_cvt(v[q][j].z * rstd * gg.z, v[q][j].w * rstd * gg.w)}; } }
    }
    for (int m = F.gw; m < (FP8_MOE ? 0 : T); m += F.NGW) {
        rms_row_to_bf16(a.in[0] + (size_t)m * D, a.in[2], Hb + (size_t)m * D, F.lane);
#if !FP8_MOE
        const f32x4 pv = *((const f32x4*)(a.in[1] + (size_t)m * PLE) + F.lane);
        *((u32x2*)(PB + (size_t)m * PLE) + F.lane) = (u32x2){pk2(pv.x, pv.y), pk2(pv.z, pv.w)};
#endif
    }
}

struct EpiZ { bf16* Z1; bf16* Z2;
    DEV void operator()(int row, int col, float v) const {
        if (col < 512) Z1[(size_t)row * Z1W + col] = (bf16)f2bf(v * QSCALE);
        else if (col < 768) Z1[(size_t)row * Z1W + col] = (bf16)f2bf(v);
        else if (col < Z1W) Z1[(size_t)row * Z1W + col] = (bf16)f2bf(gelu_tanh(v));
        else Z2[(size_t)row * Z2W + (col - Z1W)] = (bf16)f2bf(sigmoidf_(v));
    } };

DEV void phase_lnstats(Frame& F, const Args& a) {
    const bf16* Z1 = (const bf16*)(a.ws + WS_Z1); float2* st = (float2*)(a.ws + WS_STATS);
    for (int m = F.gw; m < T; m += F.NGW) {
        const u32x4 w = *((const u32x4*)(Z1 + (size_t)m * Z1W + 1280) + F.lane);
        float v[8] = {bflo(w.x), bfhi(w.x), bflo(w.y), bfhi(w.y), bflo(w.z), bfhi(w.z), bflo(w.w), bfhi(w.w)};
        float s = 0.f;
#pragma unroll
        for (int j = 0; j < 8; ++j) s += v[j];
        const float mean = wave_sum(s) * (1.f / 512.f); float q = 0.f;
#pragma unroll
        for (int j = 0; j < 8; ++j) { const float d = v[j] - mean; q += d * d; }
        const float rstd = 1.0f / sqrtf(wave_sum(q) * (1.f / 512.f) + LN_EPS);
        if (F.lane == 0) st[m] = make_float2(mean, rstd);
    }
}

DEV void phase_mixers_ref(Frame& F, const Args& a) {
    const bf16* Z1 = (const bf16*)(a.ws + WS_Z1); bf16* AP = (bf16*)(a.ws + WS_AP);
    const float* sinks = a.in[4];
    const int gid = F.vcu * NTHREADS + F.tid, nthr = F.G * NTHREADS;
    for (int item = gid; item < T * 8; item += nthr) {
        const int hh = item / T, m = item % T, b = m / SEQ, t = m % SEQ, kvh = hh >> 2;
        const float slope2 = fexp2(-(float)(hh + 1)) * LOG2E, sink2 = sinks[hh] * LOG2E;
        float q[64], o[64];
        const u32x4* qp = (const u32x4*)(Z1 + (size_t)m * Z1W + hh * 64);
#pragma unroll
        for (int c = 0; c < 8; ++c) { const u32x4 w = qp[c]; q[8 * c] = bflo(w.x); q[8 * c + 1] = bfhi(w.x); q[8 * c + 2] = bflo(w.y); q[8 * c + 3] = bfhi(w.y); q[8 * c + 4] = bflo(w.z); q[8 * c + 5] = bfhi(w.z); q[8 * c + 6] = bflo(w.w); q[8 * c + 7] = bfhi(w.w); }
#pragma unroll
        for (int d = 0; d < 64; ++d) o[d] = 0.f;
        float mrun = sink2, l = 1.0f;
        const int s0 = t - 127 < 0 ? 0 : t - 127;
        for (int s = s0; s <= t; ++s) {
            const bf16* krow = Z1 + (size_t)(b * SEQ + s) * Z1W + 512 + kvh * 64; const bf16* vrow = krow + 128;
            float dot = 0.f;
#pragma unroll
            for (int c = 0; c < 8; ++c) { const u32x4 w = ((const u32x4*)krow)[c];
                dot += q[8 * c] * bflo(w.x) + q[8 * c + 1] * bfhi(w.x) + q[8 * c + 2] * bflo(w.y) + q[8 * c + 3] * bfhi(w.y) + q[8 * c + 4] * bflo(w.z) + q[8 * c + 5] * bfhi(w.z) + q[8 * c + 6] * bflo(w.w) + q[8 * c + 7] * bfhi(w.w); }
            const float sc = dot - slope2 * (float)(t - s);
            const float mnew = fmaxf(mrun, sc), alpha = fexp2(mrun - mnew), p = fexp2(sc - mnew);
            l = l * alpha + p; mrun = mnew;
#pragma unroll
            for (int c = 0; c < 8; ++c) { const u32x4 w = ((const u32x4*)vrow)[c];
                o[8 * c] = o[8 * c] * alpha + p * bflo(w.x); o[8 * c + 1] = o[8 * c + 1] * alpha + p * bfhi(w.x); o[8 * c + 2] = o[8 * c + 2] * alpha + p * bflo(w.y); o[8 * c + 3] = o[8 * c + 3] * alpha + p * bfhi(w.y);
                o[8 * c + 4] = o[8 * c + 4] * alpha + p * bflo(w.z); o[8 * c + 5] = o[8 * c + 5] * alpha + p * bfhi(w.z); o[8 * c + 6] = o[8 * c + 6] * alpha + p * bflo(w.w); o[8 * c + 7] = o[8 * c + 7] * alpha + p * bfhi(w.w); }
        }
        const float il = 1.0f / l;
        u32x4* op = (u32x4*)(AP + (size_t)m * D + hh * 64);
#pragma unroll
        for (int c = 0; c < 8; ++c) op[c] = (u32x4){pk2(o[8 * c] * il, o[8 * c + 1] * il), pk2(o[8 * c + 2] * il, o[8 * c + 3] * il), pk2(o[8 * c + 4] * il, o[8 * c + 5] * il), pk2(o[8 * c + 6] * il, o[8 * c + 7] * il)};
    }
    const bf16* Wsp = (const bf16*)(a.ws + WS_WSP); const float2* st = (const float2*)(a.ws + WS_STATS);
    const float* g_ln = a.in[5]; const float* b_ln = a.in[6]; const float* b_sp = a.in[8];
    for (int item = gid; item < T * 512; item += nthr) {
        const int m = item >> 9, c = item & 511, g = c >> 7, t = m & 127, m0 = m - t;
        const float gl = g_ln[c], bl = b_ln[c];
        const bf16* wrow = Wsp + ((size_t)g * 128 + t) * 128;
        float acc = 0.f;
        for (int s = 0; s <= t; ++s) {
            const float2 ms = st[m0 + s];
            const float vn = (bf2f(Z1[(size_t)(m0 + s) * Z1W + 1280 + c]) - ms.x) * ms.y * gl + bl;
            acc += bf2f(wrow[s]) * vn;
        }
        const float u = bf2f(Z1[(size_t)m * Z1W + 768 + c]);
        AP[(size_t)m * D + 512 + c] = (bf16)f2bf(u * (acc + b_sp[g * 128 + t]));
    }
}

struct EpiProjA { const bf16* Z2; bf16* TMP;
    DEV void operator()(int row, int col, float v) const { TMP[(size_t)row * D + col] = (bf16)f2bf(bf2f(Z2[(size_t)row * Z2W + col]) * v); } };
struct EpiProjB { const bf16* Z2; const bf16* TMP; bf16* MRG;
    DEV void operator()(int row, int col, float v) const { MRG[(size_t)row * D + col] = (bf16)f2bf(bf2f(TMP[(size_t)row * D + col]) + bf2f(Z2[(size_t)row * Z2W + 1024 + col]) * v); } };
struct EpiResid { const float* base; float* out;
    DEV void operator()(int row, int col, float v) const { out[(size_t)row * D + col] = base[(size_t)row * D + col] + v; } };

DEV void phase_router(Frame& F, const Args& a) {
    const float* x1 = a.out; const float* g_ffn = a.in[12]; const float* w_router = a.in[13]; const float* b_router = a.in[14];
    bf16* H2 = (bf16*)(a.ws + WS_H2); unsigned* gcount = (unsigned*)(a.ws + WS_CTL) + CW_GCOUNT; int* list = (int*)(a.ws + WS_LIST); u32x2* info = (u32x2*)(a.ws + WS_INFO);
    LAS float* wt = (LAS float*)F.lds;
    LAS unsigned* lcount = (LAS unsigned*)(F.lds + 131584);
    LAS unsigned* gbase = lcount + 32;
    LAS unsigned* rec = gbase + 32;
    const int lane = F.lane;
    for (int i = F.tid; i < D * NE; i += NTHREADS) { const int d = i >> 5, e = i & 31; wt[e * 1028 + d] = w_router[i]; }
    f32x4 gg[4];
#pragma unroll
    for (int j = 0; j < 4; ++j) gg[j] = *((const f32x4*)g_ffn + lane + 64 * j);
    const int my_e = lane >> 1; const float my_bias = b_router[my_e];
    for (int blk = F.vcu; blk < T / 128; blk += F.G) {
        if (F.tid < 32) lcount[F.tid] = 0u;
        __syncthreads();
        for (int rr = 0; rr < 16; ++rr) {
            const int rl = F.wave * 16 + rr, m = blk * 128 + rl;
            const f32x4* xr = (const f32x4*)(x1 + (size_t)m * D) + lane;
            f32x4 v[4]; float s = 0.f;
#pragma unroll
            for (int j = 0; j < 4; ++j) { v[j] = xr[64 * j]; s += (v[j].x * v[j].x + v[j].y * v[j].y) + (v[j].z * v[j].z + v[j].w * v[j].w); }
            const float rstd = 1.0f / sqrtf(wave_sum(s) * (1.f / D) + RMS_EPS);
#pragma unroll
            for (int j = 0; j < 4; ++j) v[j] = v[j] * rstd * gg[j];
            unsigned long long* o8 = (unsigned long long*)(H2 + (size_t)m * D) + lane;
#pragma unroll
            for (int j = 0; j < 4; ++j) o8[64 * j] = (unsigned long long)pk2(v[j].x, v[j].y) | ((unsigned long long)pk2(v[j].z, v[j].w) << 32);
            float part[32];
#pragma unroll
            for (int e = 0; e < 32; ++e) { float acc = 0.f;
#pragma unroll
                for (int j = 0; j < 4; ++j) { const f32x4 w = *(const LAS f32x4*)(wt + e * 1028 + 4 * lane + 256 * j); acc += (v[j].x * w.x + v[j].y * w.y) + (v[j].z * w.z + v[j].w * w.w); }
                part[e] = acc; }
#define TR_STEP(N, BIT, XM) { const bool hb = (lane >> BIT) & 1; _Pragma("unroll") for (int i = 0; i < N; ++i) { const float keep = hb ? part[i + N] : part[i]; const float send = hb ? part[i] : part[i + N]; part[i] = keep + __shfl_xor(send, XM); } }
            TR_STEP(16, 5, 32) TR_STEP(8, 4, 16) TR_STEP(4, 3, 8) TR_STEP(2, 2, 4) TR_STEP(1, 1, 2)
#undef TR_STEP
            float val = part[0] + __shfl_xor(part[0], 1) + my_bias;
            float topv[4]; int tope[4];
#pragma unroll
            for (int k = 0; k < 4; ++k) { const float mx = wave_max(val); const unsigned long long bal = __ballot(val == mx); const int src = __ffsll((long long)bal) - 1; const int ek = src >> 1;
                topv[k] = mx; tope[k] = ek; if (my_e == ek) val = -INFINITY; }
            const float e1 = __expf(topv[1] - topv[0]), e2 = __expf(topv[2] - topv[0]), e3 = __expf(topv[3] - topv[0]);
            const float inv = 1.0f / (1.0f + e1 + e2 + e3);
            if (lane < 4) {
                const int ek = lane == 0 ? tope[0] : lane == 1 ? tope[1] : lane == 2 ? tope[2] : tope[3];
                const float gk = (lane == 0 ? 1.0f : lane == 1 ? e1 : lane == 2 ? e2 : e3) * inv;
                const unsigned pos = atomicAdd((unsigned*)(lcount + ek), 1u);
                rec[(rl * 4 + lane) * 2] = (unsigned)ek | (pos << 8); rec[(rl * 4 + lane) * 2 + 1] = __builtin_bit_cast(unsigned, gk);
            }
        }
        __syncthreads();
        if (F.tid < 32) gbase[F.tid] = atomicAdd(gcount + F.tid, lcount[F.tid]);
        __syncthreads();
        { const int rl = F.tid >> 2, k = F.tid & 3, m = blk * 128 + rl; const unsigned w0 = rec[F.tid * 2], w1 = rec[F.tid * 2 + 1];
          const unsigned ek = w0 & 255u, gpos = gbase[ek] + (w0 >> 8);
          list[(size_t)ek * T + gpos] = m; info[(size_t)m * 4 + k] = (u32x2){ek | (gpos << 5), w1}; }
        __syncthreads();
    }
}


DEV void phase_router2(Frame& F, const Args& a) {
    const float* g_ffn = a.in[12]; const float* b_router = a.in[14];
    bf16* H2 = (bf16*)(a.ws + WS_H2); unsigned* gcount = (unsigned*)(a.ws + WS_CTL) + CW_GCOUNT; int* list = (int*)(a.ws + WS_LIST); u32x2* info = (u32x2*)(a.ws + WS_INFO);
    float* rstd_g = (float*)(a.ws + WS_RSTD); float* srs = (float*)(a.ws + (FP8_MOE ? WS_SRS8 : WS_SRS2));
    LAS unsigned char* WRh = F.lds;
    LAS unsigned char* WRl = F.lds + 66048;
    LAS float* lg = (LAS float*)F.lds;
    LAS float* rs = (LAS float*)(F.lds + 132096);
    LAS unsigned* lcount = (LAS unsigned*)(F.lds + 132096 + 512);
    LAS unsigned* gbase = lcount + 32;
    LAS unsigned* rec = gbase + 32;
    const int lane = F.lane, wave = F.wave, fr = lane & 15, kq = lane >> 4;
    for (int blk = F.vcu; blk < T / 128; blk += F.G) {
        __syncthreads();
        { const bf16* wh = (const bf16*)(a.ws + WS_WRH); const bf16* wl = (const bf16*)(a.ws + WS_WRL);
          for (int i = F.tid; i < 32 * 128; i += NTHREADS) { const int e = i >> 7, c = i & 127;
              *(LAS u32x4*)(WRh + e * 2064 + c * 16) = *(const u32x4*)(wh + e * 1024 + c * 8); *(LAS u32x4*)(WRl + e * 2064 + c * 16) = *(const u32x4*)(wl + e * 1024 + c * 8); } }
        if (F.tid < 32) lcount[F.tid] = 0u;
        __syncthreads();
        const int row = blk * 128 + wave * 16 + fr;
        const bf16* xp = (const bf16*)a.out + (size_t)row * D + 8 * kq; const float* gp = g_ffn + 8 * kq; bf16* hp = H2 + (size_t)row * D + 8 * kq; unsigned char* h8 = a.ws + WS_H2Q + (size_t)row * D + 8 * kq; (void)hp; (void)h8;
        f32x4 acc0 = (f32x4){0.f, 0.f, 0.f, 0.f}, acc1 = acc0; float ss = 0.f;
#pragma unroll 4
        for (int k0 = 0; k0 < D; k0 += 32) {
            const u32x4 xw = *(const u32x4*)(xp + k0); const f32x4 xa = lo4(xw), xb = hi4(xw), ga = *(const f32x4*)(gp + k0), gb = *(const f32x4*)(gp + k0 + 4);
            ss += (xa.x * xa.x + xa.y * xa.y) + (xa.z * xa.z + xa.w * xa.w) + (xb.x * xb.x + xb.y * xb.y) + (xb.z * xb.z + xb.w * xb.w);
            const f32x4 pa = xa * ga, pb = xb * gb;
            u32x4 hw; hw.x = pk2(pa.x, pa.y); hw.y = pk2(pa.z, pa.w); hw.z = pk2(pb.x, pb.y); hw.w = pk2(pb.z, pb.w);
#if FP8_MOE
            *(u32x2*)(h8 + k0) = (u32x2){pk4_fp8(pa.x, pa.y, pa.z, pa.w), pk4_fp8(pb.x, pb.y, pb.z, pb.w)};
#else
            *(u32x4*)(hp + k0) = hw;
#endif
            u32x4 lw; lw.x = pk2(pa.x - bflo(hw.x), pa.y - bfhi(hw.x)); lw.y = pk2(pa.z - bflo(hw.y), pa.w - bfhi(hw.y)); lw.z = pk2(pb.x - bflo(hw.z), pb.y - bfhi(hw.z)); lw.w = pk2(pb.z - bflo(hw.w), pb.w - bfhi(hw.w));
            const bf16x8 ah = __builtin_bit_cast(bf16x8, hw), al = __builtin_bit_cast(bf16x8, lw);
            const LAS unsigned char* bh = WRh + fr * 2064 + (k0 + 8 * kq) * 2; const LAS unsigned char* bl = WRl + fr * 2064 + (k0 + 8 * kq) * 2;
            const bf16x8 bh0 = *(const LAS bf16x8*)bh, bh1 = *(const LAS bf16x8*)(bh + 16 * 2064), bl0 = *(const LAS bf16x8*)bl, bl1 = *(const LAS bf16x8*)(bl + 16 * 2064);
            acc0 = __builtin_amdgcn_mfma_f32_16x16x32_bf16(ah, bh0, acc0, 0, 0, 0); acc1 = __builtin_amdgcn_mfma_f32_16x16x32_bf16(ah, bh1, acc1, 0, 0, 0);
            acc0 = __builtin_amdgcn_mfma_f32_16x16x32_bf16(ah, bl0, acc0, 0, 0, 0); acc1 = __builtin_amdgcn_mfma_f32_16x16x32_bf16(ah, bl1, acc1, 0, 0, 0);
            acc0 = __builtin_amdgcn_mfma_f32_16x16x32_bf16(al, bh0, acc0, 0, 0, 0); acc1 = __builtin_amdgcn_mfma_f32_16x16x32_bf16(al, bh1, acc1, 0, 0, 0);
        }
        ss += __shfl_xor(ss, 16); ss += __shfl_xor(ss, 32);
        const float rstd = 1.0f / sqrtf(ss * (1.f / D) + RMS_EPS);
        if (kq == 0) { rs[wave * 16 + fr] = rstd; rstd_g[row] = rstd; }
        __syncthreads();
        { const float b0 = b_router[fr], b1 = b_router[16 + fr];
#pragma unroll
          for (int i = 0; i < 4; ++i) { const int rl = wave * 16 + 4 * kq + i; const float r_ = rs[rl]; lg[rl * 33 + fr] = acc0[i] * r_ + b0; lg[rl * 33 + 16 + fr] = acc1[i] * r_ + b1; } }
        __syncthreads();
        if (F.tid < 128) {
            const int rl = F.tid; float v[32];
#pragma unroll
            for (int e = 0; e < 32; ++e) v[e] = lg[rl * 33 + e];
            float topv[4]; int tope[4];
#pragma unroll
            for (int k = 0; k < 4; ++k) { float mx = v[0]; int mi = 0;
#pragma unroll
                for (int e = 1; e < 32; ++e) { const bool gt = v[e] > mx; mx = gt ? v[e] : mx; mi = gt ? e : mi; }
                topv[k] = mx; tope[k] = mi;
#pragma unroll
                for (int e = 0; e < 32; ++e) v[e] = (e == mi) ? -INFINITY : v[e]; }
            const float e1 = __expf(topv[1] - topv[0]), e2 = __expf(topv[2] - topv[0]), e3 = __expf(topv[3] - topv[0]);
            const float inv = 1.0f / (1.0f + e1 + e2 + e3);
            const float gk[4] = {inv, e1 * inv, e2 * inv, e3 * inv};
#pragma unroll
            for (int k = 0; k < 4; ++k) { const unsigned pos = atomicAdd((unsigned*)(lcount + tope[k]), 1u);
                rec[(rl * 4 + k) * 2] = (unsigned)tope[k] | (pos << 8); rec[(rl * 4 + k) * 2 + 1] = __float_as_uint(gk[k]); }
        }
        __syncthreads();
        if (F.tid < 32) gbase[F.tid] = atomicAdd(gcount + F.tid, lcount[F.tid]);
        __syncthreads();
        { const int rl = F.tid >> 2, k = F.tid & 3, m = blk * 128 + rl; const unsigned w0 = rec[F.tid * 2], w1 = rec[F.tid * 2 + 1];
          const unsigned ek = w0 & 255u, gpos = gbase[ek] + (w0 >> 8);
          list[(size_t)ek * T + gpos] = m; srs[(size_t)ek * T + gpos] = rs[rl]; info[(size_t)m * 4 + k] = (u32x2){ek | (gpos << 5), w1}; }
    }
    __syncthreads();
}

DEV void moe_layout(Frame& F, const Args& a) {
    volatile LAS int* L = (volatile LAS int*)(F.lds + LDS_CTL);
    if (F.tid == 0) {
        unsigned* gcount = (unsigned*)(a.ws + WS_CTL) + CW_GCOUNT; int st = 0;
        for (int e = 0; e < NE; ++e) { const int c = (int)__hip_atomic_load(gcount + e, __ATOMIC_RELAXED, __HIP_MEMORY_SCOPE_AGENT); L[LC_CNT + e] = c; L[LC_START + e] = st; st += (c + 255) & ~255; }
        L[LC_START + NE] = st; L[LC_TOTAL] = st;
        int sp = 0; while (sp < NE && 2 * L[LC_START + sp] < st) ++sp;
        L[LC_SPLIT] = sp;
    }
    __syncthreads();
}

DEV void phase_moe_up_ref(Frame& F, const Args& a) {
    moe_layout(F, a);
    volatile LAS int* L = (volatile LAS int*)(F.lds + LDS_CTL);
    const bf16* H2 = (const bf16*)(a.ws + WS_H2); const bf16* Wgu_t = (const bf16*)(a.ws + WS_WGU); bf16* ACT = (bf16*)(a.ws + WS_ACT); const int* list = (const int*)(a.ws + WS_LIST);
    const float* b_gate = a.in[16]; const float* b_up = a.in[18];
    const int r = F.lane & 31, h = F.lane >> 5, total = L[LC_TOTAL];
    const int items = (total / 32) * 32;
    for (int it = F.gw; it < items; it += F.NGW) {
        const int rt = it >> 5, ft = it & 31, s0 = rt * 32, f0 = ft * 32;
        int e = 0; while (e < NE - 1 && s0 >= L[LC_START + e + 1]) ++e;
        const int local = s0 + r - L[LC_START + e];
        const int tok = local < L[LC_CNT + e] ? list[(size_t)e * T + local] : 0;
        const bf16* ap = H2 + (size_t)tok * D + 8 * h;
        const bf16* bg = Wgu_t + ((size_t)e * 2048 + 256 * (f0 >> 7) + (f0 & 127) + r) * D + 8 * h; const bf16* bu = bg + (size_t)128 * D;
        f32x16 acca, accb;
#pragma unroll
        for (int i = 0; i < 16; ++i) { acca[i] = 0.f; accb[i] = 0.f; }
#pragma unroll 4
        for (int k0 = 0; k0 < D; k0 += 16) { const bf16x8 av = *(const bf16x8*)(ap + k0);
            acca = __builtin_amdgcn_mfma_f32_32x32x16_bf16(av, *(const bf16x8*)(bg + k0), acca, 0, 0, 0);
            accb = __builtin_amdgcn_mfma_f32_32x32x16_bf16(av, *(const bf16x8*)(bu + k0), accb, 0, 0, 0); }
        const float bgv = b_gate[e * FF + f0 + r], buv = b_up[e * FF + f0 + r];
#pragma unroll
        for (int i = 0; i < 16; ++i) ACT[(size_t)(s0 + crow(i, h)) * FF + f0 + r] = (bf16)f2bf(swiglu(acca[i] + bgv, accb[i] + buv));
    }
}
DEV void phase_moe_down_ref(Frame& F, const Args& a, int half) {
    moe_layout(F, a);
    volatile LAS int* L = (volatile LAS int*)(F.lds + LDS_CTL);
    const bf16* ACT = (const bf16*)(a.ws + WS_ACT); const bf16* Wd_t = (const bf16*)(a.ws + WS_WD); const float* b_down = a.in[20];
    const int r = F.lane & 31, h = F.lane >> 5, total = L[LC_TOTAL], srow = L[LC_START + L[LC_SPLIT]];
    const int row_lo = half == 0 ? 0 : srow, row_hi = half == 0 ? srow : total;
    bf16* Y = half == 0 ? (bf16*)(a.ws + WS_Y0) : (bf16*)(a.ws + WS_Y1) - (size_t)srow * D;
    const int items = ((row_hi - row_lo) / 32) * 32;
    for (int it = F.gw; it < items; it += F.NGW) {
        const int rt = it >> 5, nt = it & 31, s0 = row_lo + rt * 32, n0 = nt * 32;
        int e = 0; while (e < NE - 1 && s0 >= L[LC_START + e + 1]) ++e;
        const bf16* ap = ACT + (size_t)(s0 + r) * FF + 8 * h;
        const bf16* bp = Wd_t + ((size_t)e * D + n0 + r) * FF + 8 * h;
        f32x16 acc;
#pragma unroll
        for (int i = 0; i < 16; ++i) acc[i] = 0.f;
#pragma unroll 8
        for (int k0 = 0; k0 < FF; k0 += 16) acc = __builtin_amdgcn_mfma_f32_32x32x16_bf16(*(const bf16x8*)(ap + k0), *(const bf16x8*)(bp + k0), acc, 0, 0, 0);
        const float bd = b_down[e * D + n0 + r];
#pragma unroll
        for (int i = 0; i < 16; ++i) Y[(size_t)(s0 + crow(i, h)) * D + n0 + r] = (bf16)f2bf(acc[i] + bd);
    }
}

DEV void phase_combine(Frame& F, const Args& a) {
    moe_layout(F, a);
    volatile LAS int* L = (volatile LAS int*)(F.lds + LDS_CTL);
    const int srow = L[LC_START + L[LC_SPLIT]];
#if FP8_MOE
    const bf16* Y0 = (const bf16*)(a.ws + WS_Y); const bf16* Y1 = Y0; bf16* HP = (bf16*)(a.ws + WS_HP8);
#else
    const bf16* Y0 = (const bf16*)(a.ws + WS_Y0); const bf16* Y1 = (const bf16*)(a.ws + WS_Y1) - (size_t)srow * D; bf16* HP = (bf16*)(a.ws + WS_HP);
#endif
    const u32x2* info = (const u32x2*)(a.ws + WS_INFO); const float* g_ple = a.in[21];
    const int lane = F.lane;
#if FP8_MOE
    for (int m0 = F.gw; m0 < T; m0 += 2 * F.NGW) {
        u32x2 inf[2][4]; f32x4 v[2][4]; unsigned yw[2][4][4];
#pragma unroll
        for (int q = 0; q < 2; ++q) { const int m = m0 + q * F.NGW;
#pragma unroll
            for (int k = 0; k < 4; ++k) inf[q][k] = info[(size_t)m * 4 + k];
            const u32x2* xr = (const u32x2*)((const bf16*)a.out + (size_t)m * D) + lane;
#pragma unroll
            for (int j = 0; j < 4; ++j) { const u32x2 xw = xr[64 * j]; v[q][j] = (f32x4){bflo(xw.x), bfhi(xw.x), bflo(xw.y), bfhi(xw.y)}; } }
#pragma unroll
        for (int q = 0; q < 2; ++q)
#pragma unroll
            for (int k = 0; k < 4; ++k) { const unsigned wx = inf[q][k].x; const int row = L[LC_START + (wx & 31)] + (int)(wx >> 5); const unsigned char* yr = (const unsigned char*)Y0 + (size_t)row * D;
#pragma unroll
                for (int j = 0; j < 4; ++j) yw[q][k][j] = *((const unsigned*)yr + lane + 64 * j); }
#pragma unroll
        for (int q = 0; q < 2; ++q) { const int m = m0 + q * F.NGW;
#pragma unroll
            for (int k = 0; k < 4; ++k) { const unsigned wy = inf[q][k].y; const float g = __uint_as_float(wy);
#pragma unroll
                for (int j = 0; j < 4; ++j) { const unsigned yb = yw[q][k][j];
                    v[q][j].x += g * __builtin_amdgcn_cvt_f32_fp8(yb, 0); v[q][j].y += g * __builtin_amdgcn_cvt_f32_fp8(yb, 1); v[q][j].z += g * __builtin_amdgcn_cvt_f32_fp8(yb, 2); v[q][j].w += g * __builtin_amdgcn_cvt_f32_fp8(yb, 3); } }
            float ss = 0.f;
            u32x2* x2b = (u32x2*)((bf16*)(a.ws + WS_X2B) + (size_t)m * D) + lane;
#pragma unroll
            for (int j = 0; j < 4; ++j) { x2b[64 * j] = (u32x2){pg8_cvt(v[q][j].x, v[q][j].y), pg8_cvt(v[q][j].z, v[q][j].w)}; ss += (v[q][j].x * v[q][j].x + v[q][j].y * v[q][j].y) + (v[q][j].z * v[q][j].z + v[q][j].w * v[q][j].w); }
            const float rstd = 1.0f / sqrtf(wave_sum(ss) * (1.f / D) + RMS_EPS);
            unsigned* o4 = (unsigned*)((unsigned char*)HP + (size_t)m * D) + lane;
#pragma unroll
            for (int j = 0; j < 4; ++j) { const f32x4 gg = *((const f32x4*)g_ple + lane + 64 * j);
                o4[64 * j] = pk4_fp8(v[q][j].x * rstd * gg.x, v[q][j].y * rstd * gg.y, v[q][j].z * rstd * gg.z, v[q][j].w * rstd * gg.w); } }
    }
#else
    for (int m = F.gw; m < T; m += F.NGW) {
        f32x4* xr = (f32x4*)(a.out + (size_t)m * D) + lane;
        f32x4 v[4];
#pragma unroll
        for (int j = 0; j < 4; ++j) v[j] = xr[64 * j];
#pragma unroll
        for (int k = 0; k < 4; ++k) { const u32x2 w = info[(size_t)m * 4 + k]; const int e = w.x & 31, gpos = (int)(w.x >> 5); const unsigned wy = w.y; const float g = __uint_as_float(wy);
            const int row = L[LC_START + e] + gpos; const bf16* yr = (row < srow ? Y0 : Y1) + (size_t)row * D;
#pragma unroll
            for (int j = 0; j < 4; ++j) { const u32x2 yw = *((const u32x2*)yr + lane + 64 * j);
                v[j].x += g * bflo(yw.x); v[j].y += g * bfhi(yw.x); v[j].z += g * bflo(yw.y); v[j].w += g * bfhi(yw.y); } }
        float s = 0.f;
#if FP8_MOE
        u32x2* x2b = (u32x2*)((bf16*)(a.ws + WS_X2B) + (size_t)m * D) + lane;
#pragma unroll
        for (int j = 0; j < 4; ++j) { x2b[64 * j] = (u32x2){pg8_cvt(v[j].x, v[j].y), pg8_cvt(v[j].z, v[j].w)}; s += (v[j].x * v[j].x + v[j].y * v[j].y) + (v[j].z * v[j].z + v[j].w * v[j].w); }
        const float rstd = 1.0f / sqrtf(wave_sum(s) * (1.f / D) + RMS_EPS);
        unsigned* o4 = (unsigned*)((unsigned char*)HP + (size_t)m * D) + lane;
#pragma unroll
        for (int j = 0; j < 4; ++j) { const f32x4 gg = *((const f32x4*)g_ple + lane + 64 * j);
            o4[64 * j] = pk4_fp8(v[j].x * rstd * gg.x, v[j].y * rstd * gg.y, v[j].z * rstd * gg.z, v[j].w * rstd * gg.w); }
#else
#pragma unroll
        for (int j = 0; j < 4; ++j) { xr[64 * j] = v[j]; s += (v[j].x * v[j].x + v[j].y * v[j].y) + (v[j].z * v[j].z + v[j].w * v[j].w); }
        const float rstd = 1.0f / sqrtf(wave_sum(s) * (1.f / D) + RMS_EPS);
        unsigned long long* o8 = (unsigned long long*)(HP + (size_t)m * D) + lane;
#pragma unroll
        for (int j = 0; j < 4; ++j) { const f32x4 gg = *((const f32x4*)g_ple + lane + 64 * j);
            o8[64 * j] = (unsigned long long)pk2(v[j].x * rstd * gg.x, v[j].y * rstd * gg.y) | ((unsigned long long)pk2(v[j].z * rstd * gg.z, v[j].w * rstd * gg.w) << 32); }
#endif
    }
#endif
}
struct EpiStoreBf16 { bf16* O; int ldc;
    DEV void operator()(int row, int col, float v) const { O[(size_t)row * ldc + col] = (bf16)f2bf(v); } };
struct EpiPle { const bf16* PP; float* out;
    DEV void operator()(int row, int col, float v) const { const size_t i = (size_t)row * D + col; out[i] = out[i] + sigmoidf_(v) * bf2f(PP[i]); } };

DEV void phase_final(Frame& F, const Args& a) {
    const float* g = a.in[24]; const int lane = F.lane;
#if FP8_MOE
    for (int m0 = F.gw; m0 < T; m0 += 2 * F.NGW) {
        u32x2 w[2][4];
#pragma unroll
        for (int q = 0; q < 2; ++q) { const u32x2* x3b = (const u32x2*)((const bf16*)(a.ws + WS_X3B) + (size_t)(m0 + q * F.NGW) * D) + lane;
#pragma unroll
            for (int j = 0; j < 4; ++j) w[q][j] = x3b[64 * j]; }
#pragma unroll
        for (int q = 0; q < 2; ++q) { f32x4 v[4]; float ss = 0.f;
#pragma unroll
            for (int j = 0; j < 4; ++j) { v[j] = (f32x4){bflo(w[q][j].x), bfhi(w[q][j].x), bflo(w[q][j].y), bfhi(w[q][j].y)}; ss += (v[j].x * v[j].x + v[j].y * v[j].y) + (v[j].z * v[j].z + v[j].w * v[j].w); }
            const float rstd = 1.0f / sqrtf(wave_sum(ss) * (1.f / D) + RMS_EPS);
            f32x4* xr = (f32x4*)(a.out + (size_t)(m0 + q * F.NGW) * D) + lane;
#pragma unroll
            for (int j = 0; j < 4; ++j) xr[64 * j] = v[j] * rstd * *((const f32x4*)g + lane + 64 * j); }
    }
    return;
#endif
    for (int m = F.gw; m < T; m += F.NGW) {
        f32x4* xr = (f32x4*)(a.out + (size_t)m * D) + lane;
        f32x4 v[4]; float s = 0.f;
#if FP8_MOE
        const u32x2* x3b = (const u32x2*)((const bf16*)(a.ws + WS_X3B) + (size_t)m * D) + lane;
#pragma unroll
        for (int j = 0; j < 4; ++j) { const u32x2 w = x3b[64 * j]; v[j] = (f32x4){bflo(w.x), bfhi(w.x), bflo(w.y), bfhi(w.y)}; s += (v[j].x * v[j].x + v[j].y * v[j].y) + (v[j].z * v[j].z + v[j].w * v[j].w); }
#else
#pragma unroll
        for (int j = 0; j < 4; ++j) { v[j] = xr[64 * j]; s += (v[j].x * v[j].x + v[j].y * v[j].y) + (v[j].z * v[j].z + v[j].w * v[j].w); }
#endif
        const float rstd = 1.0f / sqrtf(wave_sum(s) * (1.f / D) + RMS_EPS);
#pragma unroll
        for (int j = 0; j < 4; ++j) xr[64 * j] = v[j] * rstd * *((const f32x4*)g + lane + 64 * j);
    }
}


namespace pg8 {
constexpr int BM = 256, BK = 64, HALF = 128, HTB = HALF * BK * 2, STAGE_BYTES = 8 * HTB;
DEV int lds_byte(int r, int c) { const int st = (r >> 4) * 2 + (c >> 5), rr = r & 15, cc = c & 31, ob = rr * 64 + cc * 2; return st * 1024 + (ob ^ (((ob >> 9) & 1) << 5)); }
DEV void stage_rc(int b, int& R, int& C) { const int st = b / 1024, sb = b % 1024, swz = sb ^ (((sb >> 9) & 1) << 5); R = (st >> 1) * 16 + swz / 64; C = (st & 1) * 32 + (swz % 64) / 2; }
DEV int perm32(int rho) { const int n = rho >> 4, i = rho & 15; return 8 * (i >> 2) + 4 * n + (i & 3); }
struct Unit { int pm, pn, e, mt; };
DEV unsigned cvt_pk_bf16(float lo, float hi) { unsigned r; asm volatile("v_cvt_pk_bf16_f32 %0, %1, %2" : "=v"(r) : "v"(lo), "v"(hi)); return r; }

typedef int i32x8 __attribute__((ext_vector_type(8)));
template <class Epi, class Sched, bool GATHER, bool FP8 = false>
DEV void gemm_phase(LAS unsigned char* lds, const bf16* A, int lda, const bf16* Bt, int ldb, int K, const Sched& S, const Epi& E, const int* list, volatile LAS int* L) {
    const int tid = threadIdx.x, wid = __builtin_amdgcn_readfirstlane(tid >> 6), lane = tid & 63, wr = wid >> 2, wc = wid & 3, fr = lane & 15, fq = lane >> 4;
    const int nt = K / BK;
    unsigned voffA[2], voffB[2]; int RA[2], CA[2];
#pragma unroll
    for (int i = 0; i < 2; ++i) { int R, C; stage_rc(tid * 16 + i * 8192, R, C); const int Rb = Epi::PERM ? ((R & ~31) + perm32(R & 31)) : R;
        voffA[i] = (unsigned)(R * lda + C) * 2u; voffB[i] = (unsigned)(Rb * ldb + C) * 2u; RA[i] = R; CA[i] = C; }
    const size_t kstep = (size_t)(BK * 2);
    const size_t hstepA = (size_t)HALF * lda * 2, hstepB = (size_t)HALF * ldb * 2;
    const unsigned ldsw = (unsigned)wid * 1024u;
    const int aoff = lds_byte(wr * 64 + fr, fq * 8), boff = lds_byte(wc * 32 + fr, fq * 8);
#define PG8_SA(b, h) (((b) * 2 + (h)) * HTB)
#define PG8_SB(b, h) ((4 + (b) * 2 + (h)) * HTB)
#define PG8_STAGE(bufoff, gbase, voff) do { _Pragma("unroll") for (int _i = 0; _i < 2; ++_i) \
        __builtin_amdgcn_global_load_lds((const unsigned*)((const char*)(gbase) + (voff)[_i]), (LAS unsigned*)(lds + (bufoff) + ldsw + _i * 8192), 16, 0, 0); } while (0)
    const int aoff8 = lds_byte(wr * 64 + fr, fq * 16), boff8 = lds_byte(wc * 32 + fr, fq * 16);
#define PG8_LD8(p) __builtin_bit_cast(i32x8, __builtin_shufflevector(*(const LAS u32x4*)(p), *(const LAS u32x4*)((p) + 16), 0, 1, 2, 3, 4, 5, 6, 7))
#define PG8_LDA(dst, b, h) do { if constexpr (FP8) { _Pragma("unroll") for (int m = 0; m < 4; ++m) dst##8[m] = PG8_LD8(lds + PG8_SA(b, h) + aoff8 + m * 2048); } \
        else { _Pragma("unroll") for (int m = 0; m < 4; ++m) _Pragma("unroll") for (int k = 0; k < 2; ++k) dst[m][k] = *(const LAS bf16x8*)(lds + PG8_SA(b, h) + aoff + m * 2048 + k * 1024); } } while (0)
#define PG8_LDB(dst, b, h) do { if constexpr (FP8) { _Pragma("unroll") for (int n = 0; n < 2; ++n) dst##8[n] = PG8_LD8(lds + PG8_SB(b, h) + boff8 + n * 2048); } \
        else { _Pragma("unroll") for (int n = 0; n < 2; ++n) _Pragma("unroll") for (int k = 0; k < 2; ++k) dst[n][k] = *(const LAS bf16x8*)(lds + PG8_SB(b, h) + boff + n * 2048 + k * 1024); } } while (0)
#define PG8_MMA(ai, bj, At, Bt_) do { __builtin_amdgcn_s_setprio(1); _Pragma("unroll") for (int m = 0; m < 4; ++m) _Pragma("unroll") for (int n = 0; n < 2; ++n) { \
        if constexpr (FP8) { asm volatile("v_mfma_scale_f32_16x16x128_f8f6f4 %0, %1, %2, %0, %3, %3 op_sel_hi:[0,0,0]" : "+v"(acc[ai][bj][m][n]) : "v"(Bt_##8[n]), "v"(At##8[m]), "v"(scale1)); } \
        else { _Pragma("unroll") for (int k = 0; k < 2; ++k) acc[ai][bj][m][n] = __builtin_amdgcn_mfma_f32_16x16x32_bf16(Bt_[n][k], At[m][k], acc[ai][bj][m][n], 0, 0, 0); } } \
        __builtin_amdgcn_s_setprio(0); } while (0)
#define PG8_WAIT_V(n) asm volatile("s_waitcnt vmcnt(" #n ")" ::: "memory")
#define PG8_WAIT_L(n) asm volatile("s_waitcnt lgkmcnt(" #n ")" ::: "memory")
#define PG8_BAR __builtin_amdgcn_s_barrier()
#define PG8_SCHED __builtin_amdgcn_sched_barrier(0)
    unsigned aoc[2][2], aon[2][2];
#define PG8_GATHER_OFFS(dst, u) do { _Pragma("unroll") for (int _h = 0; _h < 2; ++_h) _Pragma("unroll") for (int _i = 0; _i < 2; ++_i) { \
        const int _idx = (u).mt * 256 + _h * HALF + RA[_i]; const int _tok = _idx < L[LC_CNT + (u).e] ? list[(size_t)(u).e * T + _idx] : 0; \
        dst[_h][_i] = (unsigned)(_tok * lda + CA[_i]) * 2u; } } while (0)
    Unit cur, nxt; int ui = 0;
    if (!S.next(0, cur)) return;
    f32x4 acc[2][2][4][2];
#pragma unroll
    for (int a = 0; a < 2; ++a)
#pragma unroll
        for (int b = 0; b < 2; ++b)
#pragma unroll
            for (int m = 0; m < 4; ++m)
#pragma unroll
                for (int n = 0; n < 2; ++n) acc[a][b][m][n] = (f32x4){0.f, 0.f, 0.f, 0.f};
    bf16x8 At[4][2], B0[2][2], B1[2][2]; i32x8 At8[4], B08[2], B18[2]; unsigned scale1 = 0x7F7F7F7Fu; asm volatile("" : "+v"(scale1));
    const char* cA; const char* cB = (const char*)Bt + S.brow(cur) * (size_t)ldb * 2 + S.koff(cur);
    if constexpr (GATHER) { cA = (const char*)A; PG8_GATHER_OFFS(aoc, cur); }
    else { cA = (const char*)A + (size_t)cur.pm * BM * lda * 2 + S.koff(cur);
#pragma unroll
        for (int i = 0; i < 2; ++i) { aoc[0][i] = voffA[i]; aoc[1][i] = voffA[i] + (unsigned)hstepA; } }
    PG8_STAGE(PG8_SB(0, 0), cB, voffB); PG8_STAGE(PG8_SB(0, 1), cB + hstepB, voffB); PG8_STAGE(PG8_SA(0, 0), cA, aoc[0]); PG8_STAGE(PG8_SA(0, 1), cA, aoc[1]);
    if (wr == 1) PG8_BAR;
    PG8_WAIT_V(2); PG8_BAR;
    PG8_STAGE(PG8_SB(1, 0), cB + kstep, voffB); PG8_STAGE(PG8_SA(1, 0), cA + kstep, aoc[0]); PG8_STAGE(PG8_SB(1, 1), cB + hstepB + kstep, voffB);
    PG8_WAIT_V(6); PG8_BAR;
    for (;;) {
        const bool has_next = S.next(ui + 1, nxt);
        const char* nA; const char* nB = has_next ? (const char*)Bt + S.brow(nxt) * (size_t)ldb * 2 + S.koff(nxt) : cB;
        if constexpr (GATHER) { nA = cA; if (has_next) PG8_GATHER_OFFS(aon, nxt); else {
#pragma unroll
            for (int h = 0; h < 2; ++h)
#pragma unroll
                for (int i = 0; i < 2; ++i) aon[h][i] = aoc[h][i]; } }
        else { nA = has_next ? (const char*)A + (size_t)nxt.pm * BM * lda * 2 + S.koff(nxt) : cA; }
#pragma unroll 1
        for (int t = 0; t < nt; t += 2) {
            const bool last = (t == nt - 2);
            const char* a1 = cA + (size_t)(t + 1) * kstep;
            const char* a2 = last ? nA : cA + (size_t)(t + 2) * kstep; const char* b2 = last ? nB : cB + (size_t)(t + 2) * kstep;
            const char* a3 = a2 + kstep; const char* b3 = b2 + kstep;
            unsigned ao2[2][2];
#pragma unroll
            for (int h = 0; h < 2; ++h)
#pragma unroll
                for (int i = 0; i < 2; ++i) ao2[h][i] = GATHER ? (last ? aon[h][i] : aoc[h][i]) : aoc[h][i];
            PG8_LDB(B0, 0, 0); PG8_LDB(B1, 0, 1); PG8_SCHED; PG8_LDA(At, 0, 0); PG8_STAGE(PG8_SA(1, 1), a1, aoc[1]);
            PG8_WAIT_V(8); PG8_WAIT_L(0); PG8_BAR; PG8_MMA(0, 0, At, B0); PG8_MMA(0, 1, At, B1); PG8_BAR; PG8_SCHED;
            PG8_LDA(At, 0, 1); PG8_STAGE(PG8_SB(0, 0), b2, voffB); PG8_STAGE(PG8_SB(0, 1), b2 + hstepB, voffB); PG8_STAGE(PG8_SA(0, 0), a2, ao2[0]);
            PG8_WAIT_V(8); PG8_WAIT_L(0); PG8_BAR; PG8_MMA(1, 0, At, B0); PG8_MMA(1, 1, At, B1); PG8_BAR; PG8_SCHED;
            PG8_LDB(B0, 1, 0); PG8_LDB(B1, 1, 1); PG8_SCHED; PG8_LDA(At, 1, 0); PG8_STAGE(PG8_SA(0, 1), a2, ao2[1]);
            PG8_WAIT_V(8); PG8_WAIT_L(0); PG8_BAR; PG8_MMA(0, 0, At, B0); PG8_MMA(0, 1, At, B1); PG8_BAR; PG8_SCHED;
            PG8_LDA(At, 1, 1); PG8_STAGE(PG8_SB(1, 0), b3, voffB); PG8_STAGE(PG8_SB(1, 1), b3 + hstepB, voffB); PG8_STAGE(PG8_SA(1, 0), a3, ao2[0]);
            PG8_WAIT_V(8); PG8_WAIT_L(0); PG8_BAR; PG8_MMA(1, 0, At, B0); PG8_MMA(1, 1, At, B1); PG8_BAR; PG8_SCHED;
        }
        if constexpr (FP8) asm volatile("s_nop 15\n\ts_nop 15" ::: "memory");
        if (wr == 0) PG8_BAR;
        E(acc, cur, wr, wc, fr, fq);
        if (!has_next) break;
        if (!S.keep_acc(cur))
#pragma unroll
        for (int a = 0; a < 2; ++a)
#pragma unroll
            for (int b = 0; b < 2; ++b)
#pragma unroll
                for (int m = 0; m < 4; ++m)
#pragma unroll
                    for (int n = 0; n < 2; ++n) acc[a][b][m][n] = (f32x4){0.f, 0.f, 0.f, 0.f};
        cur = nxt; cA = nA; cB = nB; ++ui;
        if constexpr (GATHER) {
#pragma unroll
            for (int h = 0; h < 2; ++h)
#pragma unroll
                for (int i = 0; i < 2; ++i) aoc[h][i] = aon[h][i]; }
        if (wr == 1) PG8_BAR;
    }
    PG8_WAIT_V(0);
    PG8_BAR;
#undef PG8_SA
#undef PG8_SB
#undef PG8_STAGE
#undef PG8_LDA
#undef PG8_LDB
#undef PG8_MMA
#undef PG8_LD8
#undef PG8_WAIT_V
#undef PG8_WAIT_L
#undef PG8_BAR
#undef PG8_SCHED
#undef PG8_GATHER_OFFS
}

struct StaticOrder {
    int nM, nN, nwg, G, c;
    DEV void init(int M, int N, int G_, int c_) { nM = M / BM; nN = N / BM; nwg = nM * nN; G = G_; c = c_; }
    DEV bool next(int i, Unit& u) const {
        const long Lx = (long)i * G + c; if (Lx >= nwg) return false;
        int wgid = (int)Lx; { const int q = nwg / 8, r = nwg % 8, xcd = wgid % 8, off = wgid / 8; wgid = (xcd < r ? xcd * (q + 1) : r * (q + 1) + (xcd - r) * q) + off; }
        const int nig = 8 * nN, gid = wgid / nig, fm = gid * 8, gsz = (nM - fm) < 8 ? (nM - fm) : 8;
        u.pm = fm + ((wgid % nig) % gsz); u.pn = (wgid % nig) / gsz; u.e = 0; u.mt = 0; return true;
    }
    DEV size_t brow(const Unit& u) const { return (size_t)u.pn * BM; }
    DEV size_t koff(const Unit&) const { return 0; }
    DEV bool keep_acc(const Unit&) const { return false; }
};
struct SplitKOrder : StaticOrder {
    int khalf_bytes;
    DEV bool next(int i, Unit& u) const { if (!StaticOrder::next(i >> 1, u)) return false; u.mt = i & 1; return true; }
    DEV size_t koff(const Unit& u) const { return (size_t)u.mt * khalf_bytes; }
    DEV bool keep_acc(const Unit& u) const { return u.mt == 0; }
};
struct MoeOrder {
    volatile LAS int* L; int e_lo, e_hi, NT, G, c, brows;
    DEV bool next(int i, Unit& u) const {
        const int per = G >> 3; int U = (i * 8 + (c & 7)) * per + (c >> 3);
        int e = e_lo;
        for (; e < e_hi; ++e) { const int nu = (((L[LC_CNT + e] + 255) >> 8)) * NT; if (U < nu) break; U -= nu; }
        if (e >= e_hi) return false;
        const int GS = 32 / NT, nm = (L[LC_CNT + e] + 255) >> 8, g = U >> 5, q2 = U - (g << 5);
        const int gsz = (nm - GS * g) < GS ? (nm - GS * g) : GS;
        u.e = e; u.pn = q2 / gsz; u.mt = GS * g + q2 % gsz; u.pm = (L[LC_START + e] >> 8) + u.mt; return true;
    }
    DEV size_t brow(const Unit& u) const { return (size_t)u.e * brows + (size_t)u.pn * BM; }
    DEV size_t koff(const Unit&) const { return 0; }
    DEV bool keep_acc(const Unit&) const { return false; }
};
}

using pg8::Unit;
DEV u32x4 pack8(const f32x4& v0, const f32x4& v1) { u32x4 w; w.x = pg8::cvt_pk_bf16(v0[0], v0[1]); w.y = pg8::cvt_pk_bf16(v0[2], v0[3]); w.z = pg8::cvt_pk_bf16(v1[0], v1[1]); w.w = pg8::cvt_pk_bf16(v1[2], v1[3]); return w; }
struct FEpiZ { static constexpr bool PERM = true, MID = false; bf16* Z1; bf16* Z2;
    DEV void operator()(const f32x4 (&acc)[2][2][4][2], const Unit& u, int wr, int wc, int fr, int fq) const {
        const int row0 = u.pm * 256 + wr * 64 + fr, pn = u.pn;
        bf16* base; int ld, colt, kind;
        if (pn < 7) { base = Z1; ld = Z1W; colt = pn * 256; kind = pn < 2 ? 0 : (pn == 2 ? 1 : 2); } else { base = Z2; ld = Z2W; colt = (pn - 7) * 256; kind = 3; }
        const int col0 = colt + wc * 32 + 8 * fq;
#pragma unroll
        for (int ai = 0; ai < 2; ++ai)
#pragma unroll
            for (int m = 0; m < 4; ++m) { bf16* rowp = base + (size_t)(row0 + ai * 128 + m * 16) * ld + col0;
#pragma unroll
                for (int bj = 0; bj < 2; ++bj) { f32x4 v0 = acc[ai][bj][m][0], v1 = acc[ai][bj][m][1];
                    if (kind == 0) { v0 = v0 * QSCALE; v1 = v1 * QSCALE; }
                    else if (kind == 2) {
#pragma unroll
                        for (int j = 0; j < 4; ++j) { v0[j] = gelu_tanh(v0[j]); v1[j] = gelu_tanh(v1[j]); } }
                    else if (kind == 3) {
#pragma unroll
                        for (int j = 0; j < 4; ++j) { v0[j] = sigmoidf_(v0[j]); v1[j] = sigmoidf_(v1[j]); } }
                    *(u32x4*)(rowp + bj * 128) = pack8(v0, v1); } }
    } };
struct FEpiProjAB { static constexpr bool PERM = true, MID = true; const bf16* Z2; bf16* MRG;
    DEV void mid(f32x4 (&acc)[2][2][4][2], const Unit& u, int wr, int wc, int fr, int fq) const {
        const int row0 = u.pm * 256 + wr * 64 + fr, col0 = u.pn * 256 + wc * 32 + 8 * fq;
#pragma unroll
        for (int ai = 0; ai < 2; ++ai)
#pragma unroll
            for (int m = 0; m < 4; ++m) { const size_t r = (size_t)(row0 + ai * 128 + m * 16);
#pragma unroll
                for (int bj = 0; bj < 2; ++bj) { const u32x4 ga = *(const u32x4*)(Z2 + r * Z2W + col0 + bj * 128), gb = *(const u32x4*)(Z2 + r * Z2W + 1024 + col0 + bj * 128);
                    f32x4 q0 = lo4(gb), q1 = hi4(gb);
#pragma unroll
                    for (int j = 0; j < 4; ++j) { q0[j] = frcp(q0[j]); q1[j] = frcp(q1[j]); }
                    acc[ai][bj][m][0] = acc[ai][bj][m][0] * (lo4(ga) * q0); acc[ai][bj][m][1] = acc[ai][bj][m][1] * (hi4(ga) * q1);
                    asm volatile("" : "+v"(acc[ai][bj][m][0]), "+v"(acc[ai][bj][m][1]) :: "memory"); } }
    }
    DEV void operator()(f32x4 (&acc)[2][2][4][2], const Unit& u, int wr, int wc, int fr, int fq) const {
        if (u.mt == 0) { mid(acc, u, wr, wc, fr, fq); return; }
        const int row0 = u.pm * 256 + wr * 64 + fr, col0 = u.pn * 256 + wc * 32 + 8 * fq;
#pragma unroll
        for (int ai = 0; ai < 2; ++ai)
#pragma unroll
            for (int m = 0; m < 4; ++m) { const size_t r = (size_t)(row0 + ai * 128 + m * 16);
#pragma unroll
                for (int bj = 0; bj < 2; ++bj) { const u32x4 gb = *(const u32x4*)(Z2 + r * Z2W + 1024 + col0 + bj * 128);
                    *(u32x4*)(MRG + r * D + col0 + bj * 128) = pack8(acc[ai][bj][m][0] * lo4(gb), acc[ai][bj][m][1] * hi4(gb)); } }
    } };
struct FEpiProjA { static constexpr bool PERM = true, MID = false; const bf16* Z2; bf16* TMP;
    DEV void operator()(const f32x4 (&acc)[2][2][4][2], const Unit& u, int wr, int wc, int fr, int fq) const {
        const int row0 = u.pm * 256 + wr * 64 + fr, col0 = u.pn * 256 + wc * 32 + 8 * fq;
#pragma unroll
        for (int ai = 0; ai < 2; ++ai)
#pragma unroll
            for (int m = 0; m < 4; ++m) { const size_t r = (size_t)(row0 + ai * 128 + m * 16);
#pragma unroll
                for (int bj = 0; bj < 2; ++bj) { const u32x4 g = *(const u32x4*)(Z2 + r * Z2W + col0 + bj * 128);
                    *(u32x4*)(TMP + r * D + col0 + bj * 128) = pack8(acc[ai][bj][m][0] * lo4(g), acc[ai][bj][m][1] * hi4(g)); } }
    } };
struct FEpiProjB { static constexpr bool PERM = true, MID = false; const bf16* Z2; const bf16* TMP; bf16* MRG;
    DEV void operator()(const f32x4 (&acc)[2][2][4][2], const Unit& u, int wr, int wc, int fr, int fq) const {
        const int row0 = u.pm * 256 + wr * 64 + fr, col0 = u.pn * 256 + wc * 32 + 8 * fq;
#pragma unroll
        for (int ai = 0; ai < 2; ++ai)
#pragma unroll
            for (int m = 0; m < 4; ++m) { const size_t r = (size_t)(row0 + ai * 128 + m * 16);
#pragma unroll
                for (int bj = 0; bj < 2; ++bj) { const u32x4 g = *(const u32x4*)(Z2 + r * Z2W + 1024 + col0 + bj * 128); const u32x4 t = *(const u32x4*)(TMP + r * D + col0 + bj * 128);
                    *(u32x4*)(MRG + r * D + col0 + bj * 128) = pack8(lo4(t) + acc[ai][bj][m][0] * lo4(g), hi4(t) + acc[ai][bj][m][1] * hi4(g)); } }
    } };
struct FEpiResidB { static constexpr bool PERM = true, MID = false; const float* base; bf16* out;
    DEV void operator()(const f32x4 (&acc)[2][2][4][2], const Unit& u, int wr, int wc, int fr, int fq) const {
        const int row0 = u.pm * 256 + wr * 64 + fr, col0 = u.pn * 256 + wc * 32 + 8 * fq;
#pragma unroll
        for (int ai = 0; ai < 2; ++ai)
#pragma unroll
            for (int m = 0; m < 4; ++m) { const size_t off = (size_t)(row0 + ai * 128 + m * 16) * D + col0;
#pragma unroll
                for (int bj = 0; bj < 2; ++bj) { const f32x4 x0 = *(const f32x4*)(base + off + bj * 128), x1 = *(const f32x4*)(base + off + bj * 128 + 4);
                    *(u32x4*)(out + off + bj * 128) = pack8(x0 + acc[ai][bj][m][0], x1 + acc[ai][bj][m][1]); } }
    } };
struct FEpiResid { static constexpr bool PERM = false, MID = false; const float* base; float* out;
    DEV void operator()(const f32x4 (&acc)[2][2][4][2], const Unit& u, int wr, int wc, int fr, int fq) const {
        const int row0 = u.pm * 256 + wr * 64 + fr, col0 = u.pn * 256 + wc * 32 + 4 * fq;
#pragma unroll
        for (int ai = 0; ai < 2; ++ai)
#pragma unroll
            for (int m = 0; m < 4; ++m) { const size_t off = (size_t)(row0 + ai * 128 + m * 16) * D + col0;
#pragma unroll
                for (int bj = 0; bj < 2; ++bj)
#pragma unroll
                    for (int n = 0; n < 2; ++n) *(f32x4*)(out + off + bj * 128 + n * 16) = *(const f32x4*)(base + off + bj * 128 + n * 16) + acc[ai][bj][m][n]; }
    } };
struct FEpiMoeUp { static constexpr bool PERM = true, MID = false; const float* b_gate; const float* b_up; bf16* ACT; const float* srs;
    DEV void operator()(const f32x4 (&acc)[2][2][4][2], const Unit& u, int wr, int wc, int fr, int fq) const {
        const int row0 = u.pm * 256 + wr * 64 + fr, f0 = u.pn * 128 + wc * 32 + 8 * fq;
        const f32x4 bg0 = *(const f32x4*)(b_gate + u.e * FF + f0), bg1 = *(const f32x4*)(b_gate + u.e * FF + f0 + 4), bu0 = *(const f32x4*)(b_up + u.e * FF + f0), bu1 = *(const f32x4*)(b_up + u.e * FF + f0 + 4);
#pragma unroll
        for (int ai = 0; ai < 2; ++ai)
#pragma unroll
            for (int m = 0; m < 4; ++m) { const float rr_ = srs[(size_t)u.e * T + u.mt * 256 + ai * 128 + wr * 64 + m * 16 + fr];
                f32x4 a0 = acc[ai][0][m][0] * rr_ + bg0, a1 = acc[ai][0][m][1] * rr_ + bg1, b0 = acc[ai][1][m][0] * rr_ + bu0, b1 = acc[ai][1][m][1] * rr_ + bu1;
#pragma unroll
                for (int j = 0; j < 4; ++j) { a0[j] = swiglu(a0[j], b0[j]); a1[j] = swiglu(a1[j], b1[j]); }
                *(u32x4*)(ACT + (size_t)(row0 + ai * 128 + m * 16) * FF + f0) = pack8(a0, a1); }
    } };
struct FEpiMoeUp8 { static constexpr bool PERM = true, MID = false; const float* b_gate; const float* b_up; unsigned char* ACT; const float* srs;
    DEV void operator()(const f32x4 (&acc)[2][2][4][2], const Unit& u, int wr, int wc, int fr, int fq) const {
        const int row0 = u.pm * 256 + wr * 64 + fr, f0 = u.pn * 128 + wc * 32 + 8 * fq;
        const f32x4 bg0 = *(const f32x4*)(b_gate + u.e * FF + f0), bg1 = *(const f32x4*)(b_gate + u.e * FF + f0 + 4), bu0 = *(const f32x4*)(b_up + u.e * FF + f0), bu1 = *(const f32x4*)(b_up + u.e * FF + f0 + 4);
#pragma unroll
        for (int ai = 0; ai < 2; ++ai)
#pragma unroll
            for (int m = 0; m < 4; ++m) { const float rr_ = srs[(size_t)u.e * T + u.mt * 256 + ai * 128 + wr * 64 + m * 16 + fr] * W8_INV;
                f32x4 a0 = acc[ai][0][m][0] * rr_ + bg0, a1 = acc[ai][0][m][1] * rr_ + bg1, b0 = acc[ai][1][m][0] * rr_ + bu0, b1 = acc[ai][1][m][1] * rr_ + bu1;
#pragma unroll
                for (int j = 0; j < 4; ++j) { a0[j] = swiglu(a0[j], b0[j]); a1[j] = swiglu(a1[j], b1[j]); }
                *(u32x2*)(ACT + (size_t)(row0 + ai * 128 + m * 16) * FF + f0) = (u32x2){pk4_fp8(a0[0], a0[1], a0[2], a0[3]), pk4_fp8(a1[0], a1[1], a1[2], a1[3])}; }
    } };
struct FEpiMoeDown8 { static constexpr bool PERM = true, MID = false; const float* b_down; unsigned char* Y;
    DEV void operator()(const f32x4 (&acc)[2][2][4][2], const Unit& u, int wr, int wc, int fr, int fq) const {
        const int row0 = u.pm * 256 + wr * 64 + fr, col0 = u.pn * 256 + wc * 32 + 8 * fq;
        f32x4 bv[2][2];
#pragma unroll
        for (int bj = 0; bj < 2; ++bj)
#pragma unroll
            for (int n = 0; n < 2; ++n) bv[bj][n] = *(const f32x4*)(b_down + u.e * D + col0 + bj * 128 + 4 * n);
#pragma unroll
        for (int ai = 0; ai < 2; ++ai)
#pragma unroll
            for (int m = 0; m < 4; ++m) { unsigned char* rowp = Y + (size_t)(row0 + ai * 128 + m * 16) * D + col0;
#pragma unroll
                for (int bj = 0; bj < 2; ++bj) { const f32x4 y0 = acc[ai][bj][m][0] * W8_INV + bv[bj][0], y1 = acc[ai][bj][m][1] * W8_INV + bv[bj][1];
                    *(u32x2*)(rowp + bj * 128) = (u32x2){pk4_fp8(y0[0], y0[1], y0[2], y0[3]), pk4_fp8(y1[0], y1[1], y1[2], y1[3])}; } }
    } };
struct FEpiMoeDown { static constexpr bool PERM = true, MID = false; const float* b_down; bf16* Y;
    DEV void operator()(const f32x4 (&acc)[2][2][4][2], const Unit& u, int wr, int wc, int fr, int fq) const {
        const int row0 = u.pm * 256 + wr * 64 + fr, col0 = u.pn * 256 + wc * 32 + 8 * fq;
        f32x4 bv[2][2];
#pragma unroll
        for (int bj = 0; bj < 2; ++bj)
#pragma unroll
            for (int n = 0; n < 2; ++n) bv[bj][n] = *(const f32x4*)(b_down + u.e * D + col0 + bj * 128 + 4 * n);
#pragma unroll
        for (int ai = 0; ai < 2; ++ai)
#pragma unroll
            for (int m = 0; m < 4; ++m) { bf16* rowp = Y + (size_t)(row0 + ai * 128 + m * 16) * D + col0;
#pragma unroll
                for (int bj = 0; bj < 2; ++bj) *(u32x4*)(rowp + bj * 128) = pack8(acc[ai][bj][m][0] + bv[bj][0], acc[ai][bj][m][1] + bv[bj][1]); }
    } };
struct FEpiBf16 { static constexpr bool PERM = true, MID = false; bf16* O; int ldc;
    DEV void operator()(const f32x4 (&acc)[2][2][4][2], const Unit& u, int wr, int wc, int fr, int fq) const {
        const int row0 = u.pm * 256 + wr * 64 + fr, col0 = u.pn * 256 + wc * 32 + 8 * fq;
#pragma unroll
        for (int ai = 0; ai < 2; ++ai)
#pragma unroll
            for (int m = 0; m < 4; ++m) { bf16* rowp = O + (size_t)(row0 + ai * 128 + m * 16) * ldc + col0;
#pragma unroll
                for (int bj = 0; bj < 2; ++bj) *(u32x4*)(rowp + bj * 128) = pack8(acc[ai][bj][m][0], acc[ai][bj][m][1]); }
    } };
struct FEpiPle8 { static constexpr bool PERM = true, MID = false; const bf16* PP; const bf16* X2; bf16* X3;
    DEV void operator()(const f32x4 (&acc)[2][2][4][2], const Unit& u, int wr, int wc, int fr, int fq) const {
        const int row0 = u.pm * 256 + wr * 64 + fr, col0 = u.pn * 256 + wc * 32 + 8 * fq;
#pragma unroll
        for (int ai = 0; ai < 2; ++ai)
#pragma unroll
            for (int m = 0; m < 4; ++m) { const size_t off = (size_t)(row0 + ai * 128 + m * 16) * D + col0;
#pragma unroll
                for (int bj = 0; bj < 2; ++bj) { const u32x4 pw = *(const u32x4*)(PP + off + bj * 128), xw = *(const u32x4*)(X2 + off + bj * 128);
                    f32x4 g0 = acc[ai][bj][m][0] * W8_INV, g1 = acc[ai][bj][m][1] * W8_INV;
#pragma unroll
                    for (int j = 0; j < 4; ++j) { g0[j] = sigmoidf_(g0[j]); g1[j] = sigmoidf_(g1[j]); }
                    *(u32x4*)(X3 + off + bj * 128) = pack8(lo4(xw) + g0 * lo4(pw), hi4(xw) + g1 * hi4(pw)); }
                asm volatile("" ::: "memory"); }
    } };
struct FEpiPle { static constexpr bool PERM = false, MID = false; const bf16* PP; float* out;
    DEV void operator()(const f32x4 (&acc)[2][2][4][2], const Unit& u, int wr, int wc, int fr, int fq) const {
        const int row0 = u.pm * 256 + wr * 64 + fr, col0 = u.pn * 256 + wc * 32 + 4 * fq;
#pragma unroll
        for (int ai = 0; ai < 2; ++ai)
#pragma unroll
            for (int m = 0; m < 4; ++m) { const size_t off = (size_t)(row0 + ai * 128 + m * 16) * D + col0;
#pragma unroll
                for (int bj = 0; bj < 2; ++bj)
#pragma unroll
                    for (int n = 0; n < 2; ++n) { const size_t o = off + bj * 128 + n * 16; const u32x2 pw = *(const u32x2*)(PP + o); const f32x4 a = acc[ai][bj][m][n];
                        f32x4 r = *(const f32x4*)(out + o);
                        r[0] += sigmoidf_(a[0]) * bflo(pw.x); r[1] += sigmoidf_(a[1]) * bfhi(pw.x); r[2] += sigmoidf_(a[2]) * bflo(pw.y); r[3] += sigmoidf_(a[3]) * bfhi(pw.y);
                        *(f32x4*)(out + o) = r; }
                asm volatile("" ::: "memory"); }
    } };


#define MFMA32(a, b, c) __builtin_amdgcn_mfma_f32_32x32x16_bf16((a), (b), (c), 0, 0, 0)
DEV void phase_mixers_fast(Frame& F, const Args& a) {
    const bf16* Z1 = (const bf16*)(a.ws + WS_Z1); bf16* AP = (bf16*)(a.ws + WS_AP);
    const int tid = F.tid, lane = F.lane, r = lane & 31, h = lane >> 5, wave = F.wave;
    {
        LAS unsigned char* Kl = F.lds;
        LAS unsigned char* Vl = F.lds + 36864;
        LAS float* wsf = (LAS float*)(F.lds + 70144) + wave * 64;
        const float* sinks = a.in[4];
        for (int u = F.vcu; u < 512; u += F.G) {
            const int kvh = u & 1, bn = u >> 1, b = bn >> 4, n = bn & 15;
            const int tok0 = b * SEQ + n * 128, key0 = tok0 - 128;
            __syncthreads();
#pragma unroll
            for (int i = 0; i < 4; ++i) { const int idx = tid + 512 * i, key = idx >> 3, ch = idx & 7;
                u32x4 v = (u32x4){0u, 0u, 0u, 0u};
                if (n > 0 || key >= 128) v = *(const u32x4*)(Z1 + (size_t)(key0 + key) * Z1W + 512 + kvh * 64 + ch * 8);
                *(LAS u32x4*)(Kl + key * 144 + ch * 16) = v; }
#pragma unroll
            for (int i = 0; i < 2; ++i) { const int idx = tid + 512 * i, kp = idx >> 3, ch = idx & 7;
                u32x4 v0 = (u32x4){0u, 0u, 0u, 0u}, v1 = v0;
                if (n > 0 || kp >= 64) { const bf16* vp = Z1 + (size_t)(key0 + 2 * kp) * Z1W + 640 + kvh * 64 + ch * 8; v0 = *(const u32x4*)vp; v1 = *(const u32x4*)(vp + Z1W); }
                LAS unsigned char* dst = Vl + (ch * 8) * 520 + kp * 4;
                *(LAS unsigned*)(dst + 0 * 520) = (v0.x & 0xffffu) | (v1.x << 16); *(LAS unsigned*)(dst + 1 * 520) = (v0.x >> 16) | (v1.x & 0xffff0000u);
                *(LAS unsigned*)(dst + 2 * 520) = (v0.y & 0xffffu) | (v1.y << 16); *(LAS unsigned*)(dst + 3 * 520) = (v0.y >> 16) | (v1.y & 0xffff0000u);
                *(LAS unsigned*)(dst + 4 * 520) = (v0.z & 0xffffu) | (v1.z << 16); *(LAS unsigned*)(dst + 5 * 520) = (v0.z >> 16) | (v1.z & 0xffff0000u);
                *(LAS unsigned*)(dst + 6 * 520) = (v0.w & 0xffffu) | (v1.w << 16); *(LAS unsigned*)(dst + 7 * 520) = (v0.w >> 16) | (v1.w & 0xffff0000u); }
            __syncthreads();
            const int g = wave >> 1, qh = wave & 1, hh = kvh * 4 + g;
            const float slope2 = fexp2(-(float)(hh + 1)) * LOG2E, sink2 = sinks[hh] * LOG2E;
#pragma unroll 1
            for (int qs = 0; qs < 2; ++qs) {
                const int q0 = qh * 64 + qs * 32, kt0 = q0 >> 5, ql = q0 + r;
                bf16x8 qf[4];
#pragma unroll
                for (int ds = 0; ds < 4; ++ds) qf[ds] = *(const bf16x8*)(Z1 + (size_t)(tok0 + ql) * Z1W + hh * 64 + 16 * ds + 8 * h);
                f32x16 p[5];
#pragma unroll
                for (int t = 0; t < 5; ++t) {
#pragma unroll
                    for (int i = 0; i < 16; ++i) p[t][i] = 0.f;
                    const LAS unsigned char* kb = Kl + (32 * (kt0 + t) + r) * 144 + 16 * h;
#pragma unroll
                    for (int ds = 0; ds < 4; ++ds) p[t] = MFMA32(*(const LAS bf16x8*)(kb + 32 * ds), qf[ds], p[t]);
                }
                float mx = sink2;
#pragma unroll
                for (int t = 0; t < 5; ++t)
#pragma unroll
                    for (int i = 0; i < 16; ++i) { const int sk = 32 * (kt0 + t) + crow(i, h), dist = ql + 128 - sk;
                        const bool ok = ((unsigned)dist < 128u) && (n > 0 || sk >= 128);
                        const float v = ok ? p[t][i] - slope2 * (float)dist : -INFINITY; p[t][i] = v; mx = fmaxf(mx, v); }
                mx = fmaxf(mx, __shfl_xor(mx, 32));
                float ls = 0.f;
#pragma unroll
                for (int t = 0; t < 5; ++t)
#pragma unroll
                    for (int i = 0; i < 16; ++i) { const float e = fexp2(p[t][i] - mx); p[t][i] = e; ls += e; }
                ls += __shfl_xor(ls, 32); ls += fexp2(sink2 - mx);
                f32x16 o[2];
#pragma unroll
                for (int i = 0; i < 16; ++i) { o[0][i] = 0.f; o[1][i] = 0.f; }
#pragma unroll
                for (int t = 0; t < 5; ++t)
#pragma unroll
                    for (int s2 = 0; s2 < 2; ++s2) {
                        u32x4 pw; pw.x = pg8::cvt_pk_bf16(p[t][8 * s2 + 0], p[t][8 * s2 + 1]); pw.y = pg8::cvt_pk_bf16(p[t][8 * s2 + 2], p[t][8 * s2 + 3]);
                        pw.z = pg8::cvt_pk_bf16(p[t][8 * s2 + 4], p[t][8 * s2 + 5]); pw.w = pg8::cvt_pk_bf16(p[t][8 * s2 + 6], p[t][8 * s2 + 7]);
                        const bf16x8 pf = __builtin_bit_cast(bf16x8, pw);
#pragma unroll
                        for (int db = 0; db < 2; ++db) { const LAS unsigned char* vb = Vl + (db * 32 + r) * 520 + (32 * (kt0 + t) + 16 * s2 + 4 * h) * 2;
                            const u32x2 lo = *(const LAS u32x2*)vb, hi = *(const LAS u32x2*)(vb + 16);
                            u32x4 vw; vw.x = lo.x; vw.y = lo.y; vw.z = hi.x; vw.w = hi.y;
                            o[db] = MFMA32(pf, __builtin_bit_cast(bf16x8, vw), o[db]); }
                    }
                asm volatile("" ::: "memory");
                if (h == 0) wsf[r] = ls;
                asm volatile("s_waitcnt lgkmcnt(0)" ::: "memory");
                bf16* op = AP + (size_t)tok0 * D + hh * 64 + r;
#pragma unroll
                for (int i = 0; i < 16; ++i) { const int q = q0 + crow(i, h); const float il = frcp(wsf[crow(i, h)]);
                    op[(size_t)q * D] = (bf16)f2bf(o[0][i] * il); op[(size_t)q * D + 32] = (bf16)f2bf(o[1][i] * il); }
                asm volatile("s_waitcnt lgkmcnt(0)" ::: "memory");
            }
        }
    }
    {
        LAS unsigned char* vT = F.lds;
        LAS float* stl = (LAS float*)(F.lds + 69632);
        const bf16* Wsp = (const bf16*)(a.ws + WS_WSP); const float* g_ln = a.in[5]; const float* b_ln = a.in[6]; const float* b_sp = a.in[8];
        for (int u = F.vcu; u < 256; u += F.G) {
            const int tok0 = u * 128;
            __syncthreads();
            { float part[32];
#pragma unroll
              for (int rr = 0; rr < 16; ++rr) { const u32x4 w = *((const u32x4*)(Z1 + (size_t)(tok0 + wave * 16 + rr) * Z1W + 1280) + lane);
                  const float v0 = bflo(w.x), v1 = bfhi(w.x), v2 = bflo(w.y), v3 = bfhi(w.y), v4 = bflo(w.z), v5 = bfhi(w.z), v6 = bflo(w.w), v7 = bfhi(w.w);
                  part[2 * rr] = ((v0 + v1) + (v2 + v3)) + ((v4 + v5) + (v6 + v7));
                  part[2 * rr + 1] = ((v0 * v0 + v1 * v1) + (v2 * v2 + v3 * v3)) + ((v4 * v4 + v5 * v5) + (v6 * v6 + v7 * v7)); }
#define TR_STEP(N, BIT, XM) { const bool hb = (lane >> BIT) & 1; _Pragma("unroll") for (int i = 0; i < N; ++i) { const float keep = hb ? part[i + N] : part[i]; const float send = hb ? part[i] : part[i + N]; part[i] = keep + __shfl_xor(send, XM); } }
              TR_STEP(16, 5, 32) TR_STEP(8, 4, 16) TR_STEP(4, 3, 8) TR_STEP(2, 2, 4) TR_STEP(1, 1, 2)
#undef TR_STEP
              const float tot = part[0] + __shfl_xor(part[0], 1);
              const float oth = __shfl_xor(tot, 2);
              if ((lane & 3) == 0) { const int t = wave * 16 + (lane >> 2); const float mean = tot * (1.f / 512.f); const float var = fmaxf(oth * (1.f / 512.f) - mean * mean, 0.f);
                  stl[2 * t] = mean; stl[2 * t + 1] = 1.0f / sqrtf(var + LN_EPS); } }
#pragma unroll 1
            for (int hf = 0; hf < 2; ++hf) {
                __syncthreads();
#pragma unroll
                for (int i = 0; i < 4; ++i) { const int c8 = wave * 4 + i, tp = lane, ch0 = 256 * hf + 8 * c8;
                    const bf16* vp = Z1 + (size_t)(tok0 + 2 * tp) * Z1W + 1280 + ch0;
                    const u32x4 w0 = *(const u32x4*)vp, w1 = *(const u32x4*)(vp + Z1W);
                    const float m0 = stl[4 * tp], r0 = stl[4 * tp + 1], m1 = stl[4 * tp + 2], r1 = stl[4 * tp + 3];
                    const f32x4 ga = *(const f32x4*)(g_ln + ch0), gb = *(const f32x4*)(g_ln + ch0 + 4), ba = *(const f32x4*)(b_ln + ch0), bb = *(const f32x4*)(b_ln + ch0 + 4);
                    LAS unsigned char* dst = vT + (8 * c8) * 272 + tp * 4;
#define VT_W(j, w0c, w1c, gg, bbv, SEL) *(LAS unsigned*)(dst + (j) * 272) = pg8::cvt_pk_bf16((SEL(w0c) - m0) * r0 * (gg) + (bbv), (SEL(w1c) - m1) * r1 * (gg) + (bbv))
                    VT_W(0, w0.x, w1.x, ga.x, ba.x, bflo); VT_W(1, w0.x, w1.x, ga.y, ba.y, bfhi); VT_W(2, w0.y, w1.y, ga.z, ba.z, bflo); VT_W(3, w0.y, w1.y, ga.w, ba.w, bfhi);
                    VT_W(4, w0.z, w1.z, gb.x, bb.x, bflo); VT_W(5, w0.z, w1.z, gb.y, bb.y, bfhi); VT_W(6, w0.w, w1.w, gb.z, bb.z, bflo); VT_W(7, w0.w, w1.w, gb.w, bb.w, bfhi);
#undef VT_W
                }
                __syncthreads();
                const int gl = wave >> 2, cq = wave & 3, g = 2 * hf + gl, chb = gl * 128 + cq * 32;
                const int chg = 256 * hf + chb + r;
#pragma unroll 1
                for (int tt = 0; tt < 4; ++tt) {
                    f32x16 acc;
#pragma unroll
                    for (int i = 0; i < 16; ++i) acc[i] = 0.f;
                    const bf16* wp = Wsp + ((size_t)g * 128 + 32 * tt + r) * 128 + 8 * h;
                    const LAS unsigned char* bp = vT + (chb + r) * 272 + 16 * h;
                    bf16x8 wf[8];
#pragma unroll
                    for (int ss = 0; ss < 8; ++ss) wf[ss] = *(const bf16x8*)(wp + 16 * ss);
                    float uu[16];
#pragma unroll
                    for (int i = 0; i < 16; ++i) uu[i] = bf2f(Z1[(size_t)(tok0 + 32 * tt + crow(i, h)) * Z1W + 768 + chg]);
#pragma unroll
                    for (int ss = 0; ss < 8; ++ss) if (ss < 2 * tt + 2) acc = MFMA32(wf[ss], *(const LAS bf16x8*)(bp + 32 * ss), acc);
#pragma unroll
                    for (int i = 0; i < 16; ++i) { const int t = 32 * tt + crow(i, h); const size_t tok = (size_t)(tok0 + t);
                        AP[tok * D + 512 + chg] = (bf16)f2bf(uu[i] * (acc[i] + b_sp[g * 128 + t])); }
                }
            }
        }
    }
    __syncthreads();
}

constexpr int NPHASES = 14;
__global__ void __launch_bounds__(NTHREADS, 2) fwd(Args a) {
    extern __shared__ __attribute__((aligned(16))) unsigned char lds_raw[];
    Frame F;
    F.lds = (LAS unsigned char*)lds_raw;
    F.tid = threadIdx.x; F.lane = F.tid & 63; F.wave = __builtin_amdgcn_readfirstlane(F.tid >> 6);
    F.G = gridDim.x; { const int bx = blockIdx.x; F.vcu = (F.G % 8 == 0) ? (bx % 8) * (F.G / 8) + bx / 8 : bx; }
    F.gw = F.vcu * NWAVES + F.wave; F.NGW = F.G * NWAVES;
    for (int u = F.tid; u < (LDS_BYTES - LDS_CTL) / 4; u += NTHREADS) ((LAS unsigned*)(F.lds + LDS_CTL))[u] = 0u;
    __syncthreads();
    unsigned* ctl = (unsigned*)(a.ws + WS_CTL);
    const bool one = (a.ph_hi - a.ph_lo) > 1;
    XcdBarrier bar; bar.bar = ctl + CW_BAR; bar.x = 0; bar.st = nullptr;
    if (one) bar = xcd_barrier_post(ctl + CW_BAR, (volatile LAS unsigned*)(F.lds + LDS_CTL) + LC_BAR);
    unsigned char* ws = a.ws;
#define IN(k) (a.ph_lo <= (k) && (k) < a.ph_hi)
#define SEAM(k) do { if (IN(k) && IN((k) + 1)) xcd_barrier(bar); } while (0)
    if (IN(0)) { phase_prologue(F, a); } SEAM(0);
    volatile LAS int* Lc = (volatile LAS int*)(F.lds + LDS_CTL);
#if FAST_G1
    if (IN(1)) { FEpiZ E{(bf16*)(ws + WS_Z1), (bf16*)(ws + WS_Z2)}; pg8::StaticOrder S; S.init(T, NZ, F.G, (int)blockIdx.x);
        pg8::gemm_phase<FEpiZ, pg8::StaticOrder, false>(F.lds, (const bf16*)a.out, D, (const bf16*)(ws + WS_WIN), D, D, S, E, nullptr, Lc); } SEAM(1);
#else
    if (IN(1)) { EpiZ E{(bf16*)(ws + WS_Z1), (bf16*)(ws + WS_Z2)}; ngemm_wave((const bf16*)a.out, D, (const bf16*)(ws + WS_WIN), D, T / 32, NZ / 32, D, F, E); } SEAM(1);
#endif
#if FAST_MIX
    if (IN(3)) { phase_mixers_fast(F, a); } SEAM(3);
#else
    if (IN(2)) { phase_lnstats(F, a); } SEAM(2);
    if (IN(3)) { phase_mixers_ref(F, a); } SEAM(3);
#endif
#if FAST_G4
    if (IN(4)) { FEpiProjAB E{(const bf16*)(ws + WS_Z2), (bf16*)(ws + WS_MRG)}; pg8::SplitKOrder S; S.init(T, D, F.G, (int)blockIdx.x); S.khalf_bytes = 1024;
        pg8::gemm_phase<FEpiProjAB, pg8::SplitKOrder, false>(F.lds, (const bf16*)(ws + WS_AP), D, (const bf16*)(ws + WS_WAB), D, 512, S, E, nullptr, Lc); } SEAM(4);
    if (IN(6)) { FEpiResidB E{a.in[0], (bf16*)a.out}; pg8::StaticOrder S; S.init(T, D, F.G, (int)blockIdx.x);
        pg8::gemm_phase<FEpiResidB, pg8::StaticOrder, false>(F.lds, (const bf16*)(ws + WS_MRG), D, (const bf16*)(ws + WS_WOUT), D, D, S, E, nullptr, Lc); } SEAM(6);
#else
    if (IN(4)) { EpiProjA E{(const bf16*)(ws + WS_Z2), (bf16*)(ws + WS_TMP)}; ngemm_wave((const bf16*)(ws + WS_AP), D, (const bf16*)(ws + WS_WAB), D, T / 32, D / 32, 512, F, E); } SEAM(4);
    if (IN(5)) { EpiProjB E{(const bf16*)(ws + WS_Z2), (const bf16*)(ws + WS_TMP), (bf16*)(ws + WS_MRG)}; ngemm_wave((const bf16*)(ws + WS_AP) + 512, D, (const bf16*)(ws + WS_WAB) + 512, D, T / 32, D / 32, 512, F, E); } SEAM(5);
    if (IN(6)) { EpiResid E{a.in[0], a.out}; ngemm_wave((const bf16*)(ws + WS_MRG), D, (const bf16*)(ws + WS_WOUT), D, T / 32, D / 32, D, F, E); } SEAM(6);
#endif
    if (IN(7)) { phase_router2(F, a); } SEAM(7);
#if FAST_MOE && FP8_MOE
    if (IN(8)) { moe_layout(F, a); FEpiMoeUp8 E{a.in[16], a.in[18], ws + WS_ACT8, (const float*)(ws + WS_SRS8)}; pg8::MoeOrder S{Lc, 0, NE, 8, F.G, (int)blockIdx.x, 2048};
        pg8::gemm_phase<FEpiMoeUp8, pg8::MoeOrder, true, true>(F.lds, (const bf16*)(ws + WS_H2Q), D / 2, (const bf16*)(ws + WS_WGU8), D / 2, D / 2, S, E, (const int*)(ws + WS_LIST), Lc); } SEAM(8);
    if (IN(9)) { moe_layout(F, a);
        { bf16* PB = (bf16*)(ws + WS_PB8); for (int m = F.gw; m < T; m += F.NGW) { const f32x4 pv = *((const f32x4*)(a.in[1] + (size_t)m * PLE) + F.lane); *((u32x2*)(PB + (size_t)m * PLE) + F.lane) = (u32x2){pk2(pv.x, pv.y), pk2(pv.z, pv.w)}; } }
        FEpiMoeDown8 E{a.in[20], ws + WS_Y}; pg8::MoeOrder S{Lc, 0, NE, 4, F.G, (int)blockIdx.x, 1024};
        pg8::gemm_phase<FEpiMoeDown8, pg8::MoeOrder, false, true>(F.lds, (const bf16*)(ws + WS_ACT8), FF / 2, (const bf16*)(ws + WS_WD8), FF / 2, FF / 2, S, E, nullptr, Lc); } SEAM(9);
#elif FAST_MOE
    if (IN(8)) { moe_layout(F, a); FEpiMoeUp E{a.in[16], a.in[18], (bf16*)(ws + WS_ACT), (const float*)(ws + WS_SRS2)}; pg8::MoeOrder S{Lc, 0, NE, 8, F.G, (int)blockIdx.x, 2048};
        pg8::gemm_phase<FEpiMoeUp, pg8::MoeOrder, true>(F.lds, (const bf16*)(ws + WS_H2), D, (const bf16*)(ws + WS_WGU), D, D, S, E, (const int*)(ws + WS_LIST), Lc); } SEAM(8);
    if (IN(9)) { moe_layout(F, a); FEpiMoeDown E{a.in[20], (bf16*)(ws + WS_Y0)}; pg8::MoeOrder S{Lc, 0, Lc[LC_SPLIT], 4, F.G, (int)blockIdx.x, 1024};
        pg8::gemm_phase<FEpiMoeDown, pg8::MoeOrder, false>(F.lds, (const bf16*)(ws + WS_ACT), FF, (const bf16*)(ws + WS_WD), FF, FF, S, E, nullptr, Lc); } SEAM(9);
    if (IN(10)) { moe_layout(F, a); const int srow = Lc[LC_START + Lc[LC_SPLIT]]; FEpiMoeDown E{a.in[20], (bf16*)(ws + WS_Y1) - (size_t)srow * D}; pg8::MoeOrder S{Lc, Lc[LC_SPLIT], NE, 4, F.G, (int)blockIdx.x, 1024};
        pg8::gemm_phase<FEpiMoeDown, pg8::MoeOrder, false>(F.lds, (const bf16*)(ws + WS_ACT), FF, (const bf16*)(ws + WS_WD), FF, FF, S, E, nullptr, Lc); } SEAM(10);
#else
    if (IN(8)) { phase_moe_up_ref(F, a); } SEAM(8);
    if (IN(9)) { phase_moe_down_ref(F, a, 0); } SEAM(9);
    if (IN(10)) { phase_moe_down_ref(F, a, 1); } SEAM(10);
#endif
#if FAST_G11
    if (IN(11)) { phase_combine(F, a); __syncthreads(); FEpiBf16 E{(bf16*)(ws + (FP8_MOE ? WS_PP8 : WS_PP)), D}; pg8::StaticOrder S; S.init(T, D, F.G, (int)blockIdx.x);
        pg8::gemm_phase<FEpiBf16, pg8::StaticOrder, false>(F.lds, (const bf16*)(ws + (FP8_MOE ? WS_PB8 : WS_PB)), PLE, (const bf16*)(ws + WS_WPP), PLE, PLE, S, E, nullptr, Lc); } SEAM(11);
#if FP8_MOE
    if (IN(12)) { FEpiPle8 E{(const bf16*)(ws + WS_PP8), (const bf16*)(ws + WS_X2B), (bf16*)(ws + WS_X3B)}; pg8::StaticOrder S; S.init(T, D, F.G, (int)blockIdx.x);
        pg8::gemm_phase<FEpiPle8, pg8::StaticOrder, false, true>(F.lds, (const bf16*)(ws + WS_HP8), D / 2, (const bf16*)(ws + WS_WPG8), D / 2, D / 2, S, E, nullptr, Lc); } SEAM(12);
#else
    if (IN(12)) { FEpiPle E{(const bf16*)(ws + (FP8_MOE ? WS_PP8 : WS_PP)), a.out}; pg8::StaticOrder S; S.init(T, D, F.G, (int)blockIdx.x);
        pg8::gemm_phase<FEpiPle, pg8::StaticOrder, false>(F.lds, (const bf16*)(ws + (FP8_MOE ? WS_HP8 : WS_HP)), D, (const bf16*)(ws + WS_WPG), D, D, S, E, nullptr, Lc); } SEAM(12);
#endif
#else
    if (IN(11)) { phase_combine(F, a); EpiStoreBf16 E{(bf16*)(ws + WS_PP), D}; ngemm_wave((const bf16*)(ws + WS_PB), PLE, (const bf16*)(ws + WS_WPP), PLE, T / 32, D / 32, PLE, F, E); } SEAM(11);
    if (IN(12)) { EpiPle E{(const bf16*)(ws + WS_PP), a.out}; ngemm_wave((const bf16*)(ws + WS_HP), D, (const bf16*)(ws + WS_WPG), D, T / 32, D / 32, D, F, E); } SEAM(12);
#endif
    if (IN(13)) { phase_final(F, a); }
#undef IN
#undef SEAM
}

extern "C" void kernel_launch(void* const* d_in, const int* in_sizes, int n_in, void* d_out, int out_size, void* d_ws, size_t ws_size, hipStream_t stream) {
    static int grid = 0;
    if (grid == 0) {
        if (n_in != 25 || in_sizes[0] != T * D || out_size != T * D || ws_size < WS_END) { fprintf(stderr, "kernel_launch: unexpected shapes (n_in %d, ws %zu)\n", n_in, ws_size); grid = -1; return; }
        int dev = 0, cus = 0;
        if (hipGetDevice(&dev) != hipSuccess || hipDeviceGetAttribute(&cus, hipDeviceAttributeMultiprocessorCount, dev) != hipSuccess) { grid = -1; return; }
        if (hipFuncSetAttribute((const void*)fwd, hipFuncAttributeMaxDynamicSharedMemorySize, LDS_BYTES) != hipSuccess) { grid = -1; return; }
        (void)hipGetLastError();
        grid = cus;
    }
    if (grid < 0) return;
    (void)hipMemsetAsync((char*)d_ws + WS_CTL, 0, CTL_ZERO_BYTES, stream);
    Args a{};
    for (int i = 0; i < 25; ++i) a.in[i] = (const float*)d_in[i];
    a.out = (float*)d_out; a.ws = (unsigned char*)d_ws;
#if MK_ONE_LAUNCH
    a.ph_lo = 0; a.ph_hi = NPHASES;
    hipLaunchKernelGGL(fwd, dim3(grid), dim3(NTHREADS), LDS_BYTES, stream, a);
#else
    for (int p = 0; p < NPHASES; ++p) { a.ph_lo = p; a.ph_hi = p + 1; hipLaunchKernelGGL(fwd, dim3(grid), dim3(NTHREADS), LDS_BYTES, stream, a); }
#endif
}
```
